# Optimizing an MI355X kernel written in HIP

```python
import jax, jax.numpy as jnp
from jax import lax
import numpy as np


D_MODEL = 1024
BATCH = 8
SEQ = 4096
DEPTH = 2

CTX_LEN = 256
GRID_W = 64
BLOCK = 128
WINDOW = 128
ROPE_BASE = 10000.0
EPS = 1e-6
N_MOD = 6
D_FF = 4 * D_MODEL

A_HEADS = 4
A_HEAD_DIM = D_MODEL // 8
A_WIDTH = A_HEADS * A_HEAD_DIM
A_GATES = 4 * A_HEADS
B_HEADS = 8
B_KV_HEADS = 2
B_HEAD_DIM = D_MODEL // 16
B_WIDTH = B_HEADS * B_HEAD_DIM
B_KV_WIDTH = B_KV_HEADS * B_HEAD_DIM
AB_IN = 4 * A_WIDTH + A_GATES + B_WIDTH + 2 * B_KV_WIDTH
AB_OUT = A_WIDTH + B_WIDTH
C_HEADS = 8
C_KV_HEADS = 2
C_HEAD_DIM = D_MODEL // 8
C_WIDTH = C_HEADS * C_HEAD_DIM
C_KV_WIDTH = C_KV_HEADS * C_HEAD_DIM
C_IN = C_WIDTH + 2 * C_KV_WIDTH

kernel_name = 'hybrid_mlstm_swa_axial_gqa_dit'


def rms_norm(x, g):
    xf = x.astype(jnp.float32)
    y = xf * lax.rsqrt(jnp.mean(xf * xf, axis=-1, keepdims=True) + EPS)
    return (y * g.astype(jnp.float32)).astype(x.dtype)


def modulate(x, g, mod, i):
    return rms_norm(x, g) * (1 + mod[:, :, i + 1]) + mod[:, :, i]


def sq_relu_mlp(h, w1, w2):
    return jnp.square(jax.nn.relu(h @ w1)) @ w2


def axial_rope_tables(n_tokens, head_dim):
    rows = n_tokens // GRID_W
    row = jnp.broadcast_to(jnp.arange(rows)[:, None], (rows, GRID_W)).reshape(n_tokens).astype(jnp.float32)
    col = jnp.broadcast_to(jnp.arange(GRID_W)[None, :], (rows, GRID_W)).reshape(n_tokens).astype(jnp.float32)
    pairs_per_axis = head_dim // 4
    inv_freq = ROPE_BASE ** (-jnp.arange(pairs_per_axis, dtype=jnp.float32) / pairs_per_axis)
    ang = jnp.concatenate([row[:, None] * inv_freq, col[:, None] * inv_freq], axis=-1)
    return jnp.cos(ang), jnp.sin(ang)


def apply_rope(x, cos, sin):
    half = x.shape[-1] // 2
    xf = x.astype(jnp.float32)
    x1, x2 = xf[..., :half], xf[..., half:]
    cs, sn = cos[:, None, :], sin[:, None, :]
    return jnp.concatenate([x1 * cs - x2 * sn, x2 * cs + x1 * sn], axis=-1).astype(x.dtype)


def gqa_attend(q, k, v, sink=None):
    b, tq, hq, d = q.shape
    hkv = k.shape[2]
    g = hq // hkv
    s = jnp.einsum('bqhgd,bkhd->bhgqk', q.reshape(b, tq, hkv, g, d), k).astype(jnp.float32) * d ** -0.5
    if sink is None:
        p = jax.nn.softmax(s, axis=-1)
    else:
        s_sink = jnp.broadcast_to(sink.astype(jnp.float32).reshape(1, hkv, g, 1, 1), s.shape[:-1] + (1,))
        p = jax.nn.softmax(jnp.concatenate([s, s_sink], axis=-1), axis=-1)[..., :-1]
    o = jnp.einsum('bhgqk,bkhd->bqhgd', p.astype(v.dtype), v)
    return o.reshape(b, tq, hq * d)


def banded_window_attention(q, k, v, k_ctx, v_ctx, sink):
    b, t, hq, d = q.shape
    hkv = k.shape[2]
    g = hq // hkv
    nb = t // BLOCK
    n_ctx = k_ctx.shape[1]
    nw = 3 * BLOCK
    scale = d ** -0.5
    qb = jnp.moveaxis(q.reshape(b, nb, BLOCK, hkv, g, d), 1, 0)

    def band(a):
        a = jnp.pad(a, ((0, 0), (BLOCK, BLOCK), (0, 0), (0, 0))).reshape(b, nb + 2, BLOCK, hkv, d)
        a = jnp.concatenate([a[:, :-2], a[:, 1:-1], a[:, 2:]], axis=2)
        return jnp.moveaxis(a, 1, 0)

    kw, vw = band(k), band(v)
    qpos = jnp.arange(nb)[:, None, None] * BLOCK + jnp.arange(BLOCK)[None, :, None]
    kpos = (jnp.arange(nb)[:, None, None] - 1) * BLOCK + jnp.arange(nw)[None, None, :]
    valid = (jnp.abs(kpos - qpos) <= WINDOW) & (kpos >= 0) & (kpos < t)
    sink_l = sink.astype(jnp.float32).reshape(1, hkv, g, 1, 1)

    def one_block(args):
        qn, kn, vn, valid_n = args
        s_win = jnp.einsum('bqhgd,bkhd->bhgqk', qn, kn).astype(jnp.float32) * scale
        s_win = jnp.where(valid_n, s_win, -jnp.inf)
        s_ctx = jnp.einsum('bqhgd,bchd->bhgqc', qn, k_ctx).astype(jnp.float32) * scale
        s_sink = jnp.broadcast_to(sink_l, s_win.shape[:-1] + (1,))
        p = jax.nn.softmax(jnp.concatenate([s_win, s_ctx, s_sink], axis=-1), axis=-1).astype(v.dtype)
        o = (jnp.einsum('bhgqk,bkhd->bqhgd', p[..., :nw], vn)
             + jnp.einsum('bhgqc,bchd->bqhgd', p[..., nw:nw + n_ctx], v_ctx))
        return o.reshape(b, BLOCK, hq * d)

    o = lax.map(one_block, (qb, kw, vw, valid))
    return jnp.moveaxis(o, 0, 1).reshape(b, t, hq * d)


def mlstm_dir(q, k, v, log_i, log_f, state):
    n_chunks = q.shape[2] // BLOCK

    def to_chunks(a):
        a = a.reshape(a.shape[:2] + (n_chunks, BLOCK) + a.shape[3:])
        return jnp.moveaxis(a, 2, 0)

    lower = jnp.tril(jnp.ones((BLOCK, BLOCK), dtype=bool))

    def step(carry, inp):
        c_mat, n_vec, m = carry
        qc, kc, vc, ic, fc = inp
        bcum = jnp.cumsum(fc, axis=-1)
        d_log = jnp.where(lower, bcum[..., :, None] - bcum[..., None, :] + ic[..., None, :], -jnp.inf)
        inter_log = bcum + m[..., None]
        m_t = jnp.maximum(inter_log, jnp.max(d_log, axis=-1))
        inter_w = jnp.exp(inter_log - m_t)
        s = jnp.einsum('bhtd,bhsd->bhts', qc, kc) * jnp.exp(d_log - m_t[..., None])
        num = inter_w[..., None] * jnp.einsum('bhtd,bhde->bhte', qc, c_mat) + jnp.einsum('bhts,bhse->bhte', s, vc)
        den = inter_w * jnp.einsum('bhtd,bhd->bht', qc, n_vec) + jnp.sum(s, axis=-1)
        h = num / jnp.maximum(jnp.abs(den), jnp.exp(-m_t))[..., None]
        b_last = bcum[..., -1]
        w_log = b_last[..., None] - bcum + ic
        m_new = jnp.maximum(b_last + m, jnp.max(w_log, axis=-1))
        carry_w = jnp.exp(b_last + m - m_new)
        w = jnp.exp(w_log - m_new[..., None])
        c_new = carry_w[..., None, None] * c_mat + jnp.einsum('bhs,bhsd,bhse->bhde', w, kc, vc)
        n_new = carry_w[..., None] * n_vec + jnp.einsum('bhs,bhsd->bhd', w, kc)
        return (c_new, n_new, m_new), h

    state, h = lax.scan(step, state, (to_chunks(q), to_chunks(k), to_chunks(v), to_chunks(log_i), to_chunks(log_f)))
    h = jnp.moveaxis(h, 0, 2)
    return h.reshape(h.shape[:2] + (-1, h.shape[-1])), state


def mlstm_bidir(q, k, v, gates, state_f, state_b):
    li_f, lf_f, li_b, lf_b = gates
    h_f, st_f = mlstm_dir(q, k, v, li_f, lf_f, state_f)
    flip = lambda a: jnp.flip(a, axis=2)
    h_b, st_b = mlstm_dir(flip(q), flip(k), flip(v), flip(li_b), flip(lf_b), state_b)
    return h_f + flip(h_b), st_f, st_b


def ab_mixer(h_ctx, h_lat, w_in, gate_b, a_norm_g, q_norm_g, k_norm_g, sink, w_out, need_ctx):
    batch = h_lat.shape[0]
    sizes = [A_WIDTH] * 4 + [A_GATES, B_WIDTH, B_KV_WIDTH]
    bounds = [int(s) for s in np.cumsum(sizes)]

    def project(h):
        t = h.shape[1]
        qa, ka, va, oa, ga, qb, kb, vb = jnp.split(h @ w_in, bounds, axis=-1)
        heads_a = lambda a: a.reshape(batch, t, A_HEADS, A_HEAD_DIM).transpose(0, 2, 1, 3).astype(jnp.float32)
        qa, ka, va = heads_a(qa), heads_a(ka) * A_HEAD_DIM ** -0.5, heads_a(va)
        g = (ga + gate_b).astype(jnp.float32).reshape(batch, t, 4, A_HEADS).transpose(2, 0, 3, 1)
        gates = (g[0], jax.nn.log_sigmoid(g[1]), g[2], jax.nn.log_sigmoid(g[3]))
        qb = rms_norm(qb.reshape(batch, t, B_HEADS, B_HEAD_DIM), q_norm_g)
        kb = rms_norm(kb.reshape(batch, t, B_KV_HEADS, B_HEAD_DIM), k_norm_g)
        vb = vb.reshape(batch, t, B_KV_HEADS, B_HEAD_DIM)
        return (qa, ka, va, gates), oa, (qb, kb, vb)

    def mlstm_out(h, oa):
        h = rms_norm(h.transpose(0, 2, 1, 3), a_norm_g.reshape(A_HEADS, A_HEAD_DIM))
        return (h.reshape(h.shape[0], h.shape[1], A_WIDTH) * jax.nn.sigmoid(oa)).astype(oa.dtype)

    a_c, oa_c, (qb_c, kb_c, vb_c) = project(h_ctx)
    a_l, oa_l, (qb_l, kb_l, vb_l) = project(h_lat)
    zero = (jnp.zeros((batch, A_HEADS, A_HEAD_DIM, A_HEAD_DIM), jnp.float32),
            jnp.zeros((batch, A_HEADS, A_HEAD_DIM), jnp.float32),
            jnp.zeros((batch, A_HEADS), jnp.float32))
    ha_c, st_f, st_b = mlstm_bidir(*a_c, zero, zero)
    ha_l, _, _ = mlstm_bidir(*a_l, st_f, st_b)
    cos, sin = axial_rope_tables(h_lat.shape[1], B_HEAD_DIM)
    qb_l, kb_l = apply_rope(qb_l, cos, sin), apply_rope(kb_l, cos, sin)
    ob_l = banded_window_attention(qb_l, kb_l, vb_l, kb_c, vb_c, sink)
    y_lat = jnp.concatenate([mlstm_out(ha_l, oa_l), ob_l.astype(oa_l.dtype)], axis=-1) @ w_out
    y_ctx = None
    if need_ctx:
        ob_c = gqa_attend(qb_c, kb_c, vb_c, sink)
        y_ctx = jnp.concatenate([mlstm_out(ha_c, oa_c), ob_c.astype(oa_c.dtype)], axis=-1) @ w_out
    return y_ctx, y_lat


def c_mixer(h_ctx, h_lat, w_in, q_norm_g, k_norm_g, w_out, need_ctx):
    def project(h):
        b, t, _ = h.shape
        q, k, v = jnp.split(h @ w_in, [C_WIDTH, C_WIDTH + C_KV_WIDTH], axis=-1)
        q = rms_norm(q.reshape(b, t, C_HEADS, C_HEAD_DIM), q_norm_g)
        k = rms_norm(k.reshape(b, t, C_KV_HEADS, C_HEAD_DIM), k_norm_g)
        return q, k, v.reshape(b, t, C_KV_HEADS, C_HEAD_DIM)

    q_c, k_c, v_c = project(h_ctx)
    q_l, k_l, v_l = project(h_lat)
    b, t = h_lat.shape[:2]
    cos, sin = axial_rope_tables(t, C_HEAD_DIM)
    q_l, k_l = apply_rope(q_l, cos, sin), apply_rope(k_l, cos, sin)
    k_all = jnp.concatenate([k_c, k_l], axis=1)
    v_all = jnp.concatenate([v_c, v_l], axis=1)
    q_blocks = jnp.moveaxis(q_l.reshape(b, t // BLOCK, BLOCK, C_HEADS, C_HEAD_DIM), 1, 0)
    o = lax.map(lambda qb: gqa_attend(qb, k_all, v_all), q_blocks)
    y_lat = jnp.moveaxis(o, 0, 1).reshape(b, t, C_WIDTH) @ w_out
    y_ctx = gqa_attend(q_c, k_c, v_c) @ w_out if need_ctx else None
    return y_ctx, y_lat


def setup_inputs(seed: int = 0) -> dict:
    key = jax.random.key(seed)
    ks = jax.random.split(key, 24)
    n_even = (DEPTH + 1) // 2
    n_odd = DEPTH // 2
    f32 = jnp.float32
    nrm = lambda k, shape, scale: jax.random.normal(k, shape, f32) * scale
    gain = lambda k, shape: 1.0 + 0.05 * jax.random.normal(k, shape, f32)
    gate_b = jnp.concatenate([
        nrm(ks[9], (n_even, A_HEADS), 0.1),
        jax.random.uniform(ks[10], (n_even, A_HEADS), f32, 3.0, 6.0),
        nrm(ks[11], (n_even, A_HEADS), 0.1),
        jax.random.uniform(ks[12], (n_even, A_HEADS), f32, 3.0, 6.0)], axis=-1)
    return {
        'x': nrm(ks[0], (BATCH, SEQ, D_MODEL), 1.0),
        'c': nrm(ks[1], (BATCH, D_MODEL), 1.0),
        'ctx': nrm(ks[2], (BATCH, CTX_LEN, D_MODEL), 1.0),
        'c_ctx': nrm(ks[3], (D_MODEL,), 1.0),
        'ada_w': nrm(ks[4], (DEPTH, D_MODEL, N_MOD * D_MODEL), 0.5 * D_MODEL ** -0.5),
        'ada_b': nrm(ks[5], (DEPTH, N_MOD * D_MODEL), 0.02),
        'norm1_g': gain(ks[6], (DEPTH, D_MODEL)),
        'norm2_g': gain(ks[7], (DEPTH, D_MODEL)),
        'ab_w_in': nrm(ks[8], (n_even, D_MODEL, AB_IN), D_MODEL ** -0.5),
        'ab_gate_b': gate_b,
        'mlstm_norm_g': gain(ks[13], (n_even, A_WIDTH)),
        'swa_q_norm_g': gain(ks[14], (n_even, B_HEAD_DIM)),
        'swa_k_norm_g': gain(ks[15], (n_even, B_HEAD_DIM)),
        'swa_sink': nrm(ks[16], (n_even, B_HEADS), 0.5),
        'ab_w_out': nrm(ks[17], (n_even, AB_OUT, D_MODEL), AB_OUT ** -0.5),
        'c_w_in': nrm(ks[18], (n_odd, D_MODEL, C_IN), D_MODEL ** -0.5),
        'c_q_norm_g': gain(ks[19], (n_odd, C_HEAD_DIM)),
        'c_k_norm_g': gain(ks[20], (n_odd, C_HEAD_DIM)),
        'c_w_out': nrm(ks[21], (n_odd, C_WIDTH, D_MODEL), C_WIDTH ** -0.5),
        'mlp_w1': nrm(ks[22], (DEPTH, D_MODEL, D_FF), D_MODEL ** -0.5),
        'mlp_w2': nrm(ks[23], (DEPTH, D_FF, D_MODEL), D_FF ** -0.5),
    }


def reference(x, c, ctx, c_ctx, ada_w, ada_b, norm1_g, norm2_g, ab_w_in, ab_gate_b, mlstm_norm_g,
              swa_q_norm_g, swa_k_norm_g, swa_sink, ab_w_out, c_w_in, c_q_norm_g, c_k_norm_g, c_w_out,
              mlp_w1, mlp_w2):
    batch = x.shape[0]
    for layer in range(DEPTH):
        last = layer == DEPTH - 1
        mod_l = (jax.nn.silu(c) @ ada_w[layer] + ada_b[layer]).reshape(batch, 1, N_MOD, D_MODEL)
        mod_c = (jax.nn.silu(c_ctx) @ ada_w[layer] + ada_b[layer]).reshape(1, 1, N_MOD, D_MODEL)
        h_l = modulate(x, norm1_g[layer], mod_l, 0)
        h_c = modulate(ctx, norm1_g[layer], mod_c, 0)
        j = layer // 2
        if layer % 2 == 0:
            y_c, y_l = ab_mixer(h_c, h_l, ab_w_in[j], ab_gate_b[j], mlstm_norm_g[j], swa_q_norm_g[j],
                                swa_k_norm_g[j], swa_sink[j], ab_w_out[j], not last)
        else:
            y_c, y_l = c_mixer(h_c, h_l, c_w_in[j], c_q_norm_g[j], c_k_norm_g[j], c_w_out[j], not last)
        x = x + mod_l[:, :, 2] * y_l
        x = x + mod_l[:, :, 5] * sq_relu_mlp(modulate(x, norm2_g[layer], mod_l, 3), mlp_w1[layer], mlp_w2[layer])
        if not last:
            ctx = ctx + mod_c[:, :, 2] * y_c
            ctx = ctx + mod_c[:, :, 5] * sq_relu_mlp(modulate(ctx, norm2_g[layer], mod_c, 3), mlp_w1[layer], mlp_w2[layer])
    return x
```

```cpp
#include <hip/hip_runtime.h>
#include <hip/hip_cooperative_groups.h>
#include <cstdio>
#include <cstdint>
namespace cg = cooperative_groups;
namespace pg8 {
#define PG8_LAS __attribute__((address_space(3)))
typedef unsigned short bf16_t;
typedef short bf16x8 __attribute__((ext_vector_type(8)));
typedef float f32x4 __attribute__((ext_vector_type(4)));
typedef unsigned u32x4 __attribute__((ext_vector_type(4)));
constexpr int BM = 256, BK = 64, HALF = 128, HTB = HALF * BK * 2  , STAGE_BYTES = 8 * HTB, NXCD = 8, WGM = 8;

__host__ __device__ __forceinline__ int lds_byte(int r, int c) { const int st = (r >> 4) * 2 + (c >> 5), rr = r & 15, cc = c & 31, ob = rr * 64 + cc * 2; return st * 1024 + (ob ^ (((ob >> 9) & 1) << 5)); }
__host__ __device__ __forceinline__ void stage_rc(int b, int& R, int& C) { const int st = b / 1024, sb = b % 1024, swz = sb ^ (((sb >> 9) & 1) << 5); R = (st >> 1) * 16 + swz / 64; C = (st & 1) * 32 + (swz % 64) / 2; }
__host__ __device__ __forceinline__ int perm32(int rho) { const int n = rho >> 4, i = rho & 15; return 8 * (i >> 2) + 4 * n + (i & 3); }

struct Unit { int pm, pn; };
struct Gemm { const bf16_t* A; const bf16_t* Bt; int M, N, K; };

struct StaticOrder {
    int nM, nN, nwg, G, c, lo, hi;
    __host__ __device__ void init(int M, int N, int G_, int c_) { nM = M / BM; nN = N / BM; nwg = nM * nN; G = G_; c = c_; lo = 0; hi = nwg; }
    __host__ __device__ void range(int lo_, int hi_) { lo = lo_; hi = hi_ < nwg ? hi_ : nwg; }
    __host__ __device__ bool next(int i, Unit& u) const {
        const long L = (long)lo + (long)i * G + c; if (L >= hi) return false;
        int wgid = (int)L; { const int q = nwg / NXCD, r = nwg % NXCD, xcd = wgid % NXCD, off = wgid / NXCD; wgid = (xcd < r ? xcd * (q + 1) : r * (q + 1) + (xcd - r) * q) + off; }
        const int nig = WGM * nN, gid = wgid / nig, fm = gid * WGM, gsz = (nM - fm) < WGM ? (nM - fm) : WGM;
        u.pm = fm + ((wgid % nig) % gsz); u.pn = (wgid % nig) / gsz; return true;
    }
    __device__ __forceinline__ void a_ready(const Unit&) const {}
    __device__ __forceinline__ void done(const Unit&) const {}
};
}
namespace pg8 {

template <class Epi, class Sched, bool ALIGN_EPI = false, bool SP2 = false>
__device__ __forceinline__ void gemm_phase(PG8_LAS unsigned char* lds, const Gemm g, const Sched& S, const Epi& E, const int tid_in) {
    int tid_ = tid_in; asm volatile("" : "+v"(tid_)); const int tid = tid_, wid = __builtin_amdgcn_readfirstlane(tid >> 6), lane = tid & 63, wr = wid >> 2, wc = wid & 3, fr = lane & 15, fq = lane >> 4;
    const int K = g.K, nt = K / BK;
    unsigned voffA[2], voffB[2];
#pragma unroll
    for (int i = 0; i < 2; ++i) { int R, C; stage_rc(tid * 16 + i * 8192, R, C); const int Rb = Epi::PERM ? ((R & ~31) + perm32(R & 31)) : R;
        voffA[i] = (unsigned)(R * K + C) * 2u; voffB[i] = (unsigned)(Rb * K + C) * 2u; }
    const size_t kstep = (size_t)(BK * 2);
    const size_t hstep = (size_t)HALF * K * 2;
    const size_t tstep = 2 * hstep;
    const unsigned ldsw = (unsigned)wid * 1024u;
    const int aoff = lds_byte(wr * 64 + fr, fq * 8), boff = lds_byte(wc * 32 + fr, fq * 8);
#define PG8_SA(b, h) (((b) * 2 + (h)) * HTB)
#define PG8_SB(b, h) ((4 + (b) * 2 + (h)) * HTB)
#define PG8_STAGE(bufoff, gbase, voff) do { _Pragma("unroll") for (int _i = 0; _i < 2; ++_i) \
        __builtin_amdgcn_global_load_lds((const unsigned*)((const char*)(gbase) + (voff)[_i]), (PG8_LAS unsigned*)(lds + (bufoff) + ldsw + _i * 8192), 16, 0, 0); } while (0)
#define PG8_LDA(dst, b, h) do { _Pragma("unroll") for (int m = 0; m < 4; ++m) _Pragma("unroll") for (int k = 0; k < 2; ++k) dst[m][k] = *(const PG8_LAS bf16x8*)(lds + PG8_SA(b, h) + aoff + m * 2048 + k * 1024); } while (0)
#define PG8_LDB(dst, b, h) do { _Pragma("unroll") for (int n = 0; n < 2; ++n) _Pragma("unroll") for (int k = 0; k < 2; ++k) dst[n][k] = *(const PG8_LAS bf16x8*)(lds + PG8_SB(b, h) + boff + n * 2048 + k * 1024); } while (0)
#define PG8_MMA(ai, bj, At, Bt) do { __builtin_amdgcn_s_setprio(1); _Pragma("unroll") for (int m = 0; m < 4; ++m) _Pragma("unroll") for (int n = 0; n < 2; ++n) _Pragma("unroll") for (int k = 0; k < 2; ++k) \
        acc[ai][bj][m][n] = __builtin_amdgcn_mfma_f32_16x16x32_bf16(Bt[n][k], At[m][k], acc[ai][bj][m][n], 0, 0, 0); __builtin_amdgcn_s_setprio(0); } while (0)
#define PG8_WAIT_V(n) asm volatile("s_waitcnt vmcnt(" #n ")" ::: "memory")
#define PG8_WAIT_L(n) asm volatile("s_waitcnt lgkmcnt(" #n ")" ::: "memory")
#define PG8_BAR __builtin_amdgcn_s_barrier()
#define PG8_SCHED __builtin_amdgcn_sched_barrier(0)
    Unit cur, nxt; int ui = 0;
    if (!S.next(0, cur)) return;
    f32x4 acc[2][2][4][2];
#pragma unroll
    for (int a = 0; a < 2; ++a)
#pragma unroll
        for (int b = 0; b < 2; ++b)
#pragma unroll
            for (int m = 0; m < 4; ++m)
#pragma unroll
                for (int n = 0; n < 2; ++n) acc[a][b][m][n] = (f32x4){0.f, 0.f, 0.f, 0.f};
    bf16x8 At[4][2], B0[2][2], B1[2][2];
    const char* cA = (const char*)g.A + (size_t)cur.pm * tstep; const char* cB = (const char*)g.Bt + (size_t)cur.pn * tstep;
    S.a_ready(cur);
    if constexpr (SP2) {
        PG8_STAGE(PG8_SB(0, 0), cB, voffB); PG8_STAGE(PG8_SB(0, 1), cB + hstep, voffB); PG8_STAGE(PG8_SA(0, 0), cA, voffA); PG8_STAGE(PG8_SA(0, 1), cA + hstep, voffA);
        if (wr == 1) PG8_BAR;
        PG8_WAIT_V(2); PG8_BAR;
        PG8_STAGE(PG8_SB(1, 0), cB + kstep, voffB); PG8_STAGE(PG8_SA(1, 0), cA + kstep, voffA); PG8_STAGE(PG8_SB(1, 1), cB + hstep + kstep, voffB);
        PG8_WAIT_V(6); PG8_BAR;
    } else {
        PG8_STAGE(PG8_SB(0, 0), cB, voffB); PG8_STAGE(PG8_SA(0, 0), cA, voffA); PG8_STAGE(PG8_SB(0, 1), cB + hstep, voffB); PG8_STAGE(PG8_SA(0, 1), cA + hstep, voffA);
        if (wr == 1) PG8_BAR;
        PG8_WAIT_V(4); PG8_BAR;
        PG8_STAGE(PG8_SB(1, 0), cB + kstep, voffB); PG8_STAGE(PG8_SA(1, 0), cA + kstep, voffA); PG8_STAGE(PG8_SB(1, 1), cB + hstep + kstep, voffB);
        PG8_WAIT_V(6); PG8_BAR;
    }
    for (;;) {
        const bool has_next = S.next(ui + 1, nxt);
        const char* nA = has_next ? (const char*)g.A + (size_t)nxt.pm * tstep : cA; const char* nB = has_next ? (const char*)g.Bt + (size_t)nxt.pn * tstep : cB;
        for (int t = 0; t < nt; t += 2) {
            const bool last = (t == nt - 2);
            const char* a1 = cA + (size_t)(t + 1) * kstep;
            const char* a2 = last ? nA : cA + (size_t)(t + 2) * kstep; const char* b2 = last ? nB : cB + (size_t)(t + 2) * kstep;
            const char* a3 = a2 + kstep; const char* b3 = b2 + kstep;
            if (last && has_next) S.a_ready(nxt);
            if constexpr (SP2) {
            PG8_LDB(B0, 0, 0); PG8_LDB(B1, 0, 1); PG8_SCHED; PG8_LDA(At, 0, 0); PG8_STAGE(PG8_SA(1, 1), a1 + hstep, voffA);
            PG8_WAIT_V(8); PG8_WAIT_L(0); PG8_BAR; PG8_MMA(0, 0, At, B0); PG8_MMA(0, 1, At, B1); PG8_BAR; PG8_SCHED;
            PG8_LDA(At, 0, 1); PG8_STAGE(PG8_SB(0, 0), b2, voffB); PG8_STAGE(PG8_SB(0, 1), b2 + hstep, voffB); PG8_STAGE(PG8_SA(0, 0), a2, voffA);
            PG8_WAIT_V(8); PG8_WAIT_L(0); PG8_BAR; PG8_MMA(1, 0, At, B0); PG8_MMA(1, 1, At, B1); PG8_BAR; PG8_SCHED;
            PG8_LDB(B0, 1, 0); PG8_LDB(B1, 1, 1); PG8_SCHED; PG8_LDA(At, 1, 0); PG8_STAGE(PG8_SA(0, 1), a2 + hstep, voffA);
            PG8_WAIT_V(8); PG8_WAIT_L(0); PG8_BAR; PG8_MMA(0, 0, At, B0); PG8_MMA(0, 1, At, B1); PG8_BAR; PG8_SCHED;
            PG8_LDA(At, 1, 1); PG8_STAGE(PG8_SB(1, 0), b3, voffB); PG8_STAGE(PG8_SB(1, 1), b3 + hstep, voffB); PG8_STAGE(PG8_SA(1, 0), a3, voffA);
            PG8_WAIT_V(8); PG8_WAIT_L(0); PG8_BAR; PG8_MMA(1, 0, At, B0); PG8_MMA(1, 1, At, B1); PG8_BAR; PG8_SCHED;
            } else {
            PG8_LDB(B0, 0, 0); PG8_SCHED; PG8_LDA(At, 0, 0); PG8_STAGE(PG8_SA(1, 1), a1 + hstep, voffA);
            PG8_WAIT_L(8); PG8_BAR; PG8_WAIT_L(0); PG8_MMA(0, 0, At, B0); PG8_BAR; PG8_SCHED;
            PG8_LDB(B1, 0, 1); PG8_STAGE(PG8_SB(0, 0), b2, voffB);
            PG8_BAR; PG8_WAIT_L(0); PG8_MMA(0, 1, At, B1); PG8_BAR;
            PG8_LDA(At, 0, 1); PG8_STAGE(PG8_SA(0, 0), a2, voffA);
            PG8_BAR; PG8_WAIT_L(0); PG8_MMA(1, 0, At, B0); PG8_BAR; PG8_SCHED;
            PG8_STAGE(PG8_SB(0, 1), b2 + hstep, voffB);
            PG8_WAIT_V(6); PG8_BAR; PG8_MMA(1, 1, At, B1); PG8_BAR;
            PG8_LDB(B0, 1, 0); PG8_SCHED; PG8_LDA(At, 1, 0); PG8_STAGE(PG8_SA(0, 1), a2 + hstep, voffA);
            PG8_WAIT_L(8); PG8_BAR; PG8_WAIT_L(0); PG8_MMA(0, 0, At, B0); PG8_BAR; PG8_SCHED;
            PG8_LDB(B1, 1, 1); PG8_STAGE(PG8_SB(1, 0), b3, voffB);
            PG8_BAR; PG8_WAIT_L(0); PG8_MMA(0, 1, At, B1); PG8_BAR;
            PG8_LDA(At, 1, 1); PG8_STAGE(PG8_SA(1, 0), a3, voffA);
            PG8_BAR; PG8_WAIT_L(0); PG8_MMA(1, 0, At, B0); PG8_BAR; PG8_SCHED;
            PG8_STAGE(PG8_SB(1, 1), b3 + hstep, voffB);
            PG8_WAIT_V(6); PG8_BAR; PG8_MMA(1, 1, At, B1); PG8_BAR;
            }
        }
        if constexpr (ALIGN_EPI) { if (wr == 0) PG8_BAR; }
        if constexpr (!Epi::AFTER_DRAIN) { E(acc, cur, wr, wc, fr, fq); S.done(cur); }
        if (!has_next) break;
#pragma unroll
        for (int a = 0; a < 2; ++a)
#pragma unroll
            for (int b = 0; b < 2; ++b)
#pragma unroll
                for (int m = 0; m < 4; ++m)
#pragma unroll
                    for (int n = 0; n < 2; ++n) acc[a][b][m][n] = (f32x4){0.f, 0.f, 0.f, 0.f};
        cur = nxt; cA = nA; cB = nB; ++ui;
        if constexpr (ALIGN_EPI) { if (wr == 1) PG8_BAR; }
    }
    PG8_WAIT_V(0);
    if constexpr (!ALIGN_EPI) { if (wr == 0) PG8_BAR; }
    PG8_BAR;
    if constexpr (Epi::AFTER_DRAIN) { E.fused(acc, cur, wr, wc, fr, fq, lds, wid, lane); S.done(cur); }
#undef PG8_SA
#undef PG8_SB
#undef PG8_STAGE
#undef PG8_LDA
#undef PG8_LDB
#undef PG8_MMA
#undef PG8_WAIT_V
#undef PG8_WAIT_L
#undef PG8_BAR
#undef PG8_SCHED
}
}

#define DI __device__ __forceinline__
#define LAS __attribute__((address_space(3)))
typedef unsigned short bf16;
typedef short bf16x8 __attribute__((ext_vector_type(8)));
typedef short s16x4 __attribute__((ext_vector_type(4)));
typedef float f32x2 __attribute__((ext_vector_type(2)));
typedef float f32x4 __attribute__((ext_vector_type(4)));
typedef float f32x16 __attribute__((ext_vector_type(16)));
typedef unsigned u32x2 __attribute__((ext_vector_type(2)));
typedef unsigned u32x4 __attribute__((ext_vector_type(4)));
typedef __bf16 bf16x2_t __attribute__((ext_vector_type(2)));
#define LDS_WAIT() asm volatile("s_waitcnt lgkmcnt(0)" ::: "memory")
#define MFMA32(a, b, c) __builtin_amdgcn_mfma_f32_32x32x16_bf16((a), (b), (c), 0, 0, 0)

constexpr int DM = 1024, NBATCH = 8, SEQ = 4096, CTXL = 256, NCTX = NBATCH * CTXL, NLAT = NBATCH * SEQ, MTOT = NCTX + NLAT;
constexpr int NIN0 = 2816, NIN1 = 1536, DFF = 4096, KVLEN = CTXL + SEQ, AB_IN_W = 2832, NMODC = 6144;
constexpr float EPS = 1e-6f, LOG2E = 1.4426950408889634f;
constexpr size_t MiB = 1u << 20;
constexpr size_t WS_WIN0 = 0, WS_WOUT0 = 6 * MiB, WS_WIN1 = 8 * MiB, WS_WOUT1 = 11 * MiB, WS_W1 = 13 * MiB, WS_W2 = 29 * MiB, WS_MOD = 45 * MiB,
                 WS_GATES = 46 * MiB, WS_XC = 49 * MiB, WS_VT = 57 * MiB, WS_H = 74 * MiB, WS_OCAT = 142 * MiB, WS_BIG = 210 * MiB, WS_BAR = 482 * MiB, WS_RSS = 483 * MiB, WS_BIAS = 484 * MiB, WS_V1 = 485 * MiB, WS_END = 502 * MiB;
constexpr size_t WS_WG = 45 * MiB + 512 * 1024;
constexpr int LDS_BYTES = 147456;

struct Params { const float* in[21]; float* out; unsigned char* ws; };

DI unsigned cvtpk(float lo, float hi) { f32x2 v = {lo, hi}; bf16x2_t b = __builtin_convertvector(v, bf16x2_t); return __builtin_bit_cast(unsigned, b); }
DI bf16 f2bf(float x) { return (bf16)(cvtpk(x, 0.f) & 0xffffu); }
DI float bf2f(bf16 b) { return __uint_as_float(((unsigned)b) << 16); }
DI float wave_sum(float v) {
#pragma unroll
    for (int o = 1; o < 64; o <<= 1) v += __shfl_xor(v, o);
    return v;
}
DI int fresh_lane() { int l; asm volatile("v_mbcnt_lo_u32_b32 %0, -1, 0\n\tv_mbcnt_hi_u32_b32 %0, -1, %0" : "=v"(l)); return l; }
DI int crow(int i, int h) { return (i & 3) + 8 * (i >> 2) + 4 * h; }
DI f32x16 zero16() { f32x16 z; for (int i = 0; i < 16; ++i) z[i] = 0.f; return z; }

DI void mma32(f32x16& acc, const LAS bf16* A, int lda, const LAS bf16* B, int ldb, int K, int lane) {
    const int r = lane & 31, h = lane >> 5;
    const LAS bf16* ap = A + r * lda + 8 * h; const LAS bf16* bp = B + r * ldb + 8 * h;
#pragma unroll 1
    for (int k0 = 0; k0 < K; k0 += 16) {
        const bf16x8 a = *(const LAS bf16x8*)(ap + k0); const bf16x8 b = *(const LAS bf16x8*)(bp + k0);
        acc = MFMA32(a, b, acc);
    }
}

template <int ACT> struct EpiStore {
    static constexpr bool PERM = true, AFTER_DRAIN = false;
    bf16* O; int ldc;
    DI void operator()(const f32x4 (&acc)[2][2][4][2], const pg8::Unit& u, int wr, int wc, int fr, int fq) const {
        const int row0 = u.pm * 256 + wr * 64 + fr, col0 = u.pn * 256 + wc * 32 + 8 * fq;
#pragma unroll
        for (int ai = 0; ai < 2; ++ai)
#pragma unroll
            for (int m = 0; m < 4; ++m) { bf16* rowp = O + (size_t)(row0 + ai * 128 + m * 16) * ldc + col0;
#pragma unroll
                for (int bj = 0; bj < 2; ++bj) { f32x4 v0 = acc[ai][bj][m][0], v1 = acc[ai][bj][m][1];
                    if (ACT == 1) {
#pragma unroll
                        for (int e = 0; e < 4; ++e) { float a = fmaxf(v0[e], 0.f), b = fmaxf(v1[e], 0.f); v0[e] = a * a; v1[e] = b * b; } }
                    u32x4 w; w.x = cvtpk(v0[0], v0[1]); w.y = cvtpk(v0[2], v0[3]); w.z = cvtpk(v1[0], v1[1]); w.w = cvtpk(v1[2], v1[3]);
                    *(u32x4*)(rowp + bj * 128) = w; } }
    }
};
struct EpiResid {
    static constexpr bool PERM = true, AFTER_DRAIN = false;
    const float* srcC; const float* srcL; float* dstC; float* dstL; const float* mod; int gi; int row_base;
    DI void operator()(const f32x4 (&acc)[2][2][4][2], const pg8::Unit& u, int wr, int wc, int fr, int fq) const {
        const int grow0 = row_base + u.pm * 256;
        const float* s; float* d; int mrow;
        if (grow0 < NCTX) { s = srcC + (size_t)grow0 * DM; d = dstC + (size_t)grow0 * DM; mrow = 8; }
        else { const int lr = grow0 - NCTX; s = srcL + (size_t)lr * DM; d = dstL + (size_t)lr * DM; mrow = lr >> 12; }
        const float* gp = mod + mrow * NMODC + gi * DM;
#pragma unroll
        for (int bj = 0; bj < 2; ++bj) { const int col = u.pn * 256 + bj * 128 + wc * 32 + 8 * fq;
            const f32x4 g0 = *(const f32x4*)(gp + col), g1 = *(const f32x4*)(gp + col + 4);
#pragma unroll
            for (int ai = 0; ai < 2; ++ai) {
            f32x4 rr0[4], rr1[4];
#pragma unroll
                for (int m = 0; m < 4; ++m) { const int ro = (ai * 128 + wr * 64 + m * 16 + fr) * DM + col; rr0[m] = *(const f32x4*)(s + ro); rr1[m] = *(const f32x4*)(s + ro + 4); }
            asm volatile("" ::: "memory");
#pragma unroll
                for (int m = 0; m < 4; ++m) { const int ro = (ai * 128 + wr * 64 + m * 16 + fr) * DM + col;
                    *(f32x4*)(d + ro) = rr0[m] + g0 * acc[ai][bj][m][0]; *(f32x4*)(d + ro + 4) = rr1[m] + g1 * acc[ai][bj][m][1]; } } }
    }
};
struct EpiResidN {
    static constexpr bool PERM = true, AFTER_DRAIN = false;
    const float* srcC; const float* srcL; float* dstC; float* dstL; const float* mod; int gi; int row_base;
    const float* gnext; const float* modn; int sin; bf16* Hn; float* rss;
    DI void operator()(const f32x4 (&acc)[2][2][4][2], const pg8::Unit& u, int wr, int wc, int fr, int fq) const {
        const int grow0 = row_base + u.pm * 256;
        const float* s; float* d; int mrow;
        if (grow0 < NCTX) { s = srcC + (size_t)grow0 * DM; d = dstC + (size_t)grow0 * DM; mrow = 8; }
        else { const int lr = grow0 - NCTX; s = srcL + (size_t)lr * DM; d = dstL + (size_t)lr * DM; mrow = lr >> 12; }
        const float* gp = mod + mrow * NMODC + gi * DM; const float* scp = modn + mrow * NMODC + (sin + 1) * DM;
        bf16* hb = Hn + (size_t)grow0 * DM;
        float ssq[2][4];
#pragma unroll
        for (int ai = 0; ai < 2; ++ai)
#pragma unroll
            for (int m = 0; m < 4; ++m) ssq[ai][m] = 0.f;
#pragma unroll
        for (int bj = 0; bj < 2; ++bj) { const int col = u.pn * 256 + bj * 128 + wc * 32 + 8 * fq;
            const f32x4 g0 = *(const f32x4*)(gp + col), g1 = *(const f32x4*)(gp + col + 4);
            const f32x4 w0 = *(const f32x4*)(gnext + col) * (*(const f32x4*)(scp + col) + 1.f), w1 = *(const f32x4*)(gnext + col + 4) * (*(const f32x4*)(scp + col + 4) + 1.f);
#pragma unroll
            for (int ai = 0; ai < 2; ++ai) {
            f32x4 rr0[4], rr1[4];
#pragma unroll
                for (int m = 0; m < 4; ++m) { const int ro = (ai * 128 + wr * 64 + m * 16 + fr) * DM + col; rr0[m] = *(const f32x4*)(s + ro); rr1[m] = *(const f32x4*)(s + ro + 4); }
            asm volatile("" ::: "memory");
#pragma unroll
                for (int m = 0; m < 4; ++m) { const int ro = (ai * 128 + wr * 64 + m * 16 + fr) * DM + col;
                    const f32x4 r0 = rr0[m], r1 = rr1[m];
                    const f32x4 x0 = r0 + g0 * acc[ai][bj][m][0], x1 = r1 + g1 * acc[ai][bj][m][1];
                    *(f32x4*)(d + ro) = x0; *(f32x4*)(d + ro + 4) = x1;
                    ssq[ai][m] += (x0[0] * x0[0] + x0[1] * x0[1]) + (x0[2] * x0[2] + x0[3] * x0[3]) + (x1[0] * x1[0] + x1[1] * x1[1]) + (x1[2] * x1[2] + x1[3] * x1[3]);
                    const f32x4 h0 = x0 * w0, h1 = x1 * w1;
                    u32x4 w; w.x = cvtpk(h0[0], h0[1]); w.y = cvtpk(h0[2], h0[3]); w.z = cvtpk(h1[0], h1[1]); w.w = cvtpk(h1[2], h1[3]);
                    *(u32x4*)(hb + ro) = w; } } }
#pragma unroll
        for (int ai = 0; ai < 2; ++ai)
#pragma unroll
            for (int m = 0; m < 4; ++m) { float q = ssq[ai][m]; q += __shfl_xor(q, 16); q += __shfl_xor(q, 32);
                if (fq == 0) atomicAdd(rss + grow0 + ai * 128 + wr * 64 + m * 16 + fr, q); }
    }
};
template <int ACT> struct EpiStoreN {
    static constexpr bool PERM = true, AFTER_DRAIN = false;
    bf16* O; int ldc; const float* rss; const float* bias; int row_base;
    DI void operator()(const f32x4 (&acc)[2][2][4][2], const pg8::Unit& u, int wr, int wc, int fr, int fq) const {
        const int lrow0 = u.pm * 256 + wr * 64 + fr, grow0 = row_base + u.pm * 256, col0 = u.pn * 256 + wc * 32 + 8 * fq;
        bf16* Ou = O + (size_t)(u.pm * 256) * ldc + u.pn * 256;
        const int mrow = grow0 < NCTX ? 8 : (grow0 - NCTX) >> 12;
        float rstd[2][4];
#pragma unroll
        for (int ai = 0; ai < 2; ++ai)
#pragma unroll
            for (int m = 0; m < 4; ++m) rstd[ai][m] = rsqrtf(rss[row_base + lrow0 + ai * 128 + m * 16] * (1.f / DM) + EPS);
        const float* bp = bias + mrow * 4096 + col0;
        f32x4 bb[2][2];
#pragma unroll
        for (int bj = 0; bj < 2; ++bj) { bb[bj][0] = *(const f32x4*)(bp + bj * 128); bb[bj][1] = *(const f32x4*)(bp + bj * 128 + 4); }
        asm volatile("" ::: "memory");
#pragma unroll
        for (int bj = 0; bj < 2; ++bj) { const f32x4 b0 = bb[bj][0], b1 = bb[bj][1];
#pragma unroll
            for (int ai = 0; ai < 2; ++ai)
#pragma unroll
                for (int m = 0; m < 4; ++m) {
                    f32x4 v0 = acc[ai][bj][m][0] * rstd[ai][m] + b0, v1 = acc[ai][bj][m][1] * rstd[ai][m] + b1;
                    if (ACT == 1) {
#pragma unroll
                        for (int e = 0; e < 4; ++e) { float a = fmaxf(v0[e], 0.f), b = fmaxf(v1[e], 0.f); v0[e] = a * a; v1[e] = b * b; } }
                    u32x4 w; w.x = cvtpk(v0[0], v0[1]); w.y = cvtpk(v0[2], v0[3]); w.z = cvtpk(v1[0], v1[1]); w.w = cvtpk(v1[2], v1[3]);
                    *(u32x4*)(Ou + (wr * 64 + fr + ai * 128 + m * 16) * ldc + wc * 32 + 8 * fq + bj * 128) = w; } }
    }
};
template <class Epi> DI void run_gemm_rng_(LAS unsigned char* lds, const bf16* A, const bf16* Bt, int M, int N, int K, const Epi& E, int G, int c, int lo, int hi, int tid) {
    pg8::Gemm g{A, Bt, M, N, K}; pg8::StaticOrder S; S.init(M, N, G, c); S.range(lo, hi);
    pg8::gemm_phase<Epi, pg8::StaticOrder, true, true>(lds, g, S, E, tid);
}

DI void transpose_item(const float* __restrict__ W, int ldw, int K, bf16* WT, int nblk, LAS float* scr, int item, int lane) {
    const int kb = item / nblk, nb = item - kb * nblk, k0 = 64 * kb, n0 = 32 * nb;
    float wv[32];
#pragma unroll
    for (int i = 0; i < 32; ++i) wv[i] = W[(size_t)(k0 + 2 * i + (lane >> 5)) * ldw + n0 + (lane & 31)];
#pragma unroll
    for (int i = 0; i < 32; ++i) scr[(2 * i + (lane >> 5)) * 33 + (lane & 31)] = wv[i];
    LDS_WAIT();
    const int c = lane & 7;
#pragma unroll
    for (int j = 0; j < 4; ++j) { const int n = (lane >> 3) + 8 * j; const LAS float* s = scr + (8 * c) * 33 + n;
        u32x4 o; o.x = cvtpk(s[0], s[33]); o.y = cvtpk(s[66], s[99]); o.z = cvtpk(s[132], s[165]); o.w = cvtpk(s[198], s[231]);
        *(u32x4*)(WT + (size_t)(n0 + n) * K + k0 + 8 * c) = o; }
    LDS_WAIT();
}
DI void phase_prologue(const Params& p, LAS unsigned char* lds, int tid, int lane, int wave) {
    unsigned char* ws = p.ws;
    float* MOD = (float*)(ws + WS_MOD);
    for (int item = blockIdx.x; item < 192; item += gridDim.x) {
        const int l = item / 96, cgp = item - l * 96;
        LAS float* sl = (LAS float*)lds; LAS float* part = sl + 9 * 1024;
        for (int i = tid; i < 9 * 1024; i += 512) { const int r = i >> 10, k = i & 1023; const float cv = r < 8 ? p.in[1][r * 1024 + k] : p.in[3][k]; sl[i] = cv / (1.f + __expf(-cv)); }
        __syncthreads();
        const float* aw = p.in[4] + (size_t)l * 1024 * NMODC + cgp * 64 + lane;
        float acc[9];
#pragma unroll
        for (int r = 0; r < 9; ++r) acc[r] = 0.f;
        const int kbase = wave * 128;
#pragma unroll 32
        for (int k = 0; k < 128; ++k) { const float w = aw[(size_t)(kbase + k) * NMODC];
#pragma unroll
            for (int r = 0; r < 9; ++r) acc[r] += sl[r * 1024 + kbase + k] * w; }
#pragma unroll
        for (int r = 0; r < 9; ++r) part[(wave * 9 + r) * 64 + lane] = acc[r];
        __syncthreads();
        for (int i = tid; i < 576; i += 512) { const int r = i >> 6, cl = i & 63; float s = p.in[5][l * NMODC + cgp * 64 + cl];
#pragma unroll
            for (int kg = 0; kg < 8; ++kg) s += part[(kg * 9 + r) * 64 + cl];
            MOD[(l * 9 + r) * NMODC + cgp * 64 + cl] = s; }
        __syncthreads();
    }
    { float* rss = (float*)(ws + WS_RSS); for (int i = blockIdx.x * 512 + tid; i < 3 * MTOT; i += gridDim.x * 512) rss[i] = 0.f; }
    { bf16* WG = (bf16*)(ws + WS_WG);
      for (int idx = blockIdx.x * 512 + tid; idx < 16 * 1024; idx += gridDim.x * 512) { const int g = idx & 15, k = idx >> 4;
          const float w = p.in[8][(size_t)k * AB_IN_W + 2048 + g]; const bf16 hi = f2bf(w); const bf16 lo = f2bf(w - bf2f(hi));
          WG[g * 1024 + k] = hi; WG[16 * 1024 + g * 1024 + k] = lo; } }
    LAS float* scr = (LAS float*)(lds + wave * 16384);
    const int gw = blockIdx.x * 8 + wave, NGW = gridDim.x * 8;
    constexpr int I0 = 16 * 64, I1 = 16 * 24, I2 = 16 * 32, I3 = 16 * 48, I4 = 16 * 32, I5 = 16 * 128, I6 = 64 * 32;
    constexpr int NITEMS = I0 + I1 + I2 + I3 + I4 + 2 * I5 + 2 * I6;
    for (int it = gw; it < NITEMS; it += NGW) {
        int r = it;
        if (r < I0) { transpose_item(p.in[8], AB_IN_W, 1024, (bf16*)(ws + WS_WIN0), 64, scr, r, lane); continue; } r -= I0;
        if (r < I1) { transpose_item(p.in[8] + 2064, AB_IN_W, 1024, (bf16*)(ws + WS_WIN0) + (size_t)2048 * 1024, 24, scr, r, lane); continue; } r -= I1;
        if (r < I2) { transpose_item(p.in[14], 1024, 1024, (bf16*)(ws + WS_WOUT0), 32, scr, r, lane); continue; } r -= I2;
        if (r < I3) { transpose_item(p.in[15], NIN1, 1024, (bf16*)(ws + WS_WIN1), 48, scr, r, lane); continue; } r -= I3;
        if (r < I4) { transpose_item(p.in[18], 1024, 1024, (bf16*)(ws + WS_WOUT1), 32, scr, r, lane); continue; } r -= I4;
        if (r < 2 * I5) { const int l = r / I5; r -= l * I5; transpose_item(p.in[19] + (size_t)l * 1024 * DFF, DFF, 1024, (bf16*)(ws + WS_W1) + (size_t)l * DFF * 1024, 128, scr, r, lane); continue; } r -= 2 * I5;
        { const int l = r / I6; r -= l * I6; transpose_item(p.in[20] + (size_t)l * DFF * 1024, 1024, DFF, (bf16*)(ws + WS_W2) + (size_t)l * DFF * 1024, 32, scr, r, lane); }
    }
}

DI float log_sigmoid(float x) { return -(fmaxf(-x, 0.f) + log1pf(__expf(-fabsf(x)))); }
template <bool GATES>
DI void phase_norm(const Params& p, LAS unsigned char* lds, const float* srcC, const float* srcL, const float* gn, const float* modL, int si, bf16* H,
                   int row_lo, int row_hi, int tid, int lane, int wave) {
    const int gw = blockIdx.x * 8 + wave, NGW = gridDim.x * 8;
    for (int row = row_lo + gw; row < row_hi; row += 2 * NGW) {
        const int rowB = row + NGW; const bool hasB = rowB < row_hi;
        const float* xa; const float* xb; int ma, mb;
        if (row < NCTX) { xa = srcC + (size_t)row * DM; ma = 8; } else { xa = srcL + (size_t)(row - NCTX) * DM; ma = (row - NCTX) >> 12; }
        const int rb = hasB ? rowB : row;
        if (rb < NCTX) { xb = srcC + (size_t)rb * DM; mb = 8; } else { xb = srcL + (size_t)(rb - NCTX) * DM; mb = (rb - NCTX) >> 12; }
        f32x4 va[4], vb[4]; float sa = 0.f, sb = 0.f;
#pragma unroll
        for (int j = 0; j < 4; ++j) { va[j] = ((const f32x4*)xa)[lane + 64 * j]; vb[j] = ((const f32x4*)xb)[lane + 64 * j]; }
        const float* sha = modL + ma * NMODC + si * DM; const float* shb = modL + mb * NMODC + si * DM;
        f32x4 gg[4], sca[4], tca[4], scb[4], tcb[4];
#pragma unroll
        for (int j = 0; j < 4; ++j) { gg[j] = ((const f32x4*)gn)[lane + 64 * j]; sca[j] = ((const f32x4*)(sha + DM))[lane + 64 * j]; tca[j] = ((const f32x4*)sha)[lane + 64 * j];
            scb[j] = ((const f32x4*)(shb + DM))[lane + 64 * j]; tcb[j] = ((const f32x4*)shb)[lane + 64 * j]; }
        asm volatile("" ::: "memory");
#pragma unroll
        for (int j = 0; j < 4; ++j) { sa += (va[j].x * va[j].x + va[j].y * va[j].y) + (va[j].z * va[j].z + va[j].w * va[j].w);
                                      sb += (vb[j].x * vb[j].x + vb[j].y * vb[j].y) + (vb[j].z * vb[j].z + vb[j].w * vb[j].w); }
#pragma unroll
        for (int o = 1; o < 64; o <<= 1) { sa += __shfl_xor(sa, o); sb += __shfl_xor(sb, o); }
        const float ra = rsqrtf(sa * (1.f / DM) + EPS), rbs = rsqrtf(sb * (1.f / DM) + EPS);
        bf16* ha = H + (size_t)row * DM; bf16* hb = H + (size_t)rb * DM;
#pragma unroll
        for (int j = 0; j < 4; ++j) {
            { const f32x4 v = va[j] * ra * gg[j] * (sca[j] + 1.f) + tca[j]; u32x2 o; o.x = cvtpk(v.x, v.y); o.y = cvtpk(v.z, v.w); ((u32x2*)ha)[lane + 64 * j] = o; }
            if (hasB) { const f32x4 v = vb[j] * rbs * gg[j] * (scb[j] + 1.f) + tcb[j]; u32x2 o; o.x = cvtpk(v.x, v.y); o.y = cvtpk(v.z, v.w); ((u32x2*)hb)[lane + 64 * j] = o; }
        }
    }
}

DI void phase_gates(const Params& p, LAS unsigned char* lds, const bf16* H, int tid, int lane, int wave, int bidx, int nblk) {
    constexpr int GP = 1032;
    LAS bf16* Ws = (LAS bf16*)lds;
    const bf16* WG = (const bf16*)(p.ws + WS_WG);
    __syncthreads();
    for (int i = tid; i < 32 * 128; i += 512) { const int rw = i >> 7, c = i & 127; *(LAS u32x4*)(Ws + rw * GP + c * 8) = *(const u32x4*)(WG + rw * 1024 + c * 8); }
    __syncthreads();
    float* GT = (float*)(p.ws + WS_GATES);
    const int r = lane & 31, hh = lane >> 5;
    const int gw = bidx * 8 + wave, NGW = nblk * 8;
    const float gb = p.in[9][r & 15];
    for (int tile = gw; tile < MTOT / 32; tile += NGW) {
        const int row0 = 32 * tile;
        const bf16* ap = H + (size_t)(row0 + r) * DM + 8 * hh;
        const LAS bf16* bh = Ws + (r & 15) * GP + 8 * hh; const LAS bf16* bl = bh + 16 * GP;
        f32x16 acc = zero16();
#pragma unroll 1
        for (int kg = 0; kg < 4; ++kg) { bf16x8 af[16];
#pragma unroll
            for (int q = 0; q < 16; ++q) af[q] = *(const bf16x8*)(ap + 16 * (16 * kg + q));
            asm volatile("" ::: "memory");
#pragma unroll
            for (int q = 0; q < 16; ++q) { const int ks = 16 * kg + q;
                acc = MFMA32(af[q], *(const LAS bf16x8*)(bh + 16 * ks), acc); acc = MFMA32(af[q], *(const LAS bf16x8*)(bl + 16 * ks), acc); } }
        if (r < 16) {
#pragma unroll
            for (int i = 0; i < 16; ++i) { float gv = acc[i] + gb; if ((r >> 2) & 1) gv = log_sigmoid(gv); GT[(size_t)(row0 + crow(i, hh)) * 16 + r] = gv; } }
    }
    __syncthreads();
}


DI void phase_bias(const Params& p, int lane, int wave) {
    const float* MOD = (const float*)(p.ws + WS_MOD); float* BIAS = (float*)(p.ws + WS_BIAS);
    const int gw = blockIdx.x * 8 + wave, NGW = gridDim.x * 8;
    for (int it = gw; it < 4096 + 1536 + 4096; it += NGW) {
        int which, n; const bf16* WT; const float* sh;
        if (it < 4096) { which = 0; n = it; WT = (const bf16*)(p.ws + WS_W1); sh = MOD + 3 * DM; }
        else if (it < 4096 + 1536) { which = 1; n = it - 4096; WT = (const bf16*)(p.ws + WS_WIN1); sh = MOD + 9 * NMODC; }
        else { which = 2; n = it - 4096 - 1536; WT = (const bf16*)(p.ws + WS_W1) + (size_t)DFF * DM; sh = MOD + 9 * NMODC + 3 * DM; }
        const u32x4 w0 = *(const u32x4*)(WT + (size_t)n * DM + lane * 16), w1 = *(const u32x4*)(WT + (size_t)n * DM + lane * 16 + 8);
        float wf[16];
        wf[0] = __uint_as_float(w0.x << 16); wf[1] = __uint_as_float(w0.x & 0xffff0000u); wf[2] = __uint_as_float(w0.y << 16); wf[3] = __uint_as_float(w0.y & 0xffff0000u);
        wf[4] = __uint_as_float(w0.z << 16); wf[5] = __uint_as_float(w0.z & 0xffff0000u); wf[6] = __uint_as_float(w0.w << 16); wf[7] = __uint_as_float(w0.w & 0xffff0000u);
        wf[8] = __uint_as_float(w1.x << 16); wf[9] = __uint_as_float(w1.x & 0xffff0000u); wf[10] = __uint_as_float(w1.y << 16); wf[11] = __uint_as_float(w1.y & 0xffff0000u);
        wf[12] = __uint_as_float(w1.z << 16); wf[13] = __uint_as_float(w1.z & 0xffff0000u); wf[14] = __uint_as_float(w1.w << 16); wf[15] = __uint_as_float(w1.w & 0xffff0000u);
        float mine = 0.f;
        f32x4 s4[9][4];
#pragma unroll
        for (int r = 0; r < 9; ++r)
#pragma unroll
            for (int q = 0; q < 4; ++q) s4[r][q] = *(const f32x4*)(sh + r * NMODC + lane * 16 + 4 * q);
        float av[9];
#pragma unroll
        for (int r = 0; r < 9; ++r) { float a = 0.f;
#pragma unroll
            for (int q = 0; q < 4; ++q) a += s4[r][q][0] * wf[4 * q] + s4[r][q][1] * wf[4 * q + 1] + s4[r][q][2] * wf[4 * q + 2] + s4[r][q][3] * wf[4 * q + 3];
            av[r] = a; }
#pragma unroll
        for (int o = 1; o < 64; o <<= 1) {
#pragma unroll
            for (int r = 0; r < 9; ++r) av[r] += __shfl_xor(av[r], o); }
#pragma unroll
        for (int r = 0; r < 9; ++r) if (lane == r) mine = av[r];
        if (lane < 9) BIAS[(which * 9 + lane) * 4096 + n] = mine;
    }
}


DI void phase_post1(bf16* QKV, const float* qg, const float* kg, bf16* K1, bf16* V1, int lane, int wave, int row_lo, int row_hi, int bidx, int nblk) {
    constexpr int HD = 128, PPA = 32, NH = 10, pitch = NIN1, R = 2;
    const int gw = bidx * 8 + wave, NGW = nblk * 8;
    const float gq0 = qg[lane], gq1 = qg[lane + 64], gk0 = kg[lane], gk1 = kg[lane + 64];
    const int fi = lane & (PPA - 1); const float invf = exp2f(-(float)fi * (13.287712379549449f / (float)PPA));
    for (int row0 = row_lo + gw; row0 < row_hi; row0 += R * NGW) {
        int rows[R]; bool ok[R], lat[R]; int bb[R], key[R]; float cs[R], sn[R]; bf16* base[R];
        float x1[R][NH], x2[R][NH], ss[R][NH]; bf16 vv[R][4];
#pragma unroll
        for (int q = 0; q < R; ++q) { rows[q] = row0 + q * NGW; ok[q] = rows[q] < row_hi; if (!ok[q]) rows[q] = row0;
            lat[q] = rows[q] >= NCTX; const int tt = (rows[q] - NCTX) & (SEQ - 1);
            if (lat[q]) { bb[q] = (rows[q] - NCTX) >> 12; key[q] = CTXL + tt; } else { bb[q] = rows[q] >> 8; key[q] = rows[q] & 255; }
            cs[q] = 1.f; sn[q] = 0.f;
            if (lat[q]) { const float ang = (float)(lane < PPA ? (tt >> 6) : (tt & 63)) * invf; cs[q] = __cosf(ang); sn[q] = __sinf(ang); }
            base[q] = QKV + (size_t)rows[q] * pitch;
#pragma unroll
            for (int hq = 0; hq < NH; ++hq) { x1[q][hq] = bf2f(base[q][hq * HD + lane]); x2[q][hq] = bf2f(base[q][hq * HD + lane + 64]); }
#pragma unroll
            for (int j = 0; j < 4; ++j) vv[q][j] = base[q][1280 + 64 * j + lane]; }
        asm volatile("" ::: "memory");
#pragma unroll
        for (int q = 0; q < R; ++q)
#pragma unroll
            for (int hq = 0; hq < NH; ++hq) ss[q][hq] = x1[q][hq] * x1[q][hq] + x2[q][hq] * x2[q][hq];
#pragma unroll
        for (int o = 1; o < 64; o <<= 1) {
#pragma unroll
            for (int q = 0; q < R; ++q)
#pragma unroll
                for (int hq = 0; hq < NH; ++hq) ss[q][hq] += __shfl_xor(ss[q][hq], o); }
#pragma unroll
        for (int q = 0; q < R; ++q) if (ok[q]) {
#pragma unroll
            for (int hq = 0; hq < NH; ++hq) if (hq >= 8 || lat[q]) {
                const float rs = rsqrtf(ss[q][hq] * (1.f / (float)HD) + EPS);
                const float y1 = x1[q][hq] * rs * (hq < 8 ? gq0 : gk0), y2 = x2[q][hq] * rs * (hq < 8 ? gq1 : gk1);
                bf16* dst = hq < 8 ? base[q] + hq * HD : K1 + ((size_t)(bb[q] * 2 + (hq - 8)) * KVLEN + key[q]) * HD;
                dst[lane] = f2bf(y1 * cs[q] - y2 * sn[q]); dst[lane + 64] = f2bf(y2 * cs[q] + y1 * sn[q]); }
            bf16* vd0 = V1 + ((size_t)(bb[q] * 2) * KVLEN + key[q]) * HD; bf16* vd1 = V1 + ((size_t)(bb[q] * 2 + 1) * KVLEN + key[q]) * HD;
            vd0[lane] = vv[q][0]; vd0[lane + 64] = vv[q][1]; vd1[lane] = vv[q][2]; vd1[lane + 64] = vv[q][3]; }
    }
}

template <int HD>
DI void phase_post(bf16* QKV, int pitch, int qcol, int nq, int kcol, int nk, int vcol, const float* qg, const float* kg, bf16* VT, bool q_for_ctx,
                   LAS unsigned char* lds, int tid, int lane, int wave, int row_lo = 0, int row_hi = MTOT, int tile_lo = 0, int tile_hi = MTOT / 64) {
    constexpr int PPA = HD / 4, NH = 10, R = 2;
    const int gw = blockIdx.x * 8 + wave, NGW = gridDim.x * 8;
    float gq0, gq1 = 0.f, gk0, gk1 = 0.f;
    gq0 = qg[lane]; gk0 = kg[lane]; if (HD == 128) { gq1 = qg[lane + 64]; gk1 = kg[lane + 64]; }
    const int jj = (HD == 64) ? (lane & 31) : lane;
    const float invf = exp2f(-(float)(jj & (PPA - 1)) * (13.287712379549449f / (float)PPA));
    for (int row0 = row_lo + gw; row0 < row_hi; row0 += R * NGW) {
        int rows[R]; bool ok[R], lat[R]; int h0[R]; float cs[R], sn[R]; bf16* base[R];
        float x1[R][NH], x2[R][NH], ss[R][NH];
#pragma unroll
        for (int q = 0; q < R; ++q) { rows[q] = row0 + q * NGW; ok[q] = rows[q] < row_hi; if (!ok[q]) rows[q] = row0;
            lat[q] = rows[q] >= NCTX; const int tt = (rows[q] - NCTX) & (SEQ - 1);
            cs[q] = 1.f; sn[q] = 0.f;
            if (lat[q]) { const float ang = (float)(jj < PPA ? (tt >> 6) : (tt & 63)) * invf; cs[q] = __cosf(ang); sn[q] = __sinf(ang); }
            h0[q] = (lat[q] || q_for_ctx) ? 0 : nq;
            base[q] = QKV + (size_t)rows[q] * pitch + qcol;
#pragma unroll
            for (int hq = 0; hq < NH; ++hq) { x1[q][hq] = bf2f(base[q][hq * HD + lane]); x2[q][hq] = 0.f; if (HD == 128) x2[q][hq] = bf2f(base[q][hq * HD + lane + 64]); } }
        asm volatile("" ::: "memory");
#pragma unroll
        for (int q = 0; q < R; ++q)
#pragma unroll
            for (int hq = 0; hq < NH; ++hq) ss[q][hq] = x1[q][hq] * x1[q][hq] + x2[q][hq] * x2[q][hq];
#pragma unroll
        for (int o = 1; o < 64; o <<= 1) {
#pragma unroll
            for (int q = 0; q < R; ++q)
#pragma unroll
                for (int hq = 0; hq < NH; ++hq) ss[q][hq] += __shfl_xor(ss[q][hq], o); }
#pragma unroll
        for (int q = 0; q < R; ++q) {
#pragma unroll
            for (int hq = 0; hq < NH; ++hq) if (hq >= h0[q]) {
                const float rs = rsqrtf(ss[q][hq] * (1.f / (float)HD) + EPS);
                if (HD == 64) { const float y = x1[q][hq] * rs * (hq < 8 ? gq0 : gk0); const float pr = __shfl_xor(y, 32);
                    if (ok[q]) base[q][hq * HD + lane] = f2bf(lane < 32 ? y * cs[q] - pr * sn[q] : y * cs[q] + pr * sn[q]); }
                else { const float y1 = x1[q][hq] * rs * (hq < 8 ? gq0 : gk0), y2 = x2[q][hq] * rs * (hq < 8 ? gq1 : gk1);
                    if (ok[q]) { base[q][hq * HD + lane] = f2bf(y1 * cs[q] - y2 * sn[q]); base[q][hq * HD + lane + 64] = f2bf(y2 * cs[q] + y1 * sn[q]); } }
            } }
    }
    constexpr int NV = 2 * HD, TP = NV + 2;
    LAS bf16* tile = (LAS bf16*)lds;
    for (int tk = tile_lo + blockIdx.x; tk < tile_hi; tk += gridDim.x) {
        const int row0 = 64 * tk; int b, key0;
        if (row0 < NCTX) { b = row0 >> 8; key0 = row0 & 255; } else { const int lr = row0 - NCTX; b = lr >> 12; key0 = 256 + (lr & 4095); }
        { constexpr int NIT = 64 * NV / 512; bf16 tv[NIT];
#pragma unroll
          for (int i = 0; i < NIT; ++i) { const int idx = tid + 512 * i, tok = idx / NV, c = idx - tok * NV; tv[i] = QKV[(size_t)(row0 + tok) * pitch + vcol + c]; }
#pragma unroll
          for (int i = 0; i < NIT; ++i) { const int idx = tid + 512 * i, tok = idx / NV, c = idx - tok * NV; tile[tok * TP + c] = tv[i]; } }
        __syncthreads();
        for (int idx = tid; idx < 64 * NV; idx += 512) { const int rr = idx >> 6, key = idx & 63; VT[(size_t)(b * NV + rr) * KVLEN + key0 + key] = tile[key * TP + rr]; }
        __syncthreads();
    }
}

constexpr int MP = 136;
constexpr int ML_VT = 0, ML_VWT = 40 * MP * 2, ML_CT = 2 * 40 * MP * 2, ML_Q = 3 * 40 * MP * 2, ML_K = ML_Q + 128 * MP * 2, ML_KT = ML_K + 128 * MP * 2, ML_SC = ML_KT + 128 * MP * 2;
static_assert(ML_SC + 5120 <= LDS_BYTES, "mLSTM LDS map");
DI void mlstm_item(const Params& p, LAS unsigned char* lds, int item, int tid, int lane, int wave) {
    const int dvq = item & 3, dir = (item >> 2) & 1, head = (item >> 3) & 3, b = item >> 5;
    const bf16* QKV = (const bf16*)(p.ws + WS_BIG); const float* GT = (const float*)(p.ws + WS_GATES);
    float* XC = (float*)(p.ws + WS_XC);
    LAS bf16* VTs = (LAS bf16*)(lds + ML_VT); LAS bf16* VWTs = (LAS bf16*)(lds + ML_VWT); LAS bf16* CTs = (LAS bf16*)(lds + ML_CT);
    LAS bf16* Qs = (LAS bf16*)(lds + ML_Q); LAS bf16* Ks = (LAS bf16*)(lds + ML_K); LAS bf16* KTs = (LAS bf16*)(lds + ML_KT); LAS bf16* Ss = Ks;
    LAS float* sc = (LAS float*)(lds + ML_SC);
    LAS float* s_ic = sc; LAS float* s_fc = sc + 128; LAS float* s_a = sc + 256; LAS float* s_rt = sc + 384; LAS float* s_iw = sc + 512;
    LAS float* s_w = sc + 640; LAS float* s_emt = sc + 768; LAS float* s_den = sc + 896; LAS float* s_misc = sc + 1024;
    const int r = lane & 31, h = lane >> 5, ti = wave >> 1, tj = wave & 1;
    const float KSCALE = 0.08838834764831845f;
    for (int i = tid; i < 40 * MP; i += 512) CTs[i] = 0;
    if (tid < 128) VTs[32 * MP + tid] = 0x3F80;
    f32x16 accC = zero16(); float m = 0.f;
    __syncthreads();
    for (int ci = 0; ci < 34; ++ci) {
        int base;
        if (ci < 2) { const int cc = dir ? 1 - ci : ci; base = b * 256 + cc * 128; }
        else { const int cc = dir ? 31 - (ci - 2) : (ci - 2); base = NCTX + b * 4096 + cc * 128; }
#pragma unroll
        for (int i = 0; i < 4; ++i) { const int id = tid + 512 * i, rr = id >> 4, c = id & 15; const size_t grow = base + (dir ? 127 - rr : rr);
            const bf16* src = QKV + grow * NIN0 + head * 128 + c * 8;
            *(LAS u32x4*)(Qs + rr * MP + c * 8) = *(const u32x4*)src; *(LAS u32x4*)(Ks + rr * MP + c * 8) = *(const u32x4*)(src + 512); }
        { const int rr = tid >> 2, c = tid & 3; const size_t grow = base + (dir ? 127 - rr : rr);
            const u32x4 v = *(const u32x4*)(QKV + grow * NIN0 + 1024 + head * 128 + dvq * 32 + c * 8);
            LAS bf16* d = VTs + (c * 8) * MP + rr;
            d[0] = (bf16)(v.x & 0xffffu); d[MP] = (bf16)(v.x >> 16); d[2 * MP] = (bf16)(v.y & 0xffffu); d[3 * MP] = (bf16)(v.y >> 16);
            d[4 * MP] = (bf16)(v.z & 0xffffu); d[5 * MP] = (bf16)(v.z >> 16); d[6 * MP] = (bf16)(v.w & 0xffffu); d[7 * MP] = (bf16)(v.w >> 16); }
        if (tid < 256) { const int rr = tid & 127; const size_t grow = base + (dir ? 127 - rr : rr); const int gi = (dir ? 2 : 0) + (tid >> 7);
            const float gv = GT[grow * 16 + gi * 4 + head]; if (tid < 128) s_ic[rr] = gv; else s_fc[rr] = gv; }
        __syncthreads();
        { const int d = tid & 127, sg = tid >> 7;
#pragma unroll
            for (int s8 = 0; s8 < 4; ++s8) { const LAS bf16* kp = Ks + (32 * sg + 8 * s8) * MP + d;
                u32x4 o; o.x = (unsigned)kp[0] | ((unsigned)kp[MP] << 16); o.y = (unsigned)kp[2 * MP] | ((unsigned)kp[3 * MP] << 16);
                o.z = (unsigned)kp[4 * MP] | ((unsigned)kp[5 * MP] << 16); o.w = (unsigned)kp[6 * MP] | ((unsigned)kp[7 * MP] << 16);
                *(LAS u32x4*)(KTs + d * MP + 32 * sg + 8 * s8) = o; } }
        if (wave == 0) {
            const float f0 = s_fc[2 * lane], f1 = s_fc[2 * lane + 1], i0 = s_ic[2 * lane], i1 = s_ic[2 * lane + 1];
            float S = f0 + f1;
#pragma unroll
            for (int o = 1; o < 64; o <<= 1) { const float t = __shfl_up(S, o); if (lane >= o) S += t; }
            const float bc1 = S, bc0 = S - f1, a0 = i0 - bc0, a1 = i1 - bc1;
            float P = fmaxf(a0, a1);
#pragma unroll
            for (int o = 1; o < 64; o <<= 1) { const float t = __shfl_up(P, o); if (lane >= o) P = fmaxf(P, t); }
            float Pex = __shfl_up(P, 1); if (lane == 0) Pex = -INFINITY;
            const float pm0 = fmaxf(Pex, a0), pm1 = P;
            const float blast = __shfl(bc1, 63), Mall = __shfl(P, 63);
            const float mnew = blast + fmaxf(m, Mall);
            const float rt0 = -fmaxf(m, pm0), rt1 = -fmaxf(m, pm1);
            s_a[2 * lane] = a0; s_a[2 * lane + 1] = a1; s_rt[2 * lane] = rt0; s_rt[2 * lane + 1] = rt1;
            s_iw[2 * lane] = __expf(m + rt0); s_iw[2 * lane + 1] = __expf(m + rt1);
            s_w[2 * lane] = __expf(a0 + blast - mnew) * KSCALE; s_w[2 * lane + 1] = __expf(a1 + blast - mnew) * KSCALE;
            s_emt[2 * lane] = __expf(rt0 - bc0); s_emt[2 * lane + 1] = __expf(rt1 - bc1);
            if (lane == 0) { s_misc[0] = __expf(blast + m - mnew); s_misc[1] = mnew; }
        }
        __syncthreads();
        const float carry = s_misc[0], mnew = s_misc[1];
        for (int idx = tid; idx < 33 * 128; idx += 512) { const int e = idx >> 7, s = idx & 127; VWTs[e * MP + s] = f2bf(bf2f(VTs[e * MP + s]) * s_w[s]); }
        float sv[2][16];
#pragma unroll
        for (int tt = 0; tt < 2; ++tt) { const int tjs = (wave & 1) * 2 + tt;
            if (tjs <= ti) { f32x16 acc = zero16(); mma32(acc, Qs + 32 * ti * MP, MP, Ks + 32 * tjs * MP, MP, 128, lane);
                const int scol = 32 * tjs + r; const float as = s_a[scol];
#pragma unroll
                for (int i = 0; i < 16; ++i) { const int trow = 32 * ti + crow(i, h); const float e = (scol <= trow) ? __expf(as + s_rt[trow]) : 0.f; sv[tt][i] = acc[i] * KSCALE * e; } } }
        __syncthreads();
#pragma unroll
        for (int tt = 0; tt < 2; ++tt) { const int tjs = (wave & 1) * 2 + tt;
            if (tjs <= ti) { const int scol = 32 * tjs + r;
#pragma unroll
                for (int i = 0; i < 16; ++i) Ss[(32 * ti + crow(i, h)) * MP + scol] = f2bf(sv[tt][i]); } }
        __syncthreads();
        f32x16 a1 = zero16(), a2 = zero16(), up = zero16();
        mma32(a1, Qs + 32 * ti * MP, MP, CTs + 32 * tj * MP, MP, 128, lane);
        mma32(a2, Ss + 32 * ti * MP, MP, VTs + 32 * tj * MP, MP, 32 * (ti + 1), lane);
        float num[16];
#pragma unroll
        for (int i = 0; i < 16; ++i) num[i] = s_iw[32 * ti + crow(i, h)] * a1[i] + a2[i];
        if (tj == 1 && r == 0) {
#pragma unroll
            for (int i = 0; i < 16; ++i) s_den[32 * ti + crow(i, h)] = num[i]; }
        mma32(up, KTs + 32 * ti * MP, MP, VWTs + 32 * tj * MP, MP, 128, lane);
#pragma unroll
        for (int i = 0; i < 16; ++i) accC[i] = carry * accC[i] + up[i];
        __syncthreads();
        if (tj == 0) {
#pragma unroll
            for (int i = 0; i < 16; ++i) { const int trow = 32 * ti + crow(i, h); const float hv = num[i] / fmaxf(fabsf(s_den[trow]), s_emt[trow]);
                const int grow = base + (dir ? 127 - trow : trow);
                float* dst = grow < NCTX ? XC + (size_t)grow * DM : p.out + (size_t)(grow - NCTX) * DM;
                dst[dir * 512 + head * 128 + dvq * 32 + r] = hv; } }
        if (tj == 0 || r == 0) {
#pragma unroll
            for (int g = 0; g < 4; ++g) { u32x2 o; o.x = cvtpk(accC[4 * g], accC[4 * g + 1]); o.y = cvtpk(accC[4 * g + 2], accC[4 * g + 3]);
                *(LAS u32x2*)(CTs + (32 * tj + r) * MP + 32 * ti + 8 * g + 4 * h) = o; } }
        m = mnew;
    }
    __syncthreads();
}


constexpr int NCH = 34, UROWS = 129;
constexpr size_t WS_MSC = WS_GATES + 2560 * 1024;
DI int chunk_base(int b, int cp) { return cp < 2 ? b * CTXL + cp * 128 : NCTX + b * SEQ + (cp - 2) * 128; }
DI float shfl_up_l(float v, int o, int lane) { return __int_as_float(__builtin_amdgcn_ds_bpermute((lane >= o ? lane - o : lane) << 2, __float_as_int(v))); }
DI void chunk_scan(int dir, const LAS float* ic, const LAS float* fc, int lane, float& a0, float& a1, float& pm0, float& pm1, float& bc0, float& bc1, float& blast, float& Mall, int& u0, int& u1) {
    u0 = dir ? 127 - 2 * lane : 2 * lane; u1 = dir ? u0 - 1 : u0 + 1;
    const float f0 = fc[u0], f1 = fc[u1], i0 = ic[u0], i1 = ic[u1];
    float S = f0 + f1;
#pragma unroll
    for (int o = 1; o < 64; o <<= 1) { const float t = shfl_up_l(S, o, lane); if (lane >= o) S += t; }
    bc1 = S; bc0 = S - f1; a0 = i0 - bc0; a1 = i1 - bc1;
    float P = fmaxf(a0, a1);
#pragma unroll
    for (int o = 1; o < 64; o <<= 1) { const float t = shfl_up_l(P, o, lane); if (lane >= o) P = fmaxf(P, t); }
    float Pex = shfl_up_l(P, 1, lane); if (lane == 0) Pex = -INFINITY;
    pm0 = fmaxf(Pex, a0); pm1 = P;
    blast = __int_as_float(__builtin_amdgcn_readlane(__float_as_int(bc1), 63)); Mall = __int_as_float(__builtin_amdgcn_readlane(__float_as_int(P), 63));
}
constexpr int X_VT = 0, X_VWT = UROWS * MP * 2, X_KT = 2 * UROWS * MP * 2, X_SC = X_KT + 128 * MP * 2;
DI void mlstm_x1(const Params& p, LAS unsigned char* lds, int item, int tid_in, int lane_in, int wave) {
    int tid = tid_in; asm volatile("" : "+v"(tid)); const int lane = tid & 63; (void)lane_in;
    const int cp = item % NCH, head = (item / NCH) & 3, b = item / (NCH * 4);
    const bf16* QKV = (const bf16*)(p.ws + WS_BIG); const float* GT = (const float*)(p.ws + WS_GATES);
    bf16* UT = (bf16*)p.out; float* SC = (float*)(p.ws + WS_MSC);
    LAS bf16* VTs = (LAS bf16*)(lds + X_VT); LAS bf16* VWTs = (LAS bf16*)(lds + X_VWT); LAS bf16* KTs = (LAS bf16*)(lds + X_KT);
    LAS float* sc = (LAS float*)(lds + X_SC);
    LAS float* s_w = sc + 512;
    const int base = chunk_base(b, cp);
    const int r = lane & 31, h = lane >> 5;
    const float KSCALE = 0.08838834764831845f;
    __syncthreads();
#pragma unroll
    for (int i = 0; i < 4; ++i) { const int id = tid + 512 * i, rr = id & 127, c = id >> 7;
        const bf16* src = QKV + (size_t)(base + rr) * NIN0 + head * 128 + c * 8;
        const u32x4 k = *(const u32x4*)(src + 512), v = *(const u32x4*)(src + 1024);
        LAS bf16* dk = KTs + (c * 8) * MP + rr; LAS bf16* dv = VTs + (c * 8) * MP + rr;
        dk[0] = (bf16)(k.x & 0xffffu); dk[MP] = (bf16)(k.x >> 16); dk[2 * MP] = (bf16)(k.y & 0xffffu); dk[3 * MP] = (bf16)(k.y >> 16);
        dk[4 * MP] = (bf16)(k.z & 0xffffu); dk[5 * MP] = (bf16)(k.z >> 16); dk[6 * MP] = (bf16)(k.w & 0xffffu); dk[7 * MP] = (bf16)(k.w >> 16);
        dv[0] = (bf16)(v.x & 0xffffu); dv[MP] = (bf16)(v.x >> 16); dv[2 * MP] = (bf16)(v.y & 0xffffu); dv[3 * MP] = (bf16)(v.y >> 16);
        dv[4 * MP] = (bf16)(v.z & 0xffffu); dv[5 * MP] = (bf16)(v.z >> 16); dv[6 * MP] = (bf16)(v.w & 0xffffu); dv[7 * MP] = (bf16)(v.w >> 16); }
    { const int u = tid & 127, gi = tid >> 7; sc[gi * 128 + u] = GT[(size_t)(base + u) * 16 + gi * 4 + head]; }
    __syncthreads();
    if (wave < 2) { const int dir = wave; float a0, a1, pm0, pm1, bc0, bc1, blast, Mall; int u0, u1;
        chunk_scan(dir, sc + dir * 256, sc + dir * 256 + 128, lane, a0, a1, pm0, pm1, bc0, bc1, blast, Mall, u0, u1);
        s_w[dir * 128 + u0] = __expf(a0 - Mall) * KSCALE; s_w[dir * 128 + u1] = __expf(a1 - Mall) * KSCALE;
        if (lane == 0) { float* o = SC + ((size_t)((b * 4 + head) * 2 + dir) * NCH + cp) * 2; o[0] = blast; o[1] = Mall; } }
    __syncthreads();
    for (int dir = 0; dir < 2; ++dir) {
        for (int idx = tid; idx < UROWS * 16; idx += 512) { const int e = idx >> 4, c8 = (idx & 15) * 8;
            const u32x4 v = e < 128 ? *(const LAS u32x4*)(VTs + e * MP + c8) : (u32x4){0x3F803F80u, 0x3F803F80u, 0x3F803F80u, 0x3F803F80u};
            const f32x4 w0 = *(const LAS f32x4*)(s_w + dir * 128 + c8), w1 = *(const LAS f32x4*)(s_w + dir * 128 + c8 + 4);
            u32x4 o; o.x = cvtpk(__uint_as_float(v.x << 16) * w0[0], __uint_as_float(v.x & 0xffff0000u) * w0[1]); o.y = cvtpk(__uint_as_float(v.y << 16) * w0[2], __uint_as_float(v.y & 0xffff0000u) * w0[3]);
            o.z = cvtpk(__uint_as_float(v.z << 16) * w1[0], __uint_as_float(v.z & 0xffff0000u) * w1[1]); o.w = cvtpk(__uint_as_float(v.w << 16) * w1[2], __uint_as_float(v.w & 0xffff0000u) * w1[3]);
            *(LAS u32x4*)(VWTs + e * MP + c8) = o; }
        __syncthreads();
        bf16* Uo = UT + ((size_t)((b * 4 + head) * 2 + dir) * NCH + cp) * (UROWS * 128);
        for (int tile = wave; tile < 20; tile += 8) { const int td = tile & 3, te = tile >> 2;
            f32x16 acc = zero16();
            const LAS bf16* bp = VWTs + (te < 4 ? (32 * te + r) : 128) * MP + 8 * h; const LAS bf16* ap = KTs + (32 * td + r) * MP + 8 * h;
#pragma unroll
            for (int k0 = 0; k0 < 128; k0 += 16) acc = MFMA32(*(const LAS bf16x8*)(ap + k0), *(const LAS bf16x8*)(bp + k0), acc);
            if (te < 4 || r == 0) { bf16* dst = Uo + (size_t)(te < 4 ? 32 * te + r : 128) * 128 + 32 * td + 4 * h;
#pragma unroll
                for (int g = 0; g < 4; ++g) { u32x2 o; o.x = cvtpk(acc[4 * g], acc[4 * g + 1]); o.y = cvtpk(acc[4 * g + 2], acc[4 * g + 3]); *(u32x2*)(dst + 8 * g) = o; } } }
        __syncthreads();
    }
}
DI void mlstm_x2(const Params& p, int tid) {
    const bf16* __restrict__ UT = (const bf16*)p.out; const float* __restrict__ SC = (const float*)(p.ws + WS_MSC); float* __restrict__ MST = (float*)(p.ws + WS_MSC) + 64 * NCH * 2;
    bf16* __restrict__ CT = (bf16*)(p.ws + WS_BIG) + (size_t)MTOT * NIN0;
    constexpr int SZ = UROWS * 128;
    for (int item = blockIdx.x; item < 256; item += gridDim.x) {
        const int chain = item >> 2, part = item & 3, dir = chain & 1;
        const int g1 = part * 512 + tid; const bool has2 = (part == 0) && (tid < 16); const int g2 = 2048 + (tid & 15);
        float c[8], c2[8];
#pragma unroll
        for (int j = 0; j < 8; ++j) { c[j] = 0.f; c2[j] = 0.f; }
        float m = 0.f;
        const size_t cb = (size_t)chain * NCH;
#pragma unroll 1
        for (int half = 0; half < 2; ++half) {
            u32x4 uv[17], uw[17]; f32x2 scv[17];
#pragma unroll
            for (int j = 0; j < 17; ++j) { const int ci = half * 17 + j, cp = dir ? (ci < 2 ? 1 - ci : 35 - ci) : ci;
                uv[j] = *(const u32x4*)(UT + (cb + cp) * SZ + g1 * 8);
                uw[j] = has2 ? *(const u32x4*)(UT + (cb + cp) * SZ + g2 * 8) : (u32x4){0u, 0u, 0u, 0u};
                scv[j] = *(const f32x2*)(SC + (cb + cp) * 2); }
            asm volatile("" ::: "memory");
#pragma unroll
            for (int j = 0; j < 17; ++j) { const int ci = half * 17 + j, cp = dir ? (ci < 2 ? 1 - ci : 35 - ci) : ci;
                const float blast = scv[j].x, Mall = scv[j].y;
                u32x4 o; o.x = cvtpk(c[0], c[1]); o.y = cvtpk(c[2], c[3]); o.z = cvtpk(c[4], c[5]); o.w = cvtpk(c[6], c[7]);
                *(u32x4*)(CT + (cb + cp) * SZ + g1 * 8) = o;
                if (has2) { u32x4 o2; o2.x = cvtpk(c2[0], c2[1]); o2.y = cvtpk(c2[2], c2[3]); o2.z = cvtpk(c2[4], c2[5]); o2.w = cvtpk(c2[6], c2[7]); *(u32x4*)(CT + (cb + cp) * SZ + g2 * 8) = o2; }
                if (part == 0 && tid == 0) MST[cb + cp] = m;
                const float mnew = blast + fmaxf(m, Mall), cw = __expf(blast + m - mnew), uwt = __expf(blast + Mall - mnew);
                const u32x4 a = uv[j], b2 = uw[j];
                c[0] = cw * c[0] + uwt * __uint_as_float(a.x << 16); c[1] = cw * c[1] + uwt * __uint_as_float(a.x & 0xffff0000u);
                c[2] = cw * c[2] + uwt * __uint_as_float(a.y << 16); c[3] = cw * c[3] + uwt * __uint_as_float(a.y & 0xffff0000u);
                c[4] = cw * c[4] + uwt * __uint_as_float(a.z << 16); c[5] = cw * c[5] + uwt * __uint_as_float(a.z & 0xffff0000u);
                c[6] = cw * c[6] + uwt * __uint_as_float(a.w << 16); c[7] = cw * c[7] + uwt * __uint_as_float(a.w & 0xffff0000u);
                c2[0] = cw * c2[0] + uwt * __uint_as_float(b2.x << 16); c2[1] = cw * c2[1] + uwt * __uint_as_float(b2.x & 0xffff0000u);
                c2[2] = cw * c2[2] + uwt * __uint_as_float(b2.y << 16); c2[3] = cw * c2[3] + uwt * __uint_as_float(b2.y & 0xffff0000u);
                c2[4] = cw * c2[4] + uwt * __uint_as_float(b2.z << 16); c2[5] = cw * c2[5] + uwt * __uint_as_float(b2.z & 0xffff0000u);
                c2[6] = cw * c2[6] + uwt * __uint_as_float(b2.w << 16); c2[7] = cw * c2[7] + uwt * __uint_as_float(b2.w & 0xffff0000u);
                m = mnew; }
        }
    }
}
constexpr int Y_VT = 0, Y_S = UROWS * MP * 2, Y_C = Y_S + 128 * MP * 2, Y_SC = Y_C + 2 * UROWS * MP * 2;
static_assert(Y_SC + 7168 <= LDS_BYTES - 16, "X3 LDS map");
DI void mlstm_x3(const Params& p, LAS unsigned char* lds, int item, int tid_in, int lane_in, int wave) {
    (void)tid_in; (void)lane_in;
    int tid = wave * 64 + fresh_lane(); asm volatile("" : "+v"(tid)); const int lane = tid & 63;
    const int cp = item % NCH, head = (item / NCH) & 3, b = item / (NCH * 4);
    const bf16* QKV = (const bf16*)(p.ws + WS_BIG); const float* GT = (const float*)(p.ws + WS_GATES);
    const float* MST = (const float*)(p.ws + WS_MSC) + 64 * NCH * 2;
    const bf16* CT = (const bf16*)(p.ws + WS_BIG) + (size_t)MTOT * NIN0;
    bf16* OC = (bf16*)(p.ws + WS_OCAT);
    { size_t z0 = 0; asm volatile("" : "+s"(z0)); QKV += z0; CT += z0; OC += z0; GT += z0; }
    LAS bf16* VTs = (LAS bf16*)(lds + Y_VT); LAS bf16* Ss = (LAS bf16*)(lds + Y_S);
    LAS float* sc = (LAS float*)(lds + Y_SC);
    LAS float* s_dir = sc + 512; LAS float* s_ssq = sc + 512 + 1024;
    LAS bf16* Cs = (LAS bf16*)(lds + Y_C);
    const int base = chunk_base(b, cp);
    const int r_ = lane & 31, h = lane >> 5, ti = wave >> 1, eh = wave & 1;
    const float KSCALE = 0.08838834764831845f;
    __syncthreads();
    const float mst0 = MST[(size_t)((b * 4 + head) * 2) * NCH + cp], mst1 = MST[(size_t)((b * 4 + head) * 2 + 1) * NCH + cp];
    u32x4 vr[4];
#pragma unroll
    for (int i = 0; i < 4; ++i) { const int id = tid + 512 * i, rr = id & 127, c = id >> 7; vr[i] = *(const u32x4*)(QKV + (size_t)(base + rr) * NIN0 + 1024 + head * 128 + c * 8); }
    const float gval = GT[(size_t)(base + (tid & 127)) * 16 + (tid >> 7) * 4 + head];
    u32x4 cb[9];
    { const bf16* C0 = CT + ((size_t)((b * 4 + head) * 2) * NCH + cp) * (UROWS * 128);
#pragma unroll
      for (int i = 0; i < 9; ++i) { const int id = tid + 512 * i; const int idc = id < 2 * UROWS * 16 ? id : 0; const int dd = idc >= UROWS * 16, q = idc - dd * UROWS * 16;
          cb[i] = *(const u32x4*)(C0 + (size_t)dd * NCH * (UROWS * 128) + q * 8); } }
    bf16x8 qf[8], kf[2][8];
    { const bf16* qp = QKV + (size_t)(base + 32 * ti + r_) * NIN0 + head * 128 + 8 * h;
#pragma unroll
        for (int ks = 0; ks < 8; ++ks) qf[ks] = *(const bf16x8*)(qp + 16 * ks); }
#pragma unroll
    for (int tt = 0; tt < 2; ++tt) { const bf16* kp = QKV + (size_t)(base + 32 * (2 * eh + tt) + r_) * NIN0 + 512 + head * 128 + 8 * h;
#pragma unroll
        for (int ks = 0; ks < 8; ++ks) kf[tt][ks] = *(const bf16x8*)(kp + 16 * ks); }
    asm volatile("" ::: "memory");
#pragma unroll
    for (int i = 0; i < 4; ++i) { const int id = tid + 512 * i, rr = id & 127, c = id >> 7; const u32x4 v = vr[i];
        LAS bf16* dv = VTs + (c * 8) * MP + rr;
        dv[0] = (bf16)(v.x & 0xffffu); dv[MP] = (bf16)(v.x >> 16); dv[2 * MP] = (bf16)(v.y & 0xffffu); dv[3 * MP] = (bf16)(v.y >> 16);
        dv[4 * MP] = (bf16)(v.z & 0xffffu); dv[5 * MP] = (bf16)(v.z >> 16); dv[6 * MP] = (bf16)(v.w & 0xffffu); dv[7 * MP] = (bf16)(v.w >> 16); }
    if (tid < 128) VTs[128 * MP + tid] = 0x3F80;
    sc[(tid >> 7) * 128 + (tid & 127)] = gval;
#pragma unroll
    for (int i = 0; i < 9; ++i) { const int id = tid + 512 * i; if (id < 2 * UROWS * 16) { const int dd = id >= UROWS * 16, q = id - dd * UROWS * 16, e = q >> 4, c8 = (q & 15) * 8;
        *(LAS u32x4*)(Cs + (dd * UROWS + e) * MP + c8) = cb[i]; } }
    unsigned spk[2][8];
#pragma unroll
    for (int tt = 0; tt < 2; ++tt) { f32x16 sraw = zero16();
#pragma unroll
        for (int ks = 0; ks < 8; ++ks) sraw = MFMA32(qf[ks], kf[tt][ks], sraw);
#pragma unroll
        for (int i = 0; i < 8; ++i) spk[tt][i] = cvtpk(sraw[2 * i], sraw[2 * i + 1]); }
    __syncthreads();
    if (wave < 2) { const int dir = wave; float a0, a1, pm0, pm1, bc0, bc1, blast, Mall; int u0, u1;
        chunk_scan(dir, sc + dir * 256, sc + dir * 256 + 128, lane, a0, a1, pm0, pm1, bc0, bc1, blast, Mall, u0, u1);
        const float m = dir ? mst1 : mst0;
        const float rt0 = -fmaxf(m, pm0), rt1 = -fmaxf(m, pm1);
        LAS float* d = s_dir + dir * 512;
        d[u0] = a0; d[u1] = a1; d[128 + u0] = rt0; d[128 + u1] = rt1; d[256 + u0] = __expf(m + rt0); d[256 + u1] = __expf(m + rt1);
        d[384 + u0] = __expf(rt0 - bc0); d[384 + u1] = __expf(rt1 - bc1); }
    f32x16 hs[2]; hs[0] = zero16(); hs[1] = zero16();
#pragma unroll 1
    for (int dir = 0; dir < 2; ++dir) {
        __syncthreads();
        const LAS float* d = s_dir + dir * 512;
        int r = r_; asm volatile("" : "+v"(r));
#pragma unroll
        for (int tt = 0; tt < 2; ++tt) { const int tj = 2 * eh + tt; const bool need = dir ? (tj >= ti) : (tj <= ti);
            if (need) {
                const int scol = 32 * tj + r; const float as = d[scol];
#pragma unroll
                for (int i = 0; i < 16; ++i) { const int trow = 32 * ti + crow(i, h); const bool ok = dir ? (scol >= trow) : (scol <= trow);
                    const float e = ok ? __expf(as + d[128 + trow]) * KSCALE : 0.f;
                    const float sv = (i & 1) ? __uint_as_float(spk[tt][i >> 1] & 0xffff0000u) : __uint_as_float(spk[tt][i >> 1] << 16); Ss[trow * MP + scol] = f2bf(sv * e); } } }
        __syncthreads();
        asm volatile("" ::: "memory");
        const LAS bf16* Cb = Cs + dir * UROWS * MP;
        const int klo = dir ? 32 * ti : 0, khi = dir ? 128 : 32 * (ti + 1);
        const LAS bf16* sp = Ss + (32 * ti + r) * MP + 8 * h;
        {
            f32x16 a1 = zero16(), a2 = zero16();
            const LAS bf16* cpp = Cb + 128 * MP + 8 * h;
#pragma unroll
            for (int ks = 0; ks < 8; ++ks) a1 = MFMA32(qf[ks], *(const LAS bf16x8*)(cpp + 16 * ks), a1);
            const LAS bf16* vp = VTs + 128 * MP + 8 * h;
#pragma unroll 1
            for (int k0 = klo; k0 < khi; k0 += 16) a2 = MFMA32(*(const LAS bf16x8*)(sp + k0), *(const LAS bf16x8*)(vp + k0), a2);
            if (r == 0) {
#pragma unroll
            for (int i = 0; i < 16; ++i) { const int trow = 32 * ti + crow(i, h); sc[trow] = 1.f / fmaxf(fabsf(d[256 + trow] * a1[i] + a2[i]), d[384 + trow]); } }
        }
        asm volatile("" ::: "memory");
#pragma unroll
        for (int tt = 0; tt < 2; ++tt) { const int te = 2 * eh + tt;
            f32x16 a1 = zero16(), a2 = zero16();
            const LAS bf16* cpp = Cb + (32 * te + r) * MP + 8 * h;
#pragma unroll
            for (int ks = 0; ks < 8; ++ks) a1 = MFMA32(qf[ks], *(const LAS bf16x8*)(cpp + 16 * ks), a1);
            const LAS bf16* vp = VTs + (32 * te + r) * MP + 8 * h;
#pragma unroll 1
            for (int k0 = klo; k0 < khi; k0 += 16) a2 = MFMA32(*(const LAS bf16x8*)(sp + k0), *(const LAS bf16x8*)(vp + k0), a2);
#pragma unroll
            for (int i = 0; i < 16; ++i) { const int trow = 32 * ti + crow(i, h); hs[tt][i] += (d[256 + trow] * a1[i] + a2[i]) * sc[trow]; }
            asm volatile("" ::: "memory"); }
    }
#pragma unroll
    for (int i = 0; i < 16; ++i) { float q = hs[0][i] * hs[0][i] + hs[1][i] * hs[1][i];
#pragma unroll
        for (int o = 1; o < 32; o <<= 1) q += __int_as_float(__builtin_amdgcn_ds_bpermute((lane ^ o) << 2, __float_as_int(q)));
        if (r_ == 0) s_ssq[(32 * ti + crow(i, h)) * 2 + eh] = q; }
    __syncthreads();
    LAS float* Hs = (LAS float*)(lds + Y_C);
#pragma unroll
    for (int i = 0; i < 16; ++i) { const int trow = 32 * ti + crow(i, h);
        const float rs = rsqrtf((s_ssq[trow * 2] + s_ssq[trow * 2 + 1]) * (1.f / 128.f) + EPS);
        Hs[trow * 132 + 32 * (2 * eh) + r_] = hs[0][i] * rs; Hs[trow * 132 + 32 * (2 * eh + 1) + r_] = hs[1][i] * rs; }
    __syncthreads();
    const float* gn = p.in[10] + head * 128;
    const int c8o = (tid & 15) * 8;
    const f32x4 g0 = *(const f32x4*)(gn + c8o), g1 = *(const f32x4*)(gn + c8o + 4);
    u32x4 oav[4];
#pragma unroll
    for (int it = 0; it < 4; ++it) { const int row = (tid + 512 * it) >> 4; oav[it] = *(const u32x4*)(QKV + (size_t)(base + row) * NIN0 + 1536 + head * 128 + c8o); }
    asm volatile("" ::: "memory");
#pragma unroll
    for (int it = 0; it < 4; ++it) { const int row = (tid + 512 * it) >> 4; const size_t grow = base + row; const u32x4 oa = oav[it];
        const f32x4 v0 = *(const LAS f32x4*)(Hs + row * 132 + c8o), v1 = *(const LAS f32x4*)(Hs + row * 132 + c8o + 4);
        float o[8]; o[0] = __uint_as_float(oa.x << 16); o[1] = __uint_as_float(oa.x & 0xffff0000u); o[2] = __uint_as_float(oa.y << 16); o[3] = __uint_as_float(oa.y & 0xffff0000u);
        o[4] = __uint_as_float(oa.z << 16); o[5] = __uint_as_float(oa.z & 0xffff0000u); o[6] = __uint_as_float(oa.w << 16); o[7] = __uint_as_float(oa.w & 0xffff0000u);
        u32x4 w;
        w.x = cvtpk(v0[0] * g0[0] / (1.f + __expf(-o[0])), v0[1] * g0[1] / (1.f + __expf(-o[1]))); w.y = cvtpk(v0[2] * g0[2] / (1.f + __expf(-o[2])), v0[3] * g0[3] / (1.f + __expf(-o[3])));
        w.z = cvtpk(v1[0] * g1[0] / (1.f + __expf(-o[4])), v1[1] * g1[1] / (1.f + __expf(-o[5]))); w.w = cvtpk(v1[2] * g1[2] / (1.f + __expf(-o[6])), v1[3] * g1[3] / (1.f + __expf(-o[7])));
        *(u32x4*)(OC + grow * DM + head * 128 + c8o) = w; }
}

template <int D, int MODE, int NSUB>
DI void attn_item(const bf16* QKV, int pitch, int qcol0, int kcol0, const bf16* VT, bf16* O, int ocol0, const float* sink,
                  LAS unsigned char* lds, int item, int tid_in, int lane_in, int wave) {
    (void)tid_in; (void)lane_in;
    int tid = wave * 64 + fresh_lane(); asm volatile("" : "+v"(tid)); const int lane = tid & 63;
    constexpr int KT = 64 * NSUB, KP = D + 8, VP = KT + 4, KBYTES = KT * KP * 2, VBYTES = D * VP * 2, BUF = KBYTES + VBYTES, NPT = NSUB * D / 64, NKS = D / 16, NDT = D / 32, CPR = D / 8, VCR = 8 * NSUB;
    static_assert(2 * BUF <= LDS_BYTES - 16, "attention LDS");
    const int r = lane & 31, h = lane >> 5;
    int b, kvh, head, qrow, qpos = 0, nt, wstart = 0;
    if (MODE == 0) { const int qb = item & 15; head = (item >> 4) & 7; b = item >> 7; kvh = head >> 2; qrow = NCTX + b * SEQ + qb * 256 + 32 * wave; nt = KVLEN / KT; }
    else if (MODE == 1) { const int nb = item & 31, hp = (item >> 5) & 1; kvh = (item >> 6) & 1; b = item >> 7; head = kvh * 4 + hp * 2 + (wave >> 2);
        qpos = nb * 128 + (wave & 3) * 32 + r; qrow = NCTX + b * SEQ + nb * 128 + (wave & 3) * 32;
        wstart = nb > 0 ? (nb - 1) * 128 : 0; const int wend = nb < 31 ? (nb + 2) * 128 : SEQ; nt = (CTXL + wend - wstart) / KT; }
    else { const int qh = item & 1, hp = (item >> 1) & 1; kvh = (item >> 2) & 1; b = item >> 3; head = kvh * 4 + hp * 2 + (wave >> 2); qrow = b * 256 + qh * 128 + (wave & 3) * 32; nt = CTXL / KT; }
    const bf16* VTb = VT + (size_t)(b * 2 + kvh) * D * KVLEN;
    const int kcol = kcol0 + kvh * D;
    bf16x8 qf[NKS];
    { const bf16* qp = QKV + (size_t)(qrow + r) * pitch + qcol0 + head * D + 8 * h;
#pragma unroll
        for (int ks = 0; ks < NKS; ++ks) qf[ks] = *(const bf16x8*)(qp + 16 * ks); }
    const float scl = (D == 64 ? 0.125f : 0.08838834764831845f) * LOG2E;
    constexpr float THR2 = 11.0f;
    float mrun, lrun;
    if (MODE == 0) { mrun = -INFINITY; lrun = 0.f; } else { mrun = sink[head] * LOG2E; lrun = h == 0 ? 1.f : 0.f; }
    f32x16 o[NDT];
#pragma unroll
    for (int dt = 0; dt < NDT; ++dt) o[dt] = zero16();
    u32x4 kr[NPT], vr[NPT];
#define ATT_TILE(t, krow0, vkey0) do { const int key0 = KT * (t); if (MODE == 0) { krow0 = key0 < CTXL ? b * CTXL + key0 : NCTX + b * SEQ + key0 - CTXL; vkey0 = key0; } \
        else if (key0 < CTXL) { krow0 = b * CTXL + key0; vkey0 = key0; } else { const int kp_ = wstart + key0 - CTXL; krow0 = NCTX + b * SEQ + kp_; vkey0 = CTXL + kp_; } } while (0)
#define ATT_LOAD(t) do { int krow0, vkey0; ATT_TILE(t, krow0, vkey0); _Pragma("unroll") for (int i = 0; i < NPT; ++i) { const int id = tid + 512 * i; \
        kr[i] = *(const u32x4*)(QKV + (size_t)(krow0 + id / CPR) * pitch + kcol + (id % CPR) * 8); \
        vr[i] = *(const u32x4*)(VTb + (size_t)(id / VCR) * KVLEN + vkey0 + (id % VCR) * 8); } } while (0)
#define ATT_STORE(bi) do { LAS bf16* Kd = (LAS bf16*)(lds + (bi) * BUF); LAS bf16* Vd = (LAS bf16*)(lds + (bi) * BUF + KBYTES); _Pragma("unroll") for (int i = 0; i < NPT; ++i) { const int id = tid + 512 * i; \
        *(LAS u32x4*)(Kd + (id / CPR) * KP + (id % CPR) * 8) = kr[i]; { LAS u32x2* vd_ = (LAS u32x2*)(Vd + (id / VCR) * VP + (id % VCR) * 8); vd_[0] = (u32x2){vr[i].x, vr[i].y}; vd_[1] = (u32x2){vr[i].z, vr[i].w}; } } } while (0)
    ATT_LOAD(0); ATT_STORE(0);
    __syncthreads();
    for (int t = 0; t < nt; ++t) {
        if (t + 1 < nt) ATT_LOAD(t + 1);
        const LAS bf16* Kt = (const LAS bf16*)(lds + (t & 1) * BUF); const LAS bf16* Vt = (const LAS bf16*)(lds + (t & 1) * BUF + KBYTES);
#pragma unroll
        for (int sub = 0; sub < NSUB; ++sub) {
        f32x16 s[2];
#pragma unroll
        for (int q = 0; q < 2; ++q) { s[q] = zero16(); const LAS bf16* kp = Kt + (64 * sub + 32 * q + r) * KP + 8 * h;
#pragma unroll
            for (int ks = 0; ks < NKS; ++ks) s[q] = MFMA32(*(const LAS bf16x8*)(kp + 16 * ks), qf[ks], s[q]); }
        if (MODE == 1 && KT * t >= CTXL) { const int kp0 = wstart + KT * t + 64 * sub - CTXL - qpos;
#pragma unroll
            for (int q = 0; q < 2; ++q)
#pragma unroll
                for (int i = 0; i < 16; ++i) { const int d0 = kp0 + 32 * q + crow(i, h); if (d0 > 128 || d0 < -128) s[q][i] = -INFINITY; } }
        float mx = s[0][0];
#pragma unroll
        for (int q = 0; q < 2; ++q)
#pragma unroll
            for (int i = 0; i < 16; ++i) mx = fmaxf(mx, s[q][i]);
        mx = fmaxf(mx, __shfl_xor(mx, 32)) * scl;
        if (!__all(mx - mrun <= THR2)) {
            const float mnew = fmaxf(mrun, mx), alpha = __builtin_amdgcn_exp2f(mrun - mnew);
            lrun *= alpha; mrun = mnew;
#pragma unroll
            for (int dt = 0; dt < NDT; ++dt)
#pragma unroll
                for (int i = 0; i < 16; ++i) o[dt][i] *= alpha;
        }
        float ls = 0.f; const float nm = -mrun;
#pragma unroll
        for (int q = 0; q < 2; ++q)
#pragma unroll
            for (int i = 0; i < 16; ++i) { s[q][i] = __builtin_amdgcn_exp2f(fmaf(s[q][i], scl, nm)); ls += s[q][i]; }
        lrun += ls;
#pragma unroll
        for (int q = 0; q < 2; ++q)
#pragma unroll
            for (int s2 = 0; s2 < 2; ++s2) {
                u32x4 pw; pw.x = cvtpk(s[q][8 * s2], s[q][8 * s2 + 1]); pw.y = cvtpk(s[q][8 * s2 + 2], s[q][8 * s2 + 3]); pw.z = cvtpk(s[q][8 * s2 + 4], s[q][8 * s2 + 5]); pw.w = cvtpk(s[q][8 * s2 + 6], s[q][8 * s2 + 7]);
                const bf16x8 pb = __builtin_bit_cast(bf16x8, pw);
#pragma unroll
                for (int dt = 0; dt < NDT; ++dt) { const LAS bf16* vp = Vt + (32 * dt + r) * VP + 64 * sub + 32 * q + 16 * s2 + 4 * h;
                    const s16x4 lo = *(const LAS s16x4*)vp, hi = *(const LAS s16x4*)(vp + 8);
                    const bf16x8 a = __builtin_shufflevector(lo, hi, 0, 1, 2, 3, 4, 5, 6, 7);
                    o[dt] = MFMA32(a, pb, o[dt]); }
            }
        }
        if (t + 1 < nt) ATT_STORE((t + 1) & 1);
        __syncthreads();
    }
#undef ATT_TILE
#undef ATT_LOAD
#undef ATT_STORE
    const float inv = 1.f / (lrun + __shfl_xor(lrun, 32));
    bf16* op = O + (size_t)(qrow + r) * DM + ocol0 + head * D + 4 * h;
#pragma unroll
    for (int dt = 0; dt < NDT; ++dt)
#pragma unroll
        for (int g = 0; g < 4; ++g) { u32x2 w; w.x = cvtpk(o[dt][4 * g] * inv, o[dt][4 * g + 1] * inv); w.y = cvtpk(o[dt][4 * g + 2] * inv, o[dt][4 * g + 3] * inv);
            *(u32x2*)(op + 32 * dt + 8 * g) = w; }
}


namespace adb {
using bf16 = unsigned short;
using bf16x8 = __attribute__((ext_vector_type(8))) short;
using s16x4  = __attribute__((ext_vector_type(4))) short;
using f32x16 = __attribute__((ext_vector_type(16))) float;
using u32x4  = __attribute__((ext_vector_type(4))) unsigned;
using ::crow; using ::cvtpk;
constexpr int   D = 128, NW = 8, QBLK = 32, KVBLK = 64;
constexpr float SCALE = 0.088388347648318440f;
constexpr float THR = 8.f;
constexpr int SDEPTH = 2;
constexpr int LDQ = 1536, LDK = 128, LDO = 1024;
constexpr size_t SHM_V = KVBLK * D * 2, SHM_K = KVBLK * D * 2, SHM_ATTN = 2 * SHM_V + 2 * SHM_K + NW * 64 * 4;
#define KSWZ(row, colB) ((row) * 256 + ((colB) ^ (((row) & 7) << 4)))
#define SBAR() __builtin_amdgcn_sched_barrier(0)
template <typename TIn> struct Stage;
template <> struct Stage<bf16>  { using T = bf16x8;
  __device__ static __forceinline__ T ld8(const bf16* p) { return *reinterpret_cast<const bf16x8*>(p); }
  __device__ static __forceinline__ bf16x8 tobf(T x) { return x; } };

__device__ __forceinline__ void partialSM(f32x16& p0, f32x16& p1, float& m_reg, float& mn, float& alpha) {
  constexpr float C = SCALE * 1.4426950408889634f;
  float pmax = p0[0]; for (int r = 1; r < 16; ++r) pmax = fmaxf(pmax, p0[r]); for (int r = 0; r < 16; ++r) pmax = fmaxf(pmax, p1[r]);
  { auto rr = __builtin_amdgcn_permlane32_swap(__float_as_uint(pmax), __float_as_uint(pmax), false, false);
    pmax = fmaxf(__uint_as_float(rr[0]), __uint_as_float(rr[1])); }
  if (__builtin_expect(__all(pmax - m_reg <= THR / SCALE), 1)) { mn = m_reg; alpha = 1.f; }
  else { mn = fmaxf(m_reg, pmax); alpha = __builtin_amdgcn_exp2f((m_reg - mn) * C); m_reg = mn; }
  float mnC = -mn * C;
  for (int r = 0; r < 16; ++r) p0[r] = fmaf(p0[r], C, mnC); for (int r = 0; r < 16; ++r) p1[r] = fmaf(p1[r], C, mnC);
  for (int r = 0; r < 16; ++r) p0[r] = __builtin_amdgcn_exp2f(p0[r]);
}
__device__ __forceinline__ void finishSM(f32x16& p0, f32x16& p1, float alpha, float& l_reg, bf16x8& pa0, bf16x8& pa1, bf16x8& pa2, bf16x8& pa3) {
  for (int r = 0; r < 16; ++r) p1[r] = __builtin_amdgcn_exp2f(p1[r]);
  float ps = 0; for (int r = 0; r < 16; ++r) ps += p0[r]; for (int r = 0; r < 16; ++r) ps += p1[r];
  { auto rr = __builtin_amdgcn_permlane32_swap(__float_as_uint(ps), __float_as_uint(ps), false, false);
    ps = __uint_as_float(rr[0]) + __uint_as_float(rr[1]); }
  l_reg = l_reg * alpha + ps;
#define PK4(P, BASE, OUT) do { unsigned a0 = cvtpk(P[BASE + 0], P[BASE + 1]), a1 = cvtpk(P[BASE + 2], P[BASE + 3]);   \
    unsigned b0 = cvtpk(P[BASE + 4], P[BASE + 5]), b1 = cvtpk(P[BASE + 6], P[BASE + 7]);                              \
    auto r0 = __builtin_amdgcn_permlane32_swap(a0, b0, false, false); auto r1 = __builtin_amdgcn_permlane32_swap(a1, b1, false, false); \
    u32x4 w = {r0[0], r1[0], r0[1], r1[1]}; OUT = *reinterpret_cast<bf16x8*>(&w); } while (0)
  PK4(p0, 0, pa0); PK4(p0, 8, pa1); PK4(p1, 0, pa2); PK4(p1, 8, pa3);
#undef PK4
}
__device__ __forceinline__ void qkt(f32x16& p0, f32x16& p1, const bf16* Ks, const bf16x8* qr, int r32, int hi) {
  p0 = f32x16{}; p1 = f32x16{};
  for (int d0 = 0; d0 < 8; ++d0) { int cb = (d0 * 16 + hi * 8) * 2;
    bf16x8 b0 = *reinterpret_cast<const bf16x8*>((const char*)Ks + KSWZ(r32, cb));
    bf16x8 b1 = *reinterpret_cast<const bf16x8*>((const char*)Ks + KSWZ(32 + r32, cb));
    p0 = __builtin_amdgcn_mfma_f32_32x32x16_bf16(b0, qr[d0], p0, 0, 0, 0);
    p1 = __builtin_amdgcn_mfma_f32_32x32x16_bf16(b1, qr[d0], p1, 0, 0, 0); }
}
__device__ __forceinline__ int v_st(int k, int c) { const int kk = (k & ~0xC) | ((k & 4) << 1) | ((k & 8) >> 1); return ((kk >> 3) * 4 + (c >> 5)) * 512 + ((kk & 7) * 32 + (c & 31)) * 2; }
__device__ __forceinline__ int v_rd_base(int lane) { return ((lane & 3) << 3) | (((lane >> 2) & 3) << 6) | (((lane >> 4) & 1) << 5) | (((lane >> 5) & 1) << 8); }
constexpr int v_rd_off(int d0, int ks, int half) { return d0 * 512 + ks * 4096 + half * 2048; }
template <int OFF> __device__ __forceinline__ s16x4 tr_read(int vb) {
  s16x4 r; asm volatile("ds_read_b64_tr_b16 %0, %1 offset:%2" : "=&v"(r) : "v"(vb), "i"(OFF) : "memory"); return r;
}
template <int D0> __device__ __forceinline__ void pv_one(f32x16& od, int vb, bf16x8 pa0, bf16x8 pa1, bf16x8 pa2, bf16x8 pa3) {
  const s16x4 l0 = tr_read<v_rd_off(D0, 0, 0)>(vb), h0 = tr_read<v_rd_off(D0, 0, 1)>(vb), l1 = tr_read<v_rd_off(D0, 1, 0)>(vb), h1 = tr_read<v_rd_off(D0, 1, 1)>(vb);
  const s16x4 l2 = tr_read<v_rd_off(D0, 2, 0)>(vb), h2 = tr_read<v_rd_off(D0, 2, 1)>(vb), l3 = tr_read<v_rd_off(D0, 3, 0)>(vb), h3 = tr_read<v_rd_off(D0, 3, 1)>(vb);
  asm volatile("s_waitcnt lgkmcnt(0)" ::: "memory"); SBAR();
#define PK(L, H) (bf16x8){L[0], L[1], L[2], L[3], H[0], H[1], H[2], H[3]}
  od = __builtin_amdgcn_mfma_f32_32x32x16_bf16(pa0, PK(l0, h0), od, 0, 0, 0);
  od = __builtin_amdgcn_mfma_f32_32x32x16_bf16(pa1, PK(l1, h1), od, 0, 0, 0);
  od = __builtin_amdgcn_mfma_f32_32x32x16_bf16(pa2, PK(l2, h2), od, 0, 0, 0);
  od = __builtin_amdgcn_mfma_f32_32x32x16_bf16(pa3, PK(l3, h3), od, 0, 0, 0);
#undef PK
}
__device__ __forceinline__ void pv_d0(f32x16* o, int vb, bf16x8 pa0, bf16x8 pa1, bf16x8 pa2, bf16x8 pa3) {
  pv_one<0>(o[0], vb, pa0, pa1, pa2, pa3); pv_one<1>(o[1], vb, pa0, pa1, pa2, pa3); pv_one<2>(o[2], vb, pa0, pa1, pa2, pa3); pv_one<3>(o[3], vb, pa0, pa1, pa2, pa3);
}

template <typename TQ>
__device__ __forceinline__ void attn_dense_body(const TQ* __restrict__ Qb, const bf16* __restrict__ Kh, const bf16* __restrict__ Vh,
                                                bf16* __restrict__ Ob, int seq, char* lds, const int tid) {
  using St = Stage<bf16>; using SQ = Stage<TQ>;
  const int wid = __builtin_amdgcn_readfirstlane(tid >> 6), lane = tid & 63, r32 = lane & 31, hi = lane >> 5;
  bf16* V_lds = (bf16*)lds; bf16* K_lds = (bf16*)(lds + 2 * SHM_V);
  float* ws = (float*)(lds + 2 * SHM_V + 2 * SHM_K) + wid * 64; float* li_l = ws; float* al_l = ws + 32;
  float m_reg = -1e30f, l_reg = 0; f32x16 o[4] = {}; bf16x8 qr[8];
  const TQ* Qw = Qb + (long)(wid * QBLK + r32) * LDQ + hi * 8;
#pragma unroll
  for (int d0 = 0; d0 < 8; ++d0) qr[d0] = SQ::tobf(SQ::ld8(Qw + d0 * 16));
  const int sr = tid >> 4, sc = (tid & 15) * 8, vst0 = v_st(sr, sc), vst1 = v_st(32 + sr, sc);
  const int vb0 = (int)(uintptr_t)V_lds + v_rd_base(lane);
  struct { typename St::T vs0, vs1, ks0, ks1; } sr_[SDEPTH];
#define SLOAD(i, k0) do { sr_[i].vs0 = St::ld8(&Vh[(long)((k0) + sr) * LDK + sc]); sr_[i].vs1 = St::ld8(&Vh[(long)((k0) + 32 + sr) * LDK + sc]); \
    sr_[i].ks0 = St::ld8(&Kh[(long)((k0) + sr) * LDK + sc]); sr_[i].ks1 = St::ld8(&Kh[(long)((k0) + 32 + sr) * LDK + sc]); } while (0)
#define SWRITE(b, i) do { *(bf16x8*)((char*)V_lds + (b) * SHM_V + vst0) = St::tobf(sr_[i].vs0);          \
    *(bf16x8*)((char*)V_lds + (b) * SHM_V + vst1) = St::tobf(sr_[i].vs1); int kc = sc * 2;               \
    *(bf16x8*)((char*)K_lds + (b) * SHM_K + KSWZ(sr, kc)) = St::tobf(sr_[i].ks0);                       \
    *(bf16x8*)((char*)K_lds + (b) * SHM_K + KSWZ(32 + sr, kc)) = St::tobf(sr_[i].ks1); } while (0)
#define SWAIT() do { if constexpr (SDEPTH == 2) asm volatile("s_waitcnt vmcnt(4)" ::: "memory"); else asm volatile("s_waitcnt vmcnt(0)" ::: "memory"); } while (0)
#define RESC(a) do { if (__any((a) < 1.f)) { if (hi == 0) al_l[r32] = (a); asm volatile("s_waitcnt lgkmcnt(0)" ::: "memory"); \
    for (int d = 0; d < 4; ++d) for (int r = 0; r < 16; ++r) o[d][r] *= al_l[crow(r, hi)]; } } while (0)
  f32x16 pA0, pA1, pB0, pB1; float mnA, mnB, alA, alB; bf16x8 pa0, pa1, pa2, pa3; const int NT = seq / KVBLK;
  constexpr int SE = 0, SO = SDEPTH - 1;
  SLOAD(SE, 0); asm volatile("s_waitcnt vmcnt(0)" ::: "memory"); SWRITE(0, SE); __syncthreads();
  qkt(pA0, pA1, K_lds, qr, r32, hi); partialSM(pA0, pA1, m_reg, mnA, alA);
  SLOAD(SO, KVBLK); if constexpr (SDEPTH == 2) { if (2 < NT) SLOAD(SE, 2 * KVBLK); }
  SWAIT(); SWRITE(1, SO); __syncthreads();
  for (int j = 1; j + 1 < NT; j += 2) {
    SBAR(); qkt(pB0, pB1, (bf16*)((char*)K_lds + SHM_K), qr, r32, hi);
    finishSM(pA0, pA1, alA, l_reg, pa0, pa1, pa2, pa3); SBAR();
    SLOAD(SO, (j + SDEPTH) * KVBLK); SBAR();
    pv_d0(o, vb0, pa0, pa1, pa2, pa3); partialSM(pB0, pB1, m_reg, mnB, alB);
    __syncthreads(); SWAIT(); SWRITE(0, SE);
    RESC(alB); __syncthreads();
    SBAR(); qkt(pA0, pA1, K_lds, qr, r32, hi);
    finishSM(pB0, pB1, alB, l_reg, pa0, pa1, pa2, pa3); SBAR();
    if (SDEPTH == 1 || j + 3 < NT) SLOAD(SE, (j + 1 + SDEPTH) * KVBLK); SBAR();
    pv_d0(o, vb0 + (int)SHM_V, pa0, pa1, pa2, pa3); partialSM(pA0, pA1, m_reg, mnA, alA);
    __syncthreads(); SWAIT(); SWRITE(1, SO);
    RESC(alA); __syncthreads();
  }
  SBAR(); qkt(pB0, pB1, (bf16*)((char*)K_lds + SHM_K), qr, r32, hi);
  finishSM(pA0, pA1, alA, l_reg, pa0, pa1, pa2, pa3); SBAR();
  pv_d0(o, vb0, pa0, pa1, pa2, pa3); partialSM(pB0, pB1, m_reg, mnB, alB);
  __syncthreads(); RESC(alB);
  finishSM(pB0, pB1, alB, l_reg, pa0, pa1, pa2, pa3); SBAR();
  pv_d0(o, vb0 + (int)SHM_V, pa0, pa1, pa2, pa3);
  if (hi == 0) li_l[r32] = l_reg; asm volatile("s_waitcnt lgkmcnt(0)" ::: "memory");
  float rli[16];
#pragma unroll
  for (int r = 0; r < 16; ++r) rli[r] = __builtin_amdgcn_rcpf(li_l[crow(r, hi)]);
  bf16* Ow = Ob + (long)(wid * QBLK) * LDO;
#pragma unroll
  for (int r = 0; r < 16; ++r) { int orow = crow(r, hi);
    for (int d0 = 0; d0 < 4; ++d0) Ow[(long)orow * LDO + d0 * 32 + r32] = (bf16)(::cvtpk(o[d0][r] * rli[r], 0.f) & 0xffffu); }
#undef SLOAD
#undef SWRITE
#undef SWAIT
#undef RESC
}
#undef SBAR
#undef KSWZ
}

DI void phase_mlstm_out(const Params& p, int lane, int wave) {
    const bf16* QKV = (const bf16*)(p.ws + WS_BIG); bf16* OC = (bf16*)(p.ws + WS_OCAT); const float* XC = (const float*)(p.ws + WS_XC);
    const float* gn = p.in[10];
    const int gw = blockIdx.x * 8 + wave, NGW = gridDim.x * 8;
    for (int row = gw; row < MTOT; row += NGW) {
        const float* hp = row < NCTX ? XC + (size_t)row * DM : p.out + (size_t)(row - NCTX) * DM;
        const bf16* oa = QKV + (size_t)row * NIN0 + 1536;
        bf16* dst = OC + (size_t)row * DM;
#pragma unroll
        for (int hd = 0; hd < 4; ++hd) { const int c0 = hd * 128 + lane, c1 = c0 + 64;
            const float v0 = hp[c0] + hp[512 + c0], v1 = hp[c1] + hp[512 + c1];
            const float rs = rsqrtf(wave_sum(v0 * v0 + v1 * v1) * (1.f / 128.f) + EPS);
            const float o0 = bf2f(oa[c0]), o1 = bf2f(oa[c1]);
            dst[c0] = f2bf(v0 * rs * gn[c0] / (1.f + __expf(-o0))); dst[c1] = f2bf(v1 * rs * gn[c1] / (1.f + __expf(-o1))); }
    }
}


#define XB_TMO      128
#define XB_XCNT(j)  (256  + 64 * (j))
#define XB_XSUB(j)  (1280 + 64 * (j))
#define XB_XGEN(j)  (2304 + 64 * (j))
#define XB_TOP      3328
#define XB_TOPGEN   3392
#define XCD_BAR_WORDS 3456
#define XB_SPIN_CAP (1u << 18)
DI unsigned xb_ld(unsigned* p)              { return __hip_atomic_load(p, __ATOMIC_RELAXED, __HIP_MEMORY_SCOPE_AGENT); }
DI unsigned xb_add(unsigned* p, unsigned v) { return __hip_atomic_fetch_add(p, v, __ATOMIC_RELAXED, __HIP_MEMORY_SCOPE_AGENT); }
DI unsigned xb_xcc_id() { return (unsigned)__builtin_amdgcn_s_getreg((3 << 11) | 20) & 0xFu; }
#define XB_SPIN(cond, bar) do { unsigned _sp = 0; while (cond) { __builtin_amdgcn_s_sleep(1); \
    if ((++_sp & 255u) == 0u) { if (xb_ld(&(bar)[XB_TMO])) break; if (_sp > XB_SPIN_CAP) { atomicAdd(&(bar)[XB_TMO], 1u); break; } } } } while (0)
struct XcdBarrier { unsigned* bar; unsigned x; volatile LAS unsigned* st; };
DI XcdBarrier xcd_barrier_post(unsigned* bar, volatile LAS unsigned* st, int tid) {
    XcdBarrier b; b.bar = bar; b.x = xb_xcc_id(); b.st = st;
    if (tid == 0) (void)xb_add(&bar[XB_XCNT(b.x)], 1u);
    return b;
}
DI void xcd_barrier_complete(unsigned* bar, unsigned x, unsigned& nloc, unsigned& nx) {
    const unsigned G = gridDim.x * gridDim.y * gridDim.z;
    unsigned sum, cnt, mine, sp = 0u;
    for (;;) {
        sum = 0u; cnt = 0u; mine = 0u;
#pragma unroll
        for (unsigned j = 0; j < 16; ++j) { const unsigned c = xb_ld(&bar[XB_XCNT(j)]); sum += c; cnt += (c > 0u) ? 1u : 0u; mine = (j == x) ? c : mine; }
        if (sum == G) break;
        __builtin_amdgcn_s_sleep(1);
        if ((++sp & 255u) == 0u) { if (xb_ld(&bar[XB_TMO])) break; if (sp > XB_SPIN_CAP) { atomicAdd(&bar[XB_TMO], 1u); break; } }
    }
    nloc = mine > 0u ? mine : 1u; nx = cnt > 0u ? cnt : 1u;
}
DI void xcd_barrier(const XcdBarrier& b, int tid) {
    asm volatile("s_waitcnt vmcnt(0)" ::: "memory");
    __syncthreads();
    if (tid == 0) {
        unsigned* bar = b.bar;
        __builtin_amdgcn_s_waitcnt(0);
        unsigned nloc = b.st[0], nx = b.st[1];
        if (nloc == 0u) { xcd_barrier_complete(bar, b.x, nloc, nx); b.st[0] = nloc; b.st[1] = nx; }
        const unsigned old = xb_add(&bar[XB_XSUB(b.x)], 1u);
        const unsigned gen = old / nloc;
        if (old + 1u == (gen + 1u) * nloc) {
            __builtin_amdgcn_fence(__ATOMIC_RELEASE, "agent");
            asm volatile("s_waitcnt vmcnt(0)" ::: "memory");
            const unsigned og = xb_add(&bar[XB_TOP], 1u);
            const unsigned tg = og / nx;
            if (og + 1u == (tg + 1u) * nx) xb_add(&bar[XB_TOPGEN], 1u);
            else XB_SPIN(xb_ld(&bar[XB_TOPGEN]) == tg, bar);
            __builtin_amdgcn_fence(__ATOMIC_ACQUIRE, "agent");
            xb_add(&bar[XB_XGEN(b.x)], 1u);
            asm volatile("s_waitcnt vmcnt(0)" ::: "memory");
        } else {
            XB_SPIN(xb_ld(&bar[XB_XGEN(b.x)]) == gen, bar);
            __builtin_amdgcn_fence(__ATOMIC_ACQUIRE, "agent");
            asm volatile("s_waitcnt vmcnt(0)" ::: "memory");
        }
    }
    __syncthreads();
}
DI void sub_barrier(unsigned* cnt, unsigned n, int tid) {
    asm volatile("s_waitcnt vmcnt(0)" ::: "memory");
    __syncthreads();
    if (tid == 0) {
        __builtin_amdgcn_fence(__ATOMIC_RELEASE, "agent");
        asm volatile("s_waitcnt vmcnt(0)" ::: "memory");
        (void)xb_add(cnt, 1u);
        unsigned sp = 0u; while (xb_ld(cnt) < n) { __builtin_amdgcn_s_sleep(1); if (++sp > (1u << 22)) break; }
        __builtin_amdgcn_fence(__ATOMIC_ACQUIRE, "agent");
        asm volatile("s_waitcnt vmcnt(0)" ::: "memory");
    }
    __syncthreads();
}
#ifndef REP_X1
#define REP_X1 1
#endif
#ifndef REP_X2
#define REP_X2 1
#endif
#ifndef REP_X3
#define REP_X3 1
#endif
#ifndef REP_SYNC
#define REP_SYNC 1
#endif
#ifndef REP_ATTNC
#define REP_ATTNC 1
#endif
#ifndef REP_MLSTM
#define REP_MLSTM 1
#endif
#ifndef REP_SWA
#define REP_SWA 1
#endif
#ifndef REP_UP1
#define REP_UP1 1
#endif
#ifndef REP_NORM
#define REP_NORM 1
#endif
#ifndef REP_PROL
#define REP_PROL 1
#endif
#define GSYNC() do { FRESH_IDS(); for (int s_ = 0; s_ < REP_SYNC; ++s_) xcd_barrier(xbar, tid); } while (0)
__global__ void __launch_bounds__(512, 2) fwd_kernel(Params p) {
    extern __shared__ __attribute__((aligned(16))) unsigned char lds_raw[];
    LAS unsigned char* lds = (LAS unsigned char*)lds_raw;
    cg::grid_group grid = cg::this_grid();
#define FRESH_IDS() int tid_ = wave_s * 64 + fresh_lane(); asm volatile("" : "+v"(tid_)); const int tid = tid_, lane = tid & 63, wave = wave_s; (void)tid; (void)lane; (void)wave
#define run_gemm(...) run_gemm_rng_(__VA_ARGS__, (int)gridDim.x, (int)blockIdx.x, 0, 0x7fffffff, tid)
#define run_gemm_gc(...) run_gemm_rng_(__VA_ARGS__, 0, 0x7fffffff, tid)
#define run_gemm_rng(...) run_gemm_rng_(__VA_ARGS__, tid)
    const int wave_s = __builtin_amdgcn_readfirstlane((int)threadIdx.x >> 6);
    unsigned char* ws = p.ws;
    bf16* WIN0 = (bf16*)(ws + WS_WIN0); bf16* WOUT0 = (bf16*)(ws + WS_WOUT0); bf16* WIN1 = (bf16*)(ws + WS_WIN1); bf16* WOUT1 = (bf16*)(ws + WS_WOUT1);
    bf16* W1 = (bf16*)(ws + WS_W1); bf16* W2 = (bf16*)(ws + WS_W2);
    const float* MOD0 = (const float*)(ws + WS_MOD); const float* MOD1 = MOD0 + 9 * NMODC;
    float* XC = (float*)(ws + WS_XC); bf16* VT = (bf16*)(ws + WS_VT); bf16* H = (bf16*)(ws + WS_H); bf16* OC = (bf16*)(ws + WS_OCAT); bf16* BIG = (bf16*)(ws + WS_BIG);
    const float* x = p.in[0]; const float* ctx = p.in[2];

    unsigned* barw = (unsigned*)(ws + WS_BAR);
    volatile LAS unsigned* bst = (volatile LAS unsigned*)(lds + LDS_BYTES - 16);
    { FRESH_IDS();
      if (tid < 2) bst[tid] = 0u;
      if (blockIdx.x == 0) for (int i = tid; i < 4096; i += 512) barw[i] = 0u; }
    for (int rep_ = 0; rep_ < REP_PROL; ++rep_) { FRESH_IDS();
        phase_prologue(p, lds, tid, lane, wave);
    }
    grid.sync();
    XcdBarrier xbar; { FRESH_IDS(); xbar = xcd_barrier_post(barw, bst, tid); }
    float* RSS = (float*)(ws + WS_RSS); const float* BIAS = (const float*)(ws + WS_BIAS);
    for (int rep_ = 0; rep_ < REP_NORM; ++rep_) { FRESH_IDS(); __syncthreads();
        phase_norm<false>(p, lds, ctx, x, p.in[6], MOD0, 0, H, 0, MTOT, tid, lane, wave);
        phase_bias(p, lane, wave);
    }
    GSYNC();
    { FRESH_IDS();
        run_gemm(lds, H, WIN0, MTOT, NIN0, DM, EpiStore<0>{BIG, NIN0});
        { const int G = (int)gridDim.x, rem = ((MTOT / 256) * (NIN0 / 256)) % G;
          if (rem == 0) phase_gates(p, lds, H, tid, lane, wave, (int)blockIdx.x, G);
          else if ((int)blockIdx.x >= rem) phase_gates(p, lds, H, tid, lane, wave, (int)blockIdx.x - rem, G - rem); }
    }
    GSYNC();
    for (int rep_ = 0; rep_ < REP_MLSTM; ++rep_) {
    { FRESH_IDS();
        if (rep_ == 0) phase_post<64>(BIG, NIN0, 2048, 8, 2560, 2, 2688, p.in[11], p.in[12], VT, true, lds, tid, lane, wave);
        for (int rx_ = 0; rx_ < REP_X1; ++rx_) for (int item = blockIdx.x; item < 32 * NCH; item += gridDim.x) mlstm_x1(p, lds, item, tid, lane, wave);
    }
    GSYNC();
    { FRESH_IDS();
        const int G_ = (int)gridDim.x, first = ((int)blockIdx.x + G_ - (G_ >> 2)) % G_;
        if (((int)blockIdx.x & 1) == 0) for (int rx_ = 0; rx_ < REP_X2; ++rx_) mlstm_x2(p, tid);
        for (int rep_s = 0; rep_s < REP_SWA; ++rep_s)
        for (int item = first; item < 1024 + 64; item += G_) {
            if (item < 1024) attn_item<64, 1, 2>(BIG, NIN0, 2048, 2560, VT, OC, 512, p.in[13], lds, item, tid, lane, wave);
            else attn_item<64, 2, 2>(BIG, NIN0, 2048, 2560, VT, OC, 512, p.in[13], lds, item - 1024, tid, lane, wave);
        }
        if (((int)blockIdx.x & 1) == 1) for (int rx_ = 0; rx_ < REP_X2; ++rx_) mlstm_x2(p, tid);
    }
    GSYNC();
    { FRESH_IDS();
        for (int rx_ = 0; rx_ < REP_X3; ++rx_) for (int item = blockIdx.x; item < 32 * NCH; item += gridDim.x) mlstm_x3(p, lds, item, tid, lane, wave);
    }
    }
    GSYNC();
    { FRESH_IDS();
        run_gemm(lds, OC + (size_t)NCTX * DM, WOUT0, NLAT, DM, DM, EpiResidN{ctx, x, XC, p.out, MOD0, 2, NCTX, p.in[7], MOD0, 3, H, RSS});
    }
    GSYNC();
    { FRESH_IDS();
        const int NG1 = 32, bid = (int)blockIdx.x, G = (int)gridDim.x;
        const EpiStoreN<1> eup{BIG + (size_t)NCTX * DFF, DFF, RSS, BIAS, NCTX};
        if (bid < NG1) {
            run_gemm_gc(lds, OC, WOUT0, NCTX, DM, DM, EpiResidN{ctx, x, XC, p.out, MOD0, 2, 0, p.in[7], MOD0, 3, H, RSS}, NG1, bid);
            sub_barrier(barw + 3584, NG1, tid);
            run_gemm_gc(lds, H, W1, NCTX, DFF, DM, EpiStoreN<1>{BIG, DFF, RSS, BIAS, 0}, NG1, bid);
            run_gemm_rng(lds, H + (size_t)NCTX * DM, W1, NLAT, DFF, DM, eup, NG1, bid, 0, 96);
        } else {
            run_gemm_rng(lds, H + (size_t)NCTX * DM, W1, NLAT, DFF, DM, eup, G - NG1, bid - NG1, 96, 0x7fffffff);
        }
    }
    GSYNC();
    bf16* BIG1 = BIG + (size_t)16 * 1024 * 1024;
    const int GC = 32;
    { FRESH_IDS();
        run_gemm(lds, BIG + (size_t)NCTX * DFF, W2, NLAT, DM, DFF, EpiResidN{XC, p.out, XC, p.out, MOD0, 5, NCTX, p.in[6] + DM, MOD1, 0, H, RSS + MTOT});
    }
    GSYNC();
    { FRESH_IDS();
        if ((int)blockIdx.x < GC) run_gemm_gc(lds, BIG, W2, NCTX, DM, DFF, EpiResidN{XC, p.out, XC, p.out, MOD0, 5, 0, p.in[6] + DM, MOD1, 0, H, RSS + MTOT}, GC, (int)blockIdx.x);
        else run_gemm_gc(lds, H + (size_t)NCTX * DM, WIN1, NLAT, NIN1, DM, EpiStoreN<0>{BIG1 + (size_t)NCTX * NIN1, NIN1, RSS + MTOT, BIAS + 9 * 4096, NCTX}, (int)gridDim.x - GC, (int)blockIdx.x - GC);
    }
    GSYNC();
    { FRESH_IDS();
        if ((int)blockIdx.x < 48) { run_gemm_gc(lds, H, WIN1, NCTX, NIN1, DM, EpiStoreN<0>{BIG1, NIN1, RSS + MTOT, BIAS + 9 * 4096, 0}, 48, (int)blockIdx.x);
            sub_barrier(barw + 3600, 48, tid);
            phase_post1(BIG1, p.in[16], p.in[17], VT, (bf16*)(ws + WS_V1), lane, wave, 0, NCTX, (int)blockIdx.x, 48); }
        else phase_post1(BIG1, p.in[16], p.in[17], VT, (bf16*)(ws + WS_V1), lane, wave, NCTX, MTOT, (int)blockIdx.x - 48, (int)gridDim.x - 48);
    }
    GSYNC();
    for (int rep_ = 0; rep_ < REP_ATTNC; ++rep_) { FRESH_IDS();
        const int G_ = (int)gridDim.x, vcu = (G_ % 8 == 0) ? ((int)blockIdx.x & 7) * (G_ >> 3) + ((int)blockIdx.x >> 3) : (int)blockIdx.x;
        for (int item = vcu; item < 1024; item += G_) {
            const int qb = item & 15, head = (item >> 4) & 7, b = item >> 7, kvh = head >> 2;
            int tl = wave * 64 + fresh_lane(); asm volatile("" : "+v"(tl));
            const size_t qrow = (size_t)NCTX + (size_t)b * SEQ + qb * 256;
            __syncthreads();
            adb::attn_dense_body<adb::bf16>(BIG1 + qrow * NIN1 + head * 128, VT + (size_t)(b * 2 + kvh) * KVLEN * 128, (const bf16*)(ws + WS_V1) + (size_t)(b * 2 + kvh) * KVLEN * 128,
                                            OC + qrow * DM + head * 128, KVLEN, (char*)lds, tl);
        }
    }
    GSYNC();
    { FRESH_IDS();
        run_gemm(lds, OC + (size_t)NCTX * DM, WOUT1, NLAT, DM, DM, EpiResidN{XC, p.out, XC, p.out, MOD1, 2, NCTX, p.in[7] + DM, MOD1, 3, H, RSS + 2 * MTOT});
    }
    GSYNC();
    for (int rep_ = 0; rep_ < REP_UP1; ++rep_) { FRESH_IDS();
        run_gemm(lds, H + (size_t)NCTX * DM, W1 + (size_t)DFF * DM, NLAT, DFF, DM, EpiStoreN<1>{BIG, DFF, RSS + 2 * MTOT, BIAS + 2 * 9 * 4096, NCTX});
    }
    GSYNC();
    { FRESH_IDS();
        run_gemm(lds, BIG, W2 + (size_t)DFF * DM, NLAT, DM, DFF, EpiResid{XC, p.out, XC, p.out, MOD1, 5, NCTX});
    }
}

extern "C" void kernel_launch(void* const* d_in, const int* in_sizes, int n_in, void* d_out, int out_size, void* d_ws, size_t ws_size, hipStream_t stream) {
    static int grid = 0;
    if (grid == 0) {
        if (n_in != 21 || out_size != NLAT * DM || ws_size < WS_END) { fprintf(stderr, "kernel_launch: unexpected shapes (n_in %d out %d ws %zu)\n", n_in, out_size, ws_size); grid = -1; return; }
        int dev = 0, cus = 0, per_cu = 0;
        hipGetDevice(&dev); hipDeviceGetAttribute(&cus, hipDeviceAttributeMultiprocessorCount, dev);
        hipFuncSetAttribute((const void*)fwd_kernel, hipFuncAttributeMaxDynamicSharedMemorySize, LDS_BYTES);
        hipOccupancyMaxActiveBlocksPerMultiprocessor(&per_cu, (const void*)fwd_kernel, 512, LDS_BYTES);
        if (per_cu < 1) { fprintf(stderr, "kernel_launch: occupancy query says %d blocks per CU\n", per_cu); per_cu = 1; }
        grid = cus * per_cu;
    }
    if (grid < 0) return;
    Params p{};
    for (int i = 0; i < 21; ++i) p.in[i] = (const float*)d_in[i];
    p.out = (float*)d_out; p.ws = (unsigned char*)d_ws;
    void* args[] = {&p};
    hipError_t e = hipLaunchCooperativeKernel((const void*)fwd_kernel, dim3(grid), dim3(512), args, LDS_BYTES, stream);
    if (e != hipSuccess) fprintf(stderr, "cooperative launch failed: %s (grid %d)\n", hipGetErrorString(e), grid);
}
```

```cpp
#include <hip/hip_runtime.h>
#include <hip/hip_cooperative_groups.h>
#include <cstdio>
#include <cstdint>
namespace cg = cooperative_groups;
namespace pg8 {
#define PG8_LAS __attribute__((address_space(3)))
typedef unsigned short bf16_t;
typedef short bf16x8 __attribute__((ext_vector_type(8)));
typedef float f32x4 __attribute__((ext_vector_type(4)));
typedef unsigned u32x4 __attribute__((ext_vector_type(4)));
constexpr int BM = 256, BK = 64, HALF = 128, HTB = HALF * BK * 2  , STAGE_BYTES = 8 * HTB, NXCD = 8, WGM = 8;

__host__ __device__ __forceinline__ int lds_byte(int r, int c) { const int st = (r >> 4) * 2 + (c >> 5), rr = r & 15, cc = c & 31, ob = rr * 64 + cc * 2; return st * 1024 + (ob ^ (((ob >> 9) & 1) << 5)); }
__host__ __device__ __forceinline__ void stage_rc(int b, int& R, int& C) { const int st = b / 1024, sb = b % 1024, swz = sb ^ (((sb >> 9) & 1) << 5); R = (st >> 1) * 16 + swz / 64; C = (st & 1) * 32 + (swz % 64) / 2; }
__host__ __device__ __forceinline__ int perm32(int rho) { const int n = rho >> 4, i = rho & 15; return 8 * (i >> 2) + 4 * n + (i & 3); }

struct Unit { int pm, pn; };
struct Gemm { const bf16_t* A; const bf16_t* Bt; int M, N, K; };

struct StaticOrder {
    int nM, nN, nwg, G, c, lo, hi;
    __host__ __device__ void init(int M, int N, int G_, int c_) { nM = M / BM; nN = N / BM; nwg = nM * nN; G = G_; c = c_; lo = 0; hi = nwg; }
    __host__ __device__ void range(int lo_, int hi_) { lo = lo_; hi = hi_ < nwg ? hi_ : nwg; }
    __host__ __device__ bool next(int i, Unit& u) const {
        const long L = (long)lo + (long)i * G + c; if (L >= hi) return false;
        int wgid = (int)L; { const int q = nwg / NXCD, r = nwg % NXCD, xcd = wgid % NXCD, off = wgid / NXCD; wgid = (xcd < r ? xcd * (q + 1) : r * (q + 1) + (xcd - r) * q) + off; }
        const int nig = WGM * nN, gid = wgid / nig, fm = gid * WGM, gsz = (nM - fm) < WGM ? (nM - fm) : WGM;
        u.pm = fm + ((wgid % nig) % gsz); u.pn = (wgid % nig) / gsz; return true;
    }
    __device__ __forceinline__ void a_ready(const Unit&) const {}
    __device__ __forceinline__ void done(const Unit&) const {}
};
}
namespace pg8 {

template <class Epi, class Sched, bool ALIGN_EPI = false, bool SP2 = false>
__device__ __forceinline__ void gemm_phase(PG8_LAS unsigned char* lds, const Gemm g, const Sched& S, const Epi& E, const int tid_in) {
    int tid_ = tid_in; asm volatile("" : "+v"(tid_)); const int tid = tid_, wid = __builtin_amdgcn_readfirstlane(tid >> 6), lane = tid & 63, wr = wid >> 2, wc = wid & 3, fr = lane & 15, fq = lane >> 4;
    const int K = g.K, nt = K / BK;
    unsigned voffA[2], voffB[2];
#pragma unroll
    for (int i = 0; i < 2; ++i) { int R, C; stage_rc(tid * 16 + i * 8192, R, C); const int Rb = Epi::PERM ? ((R & ~31) + perm32(R & 31)) : R;
        voffA[i] = (unsigned)(R * K + C) * 2u; voffB[i] = (unsigned)(Rb * K + C) * 2u; }
    const size_t kstep = (size_t)(BK * 2);
    const size_t hstep = (size_t)HALF * K * 2;
    const size_t tstep = 2 * hstep;
    const unsigned ldsw = (unsigned)wid * 1024u;
    const int aoff = lds_byte(wr * 64 + fr, fq * 8), boff = lds_byte(wc * 32 + fr, fq * 8);
#define PG8_SA(b, h) (((b) * 2 + (h)) * HTB)
#define PG8_SB(b, h) ((4 + (b) * 2 + (h)) * HTB)
#define PG8_STAGE(bufoff, gbase, voff) do { _Pragma("unroll") for (int _i = 0; _i < 2; ++_i) \
        __builtin_amdgcn_global_load_lds((const unsigned*)((const char*)(gbase) + (voff)[_i]), (PG8_LAS unsigned*)(lds + (bufoff) + ldsw + _i * 8192), 16, 0, 0); } while (0)
#define PG8_LDA(dst, b, h) do { _Pragma("unroll") for (int m = 0; m < 4; ++m) _Pragma("unroll") for (int k = 0; k < 2; ++k) dst[m][k] = *(const PG8_LAS bf16x8*)(lds + PG8_SA(b, h) + aoff + m * 2048 + k * 1024); } while (0)
#define PG8_LDB(dst, b, h) do { _Pragma("unroll") for (int n = 0; n < 2; ++n) _Pragma("unroll") for (int k = 0; k < 2; ++k) dst[n][k] = *(const PG8_LAS bf16x8*)(lds + PG8_SB(b, h) + boff + n * 2048 + k * 1024); } while (0)
#define PG8_MMA(ai, bj, At, Bt) do { __builtin_amdgcn_s_setprio(1); _Pragma("unroll") for (int m = 0; m < 4; ++m) _Pragma("unroll") for (int n = 0; n < 2; ++n) _Pragma("unroll") for (int k = 0; k < 2; ++k) \
        acc[ai][bj][m][n] = __builtin_amdgcn_mfma_f32_16x16x32_bf16(Bt[n][k], At[m][k], acc[ai][bj][m][n], 0, 0, 0); __builtin_amdgcn_s_setprio(0); } while (0)
#define PG8_WAIT_V(n) asm volatile("s_waitcnt vmcnt(" #n ")" ::: "memory")
#define PG8_WAIT_L(n) asm volatile("s_waitcnt lgkmcnt(" #n ")" ::: "memory")
#define PG8_BAR __builtin_amdgcn_s_barrier()
#define PG8_SCHED __builtin_amdgcn_sched_barrier(0)
    Unit cur, nxt; int ui = 0;
    if (!S.next(0, cur)) return;
    f32x4 acc[2][2][4][2];
#pragma unroll
    for (int a = 0; a < 2; ++a)
#pragma unroll
        for (int b = 0; b < 2; ++b)
#pragma unroll
            for (int m = 0; m < 4; ++m)
#pragma unroll
                for (int n = 0; n < 2; ++n) acc[a][b][m][n] = (f32x4){0.f, 0.f, 0.f, 0.f};
    bf16x8 At[4][2], B0[2][2], B1[2][2];
    const char* cA = (const char*)g.A + (size_t)cur.pm * tstep; const char* cB = (const char*)g.Bt + (size_t)cur.pn * tstep;
    S.a_ready(cur);
    if constexpr (SP2) {
        PG8_STAGE(PG8_SB(0, 0), cB, voffB); PG8_STAGE(PG8_SB(0, 1), cB + hstep, voffB); PG8_STAGE(PG8_SA(0, 0), cA, voffA); PG8_STAGE(PG8_SA(0, 1), cA + hstep, voffA);
        if (wr == 1) PG8_BAR;
        PG8_WAIT_V(2); PG8_BAR;
        PG8_STAGE(PG8_SB(1, 0), cB + kstep, voffB); PG8_STAGE(PG8_SA(1, 0), cA + kstep, voffA); PG8_STAGE(PG8_SB(1, 1), cB + hstep + kstep, voffB);
        PG8_WAIT_V(6); PG8_BAR;
    } else {
        PG8_STAGE(PG8_SB(0, 0), cB, voffB); PG8_STAGE(PG8_SA(0, 0), cA, voffA); PG8_STAGE(PG8_SB(0, 1), cB + hstep, voffB); PG8_STAGE(PG8_SA(0, 1), cA + hstep, voffA);
        if (wr == 1) PG8_BAR;
        PG8_WAIT_V(4); PG8_BAR;
        PG8_STAGE(PG8_SB(1, 0), cB + kstep, voffB); PG8_STAGE(PG8_SA(1, 0), cA + kstep, voffA); PG8_STAGE(PG8_SB(1, 1), cB + hstep + kstep, voffB);
        PG8_WAIT_V(6); PG8_BAR;
    }
    for (;;) {
        const bool has_next = S.next(ui + 1, nxt);
        const char* nA = has_next ? (const char*)g.A + (size_t)nxt.pm * tstep : cA; const char* nB = has_next ? (const char*)g.Bt + (size_t)nxt.pn * tstep : cB;
        for (int t = 0; t < nt; t += 2) {
            const bool last = (t == nt - 2);
            const char* a1 = cA + (size_t)(t + 1) * kstep;
            const char* a2 = last ? nA : cA + (size_t)(t + 2) * kstep; const char* b2 = last ? nB : cB + (size_t)(t + 2) * kstep;
            const char* a3 = a2 + kstep; const char* b3 = b2 + kstep;
            if (last && has_next) S.a_ready(nxt);
            if constexpr (SP2) {
            PG8_LDB(B0, 0, 0); PG8_LDB(B1, 0, 1); PG8_SCHED; PG8_LDA(At, 0, 0); PG8_STAGE(PG8_SA(1, 1), a1 + hstep, voffA);
            PG8_WAIT_V(8); PG8_WAIT_L(0); PG8_BAR; PG8_MMA(0, 0, At, B0); PG8_MMA(0, 1, At, B1); PG8_BAR; PG8_SCHED;
            PG8_LDA(At, 0, 1); PG8_STAGE(PG8_SB(0, 0), b2, voffB); PG8_STAGE(PG8_SB(0, 1), b2 + hstep, voffB); PG8_STAGE(PG8_SA(0, 0), a2, voffA);
            PG8_WAIT_V(8); PG8_WAIT_L(0); PG8_BAR; PG8_MMA(1, 0, At, B0); PG8_MMA(1, 1, At, B1); PG8_BAR; PG8_SCHED;
            PG8_LDB(B0, 1, 0); PG8_LDB(B1, 1, 1); PG8_SCHED; PG8_LDA(At, 1, 0); PG8_STAGE(PG8_SA(0, 1), a2 + hstep, voffA);
            PG8_WAIT_V(8); PG8_WAIT_L(0); PG8_BAR; PG8_MMA(0, 0, At, B0); PG8_MMA(0, 1, At, B1); PG8_BAR; PG8_SCHED;
            PG8_LDA(At, 1, 1); PG8_STAGE(PG8_SB(1, 0), b3, voffB); PG8_STAGE(PG8_SB(1, 1), b3 + hstep, voffB); PG8_STAGE(PG8_SA(1, 0), a3, voffA);
            PG8_WAIT_V(8); PG8_WAIT_L(0); PG8_BAR; PG8_MMA(1, 0, At, B0); PG8_MMA(1, 1, At, B1); PG8_BAR; PG8_SCHED;
            } else {
            PG8_LDB(B0, 0, 0); PG8_SCHED; PG8_LDA(At, 0, 0); PG8_STAGE(PG8_SA(1, 1), a1 + hstep, voffA);
            PG8_WAIT_L(8); PG8_BAR; PG8_WAIT_L(0); PG8_MMA(0, 0, At, B0); PG8_BAR; PG8_SCHED;
            PG8_LDB(B1, 0, 1); PG8_STAGE(PG8_SB(0, 0), b2, voffB);
            PG8_BAR; PG8_WAIT_L(0); PG8_MMA(0, 1, At, B1); PG8_BAR;
            PG8_LDA(At, 0, 1); PG8_STAGE(PG8_SA(0, 0), a2, voffA);
            PG8_BAR; PG8_WAIT_L(0); PG8_MMA(1, 0, At, B0); PG8_BAR; PG8_SCHED;
            PG8_STAGE(PG8_SB(0, 1), b2 + hstep, voffB);
            PG8_WAIT_V(6); PG8_BAR; PG8_MMA(1, 1, At, B1); PG8_BAR;
            PG8_LDB(B0, 1, 0); PG8_SCHED; PG8_LDA(At, 1, 0); PG8_STAGE(PG8_SA(0, 1), a2 + hstep, voffA);
            PG8_WAIT_L(8); PG8_BAR; PG8_WAIT_L(0); PG8_MMA(0, 0, At, B0); PG8_BAR; PG8_SCHED;
            PG8_LDB(B1, 1, 1); PG8_STAGE(PG8_SB(1, 0), b3, voffB);
            PG8_BAR; PG8_WAIT_L(0); PG8_MMA(0, 1, At, B1); PG8_BAR;
            PG8_LDA(At, 1, 1); PG8_STAGE(PG8_SA(1, 0), a3, voffA);
            PG8_BAR; PG8_WAIT_L(0); PG8_MMA(1, 0, At, B0); PG8_BAR; PG8_SCHED;
            PG8_STAGE(PG8_SB(1, 1), b3 + hstep, voffB);
            PG8_WAIT_V(6); PG8_BAR; PG8_MMA(1, 1, At, B1); PG8_BAR;
            }
        }
        if constexpr (ALIGN_EPI) { if (wr == 0) PG8_BAR; }
        if constexpr (!Epi::AFTER_DRAIN) { E(acc, cur, wr, wc, fr, fq); S.done(cur); }
        if (!has_next) break;
#pragma unroll
        for (int a = 0; a < 2; ++a)
#pragma unroll
            for (int b = 0; b < 2; ++b)
#pragma unroll
                for (int m = 0; m < 4; ++m)
#pragma unroll
                    for (int n = 0; n < 2; ++n) acc[a][b][m][n] = (f32x4){0.f, 0.f, 0.f, 0.f};
        cur = nxt; cA = nA; cB = nB; ++ui;
        if constexpr (ALIGN_EPI) { if (wr == 1) PG8_BAR; }
    }
    PG8_WAIT_V(0);
    if constexpr (!ALIGN_EPI) { if (wr == 0) PG8_BAR; }
    PG8_BAR;
    if constexpr (Epi::AFTER_DRAIN) { E.fused(acc, cur, wr, wc, fr, fq, lds, wid, lane); S.done(cur); }
#undef PG8_SA
#undef PG8_SB
#undef PG8_STAGE
#undef PG8_LDA
#undef PG8_LDB
#undef PG8_MMA
#undef PG8_WAIT_V
#undef PG8_WAIT_L
#undef PG8_BAR
#undef PG8_SCHED
}
}

#define DI __device__ __forceinline__
#define LAS __attribute__((address_space(3)))
typedef unsigned short bf16;
typedef short bf16x8 __attribute__((ext_vector_type(8)));
typedef short s16x4 __attribute__((ext_vector_type(4)));
typedef float f32x2 __attribute__((ext_vector_type(2)));
typedef float f32x4 __attribute__((ext_vector_type(4)));
typedef float f32x16 __attribute__((ext_vector_type(16)));
typedef unsigned u32x2 __attribute__((ext_vector_type(2)));
typedef unsigned u32x4 __attribute__((ext_vector_type(4)));
typedef __bf16 bf16x2_t __attribute__((ext_vector_type(2)));
#define LDS_WAIT() asm volatile("s_waitcnt lgkmcnt(0)" ::: "memory")
#define MFMA32(a, b, c) __builtin_amdgcn_mfma_f32_32x32x16_bf16((a), (b), (c), 0, 0, 0)

constexpr int DM = 1024, NBATCH = 8, SEQ = 4096, CTXL = 256, NCTX = NBATCH * CTXL, NLAT = NBATCH * SEQ, MTOT = NCTX + NLAT;
constexpr int NIN0 = 2816, NIN1 = 1536, DFF = 4096, KVLEN = CTXL + SEQ, AB_IN_W = 2832, NMODC = 6144;
constexpr float EPS = 1e-6f, LOG2E = 1.4426950408889634f;
constexpr size_t MiB = 1u << 20;
constexpr size_t WS_WIN0 = 0, WS_WOUT0 = 6 * MiB, WS_WIN1 = 8 * MiB, WS_WOUT1 = 11 * MiB, WS_W1 = 13 * MiB, WS_W2 = 29 * MiB, WS_MOD = 45 * MiB,
                 WS_GATES = 46 * MiB, WS_XC = 49 * MiB, WS_VT = 57 * MiB, WS_H = 74 * MiB, WS_OCAT = 142 * MiB, WS_BIG = 210 * MiB, WS_BAR = 482 * MiB, WS_RSS = 483 * MiB, WS_BIAS = 484 * MiB, WS_V1 = 485 * MiB, WS_END = 502 * MiB;
constexpr size_t WS_WG = 45 * MiB + 512 * 1024;
constexpr int LDS_BYTES = 147456;

struct Params { const float* in[21]; float* out; unsigned char* ws; };

DI unsigned cvtpk(float lo, float hi) { f32x2 v = {lo, hi}; bf16x2_t b = __builtin_convertvector(v, bf16x2_t); return __builtin_bit_cast(unsigned, b); }
DI bf16 f2bf(float x) { return (bf16)(cvtpk(x, 0.f) & 0xffffu); }
DI float bf2f(bf16 b) { return __uint_as_float(((unsigned)b) << 16); }
DI float wave_sum(float v) {
#pragma unroll
    for (int o = 1; o < 64; o <<= 1) v += __shfl_xor(v, o);
    return v;
}
DI int fresh_lane() { int l; asm volatile("v_mbcnt_lo_u32_b32 %0, -1, 0\n\tv_mbcnt_hi_u32_b32 %0, -1, %0" : "=v"(l)); return l; }
DI int crow(int i, int h) { return (i & 3) + 8 * (i >> 2) + 4 * h; }
DI f32x16 zero16() { f32x16 z; for (int i = 0; i < 16; ++i) z[i] = 0.f; return z; }

DI void mma32(f32x16& acc, const LAS bf16* A, int lda, const LAS bf16* B, int ldb, int K, int lane) {
    const int r = lane & 31, h = lane >> 5;
    const LAS bf16* ap = A + r * lda + 8 * h; const LAS bf16* bp = B + r * ldb + 8 * h;
#pragma unroll 1
    for (int k0 = 0; k0 < K; k0 += 16) {
        const bf16x8 a = *(const LAS bf16x8*)(ap + k0); const bf16x8 b = *(const LAS bf16x8*)(bp + k0);
        acc = MFMA32(a, b, acc);
    }
}

template <int ACT> struct EpiStore {
    static constexpr bool PERM = true, AFTER_DRAIN = false;
    bf16* O; int ldc;
    DI void operator()(const f32x4 (&acc)[2][2][4][2], const pg8::Unit& u, int wr, int wc, int fr, int fq) const {
        const int row0 = u.pm * 256 + wr * 64 + fr, col0 = u.pn * 256 + wc * 32 + 8 * fq;
#pragma unroll
        for (int ai = 0; ai < 2; ++ai)
#pragma unroll
            for (int m = 0; m < 4; ++m) { bf16* rowp = O + (size_t)(row0 + ai * 128 + m * 16) * ldc + col0;
#pragma unroll
                for (int bj = 0; bj < 2; ++bj) { f32x4 v0 = acc[ai][bj][m][0], v1 = acc[ai][bj][m][1];
                    if (ACT == 1) {
#pragma unroll
                        for (int e = 0; e < 4; ++e) { float a = fmaxf(v0[e], 0.f), b = fmaxf(v1[e], 0.f); v0[e] = a * a; v1[e] = b * b; } }
                    u32x4 w; w.x = cvtpk(v0[0], v0[1]); w.y = cvtpk(v0[2], v0[3]); w.z = cvtpk(v1[0], v1[1]); w.w = cvtpk(v1[2], v1[3]);
                    *(u32x4*)(rowp + bj * 128) = w; } }
    }
};
struct EpiResid {
    static constexpr bool PERM = true, AFTER_DRAIN = false;
    const float* srcC; const float* srcL; float* dstC; float* dstL; const float* mod; int gi; int row_base;
    DI void operator()(const f32x4 (&acc)[2][2][4][2], const pg8::Unit& u, int wr, int wc, int fr, int fq) const {
        const int grow0 = row_base + u.pm * 256;
        const float* s; float* d; int mrow;
        if (grow0 < NCTX) { s = srcC + (size_t)grow0 * DM; d = dstC + (size_t)grow0 * DM; mrow = 8; }
        else { const int lr = grow0 - NCTX; s = srcL + (size_t)lr * DM; d = dstL + (size_t)lr * DM; mrow = lr >> 12; }
        const float* gp = mod + mrow * NMODC + gi * DM;
#pragma unroll
        for (int bj = 0; bj < 2; ++bj) { const int col = u.pn * 256 + bj * 128 + wc * 32 + 8 * fq;
            const f32x4 g0 = *(const f32x4*)(gp + col), g1 = *(const f32x4*)(gp + col + 4);
#pragma unroll
            for (int ai = 0; ai < 2; ++ai) {
            f32x4 rr0[4], rr1[4];
#pragma unroll
                for (int m = 0; m < 4; ++m) { const int ro = (ai * 128 + wr * 64 + m * 16 + fr) * DM + col; rr0[m] = *(const f32x4*)(s + ro); rr1[m] = *(const f32x4*)(s + ro + 4); }
            asm volatile("" ::: "memory");
#pragma unroll
                for (int m = 0; m < 4; ++m) { const int ro = (ai * 128 + wr * 64 + m * 16 + fr) * DM + col;
                    *(f32x4*)(d + ro) = rr0[m] + g0 * acc[ai][bj][m][0]; *(f32x4*)(d + ro + 4) = rr1[m] + g1 * acc[ai][bj][m][1]; } } }
    }
};
struct EpiResidN {
    static constexpr bool PERM = true, AFTER_DRAIN = false;
    const float* srcC; const float* srcL; float* dstC; float* dstL; const float* mod; int gi; int row_base;
    const float* gnext; const float* modn; int sin; bf16* Hn; float* rss;
    DI void operator()(const f32x4 (&acc)[2][2][4][2], const pg8::Unit& u, int wr, int wc, int fr, int fq) const {
        const int grow0 = row_base + u.pm * 256;
        const float* s; float* d; int mrow;
        if (grow0 < NCTX) { s = srcC + (size_t)grow0 * DM; d = dstC + (size_t)grow0 * DM; mrow = 8; }
        else { const int lr = grow0 - NCTX; s = srcL + (size_t)lr * DM; d = dstL + (size_t)lr * DM; mrow = lr >> 12; }
        const float* gp = mod + mrow * NMODC + gi * DM; const float* scp = modn + mrow * NMODC + (sin + 1) * DM;
        bf16* hb = Hn + (size_t)grow0 * DM;
        float ssq[2][4];
#pragma unroll
        for (int ai = 0; ai < 2; ++ai)
#pragma unroll
            for (int m = 0; m < 4; ++m) ssq[ai][m] = 0.f;
#pragma unroll
        for (int bj = 0; bj < 2; ++bj) { const int col = u.pn * 256 + bj * 128 + wc * 32 + 8 * fq;
            const f32x4 g0 = *(const f32x4*)(gp + col), g1 = *(const f32x4*)(gp + col + 4);
            const f32x4 w0 = *(const f32x4*)(gnext + col) * (*(const f32x4*)(scp + col) + 1.f), w1 = *(const f32x4*)(gnext + col + 4) * (*(const f32x4*)(scp + col + 4) + 1.f);
#pragma unroll
            for (int ai = 0; ai < 2; ++ai) {
            f32x4 rr0[4], rr1[4];
#pragma unroll
                for (int m = 0; m < 4; ++m) { const int ro = (ai * 128 + wr * 64 + m * 16 + fr) * DM + col; rr0[m] = *(const f32x4*)(s + ro); rr1[m] = *(const f32x4*)(s + ro + 4); }
            asm volatile("" ::: "memory");
#pragma unroll
                for (int m = 0; m < 4; ++m) { const int ro = (ai * 128 + wr * 64 + m * 16 + fr) * DM + col;
                    const f32x4 r0 = rr0[m], r1 = rr1[m];
                    const f32x4 x0 = r0 + g0 * acc[ai][bj][m][0], x1 = r1 + g1 * acc[ai][bj][m][1];
                    *(f32x4*)(d + ro) = x0; *(f32x4*)(d + ro + 4) = x1;
                    ssq[ai][m] += (x0[0] * x0[0] + x0[1] * x0[1]) + (x0[2] * x0[2] + x0[3] * x0[3]) + (x1[0] * x1[0] + x1[1] * x1[1]) + (x1[2] * x1[2] + x1[3] * x1[3]);
                    const f32x4 h0 = x0 * w0, h1 = x1 * w1;
                    u32x4 w; w.x = cvtpk(h0[0], h0[1]); w.y = cvtpk(h0[2], h0[3]); w.z = cvtpk(h1[0], h1[1]); w.w = cvtpk(h1[2], h1[3]);
                    *(u32x4*)(hb + ro) = w; } } }
#pragma unroll
        for (int ai = 0; ai < 2; ++ai)
#pragma unroll
            for (int m = 0; m < 4; ++m) { float q = ssq[ai][m]; q += __shfl_xor(q, 16); q += __shfl_xor(q, 32);
                if (fq == 0) atomicAdd(rss + grow0 + ai * 128 + wr * 64 + m * 16 + fr, q); }
    }
};
template <int ACT> struct EpiStoreN {
    static constexpr bool PERM = true, AFTER_DRAIN = false;
    bf16* O; int ldc; const float* rss; const float* bias; int row_base;
    DI void operator()(const f32x4 (&acc)[2][2][4][2], const pg8::Unit& u, int wr, int wc, int fr, int fq) const {
        const int lrow0 = u.pm * 256 + wr * 64 + fr, grow0 = row_base + u.pm * 256, col0 = u.pn * 256 + wc * 32 + 8 * fq;
        bf16* Ou = O + (size_t)(u.pm * 256) * ldc + u.pn * 256;
        const int mrow = grow0 < NCTX ? 8 : (grow0 - NCTX) >> 12;
        float rstd[2][4];
#pragma unroll
        for (int ai = 0; ai < 2; ++ai)
#pragma unroll
            for (int m = 0; m < 4; ++m) rstd[ai][m] = rsqrtf(rss[row_base + lrow0 + ai * 128 + m * 16] * (1.f / DM) + EPS);
        const float* bp = bias + mrow * 4096 + col0;
        f32x4 bb[2][2];
#pragma unroll
        for (int bj = 0; bj < 2; ++bj) { bb[bj][0] = *(const f32x4*)(bp + bj * 128); bb[bj][1] = *(const f32x4*)(bp + bj * 128 + 4); }
        asm volatile("" ::: "memory");
#pragma unroll
        for (int bj = 0; bj < 2; ++bj) { const f32x4 b0 = bb[bj][0], b1 = bb[bj][1];
#pragma unroll
            for (int ai = 0; ai < 2; ++ai)
#pragma unroll
                for (int m = 0; m < 4; ++m) {
                    f32x4 v0 = acc[ai][bj][m][0] * rstd[ai][m] + b0, v1 = acc[ai][bj][m][1] * rstd[ai][m] + b1;
                    if (ACT == 1) {
#pragma unroll
                        for (int e = 0; e < 4; ++e) { float a = fmaxf(v0[e], 0.f), b = fmaxf(v1[e], 0.f); v0[e] = a * a; v1[e] = b * b; } }
                    u32x4 w; w.x = cvtpk(v0[0], v0[1]); w.y = cvtpk(v0[2], v0[3]); w.z = cvtpk(v1[0], v1[1]); w.w = cvtpk(v1[2], v1[3]);
                    *(u32x4*)(Ou + (wr * 64 + fr + ai * 128 + m * 16) * ldc + wc * 32 + 8 * fq + bj * 128) = w; } }
    }
};
template <class Epi> DI void run_gemm_rng_(LAS unsigned char* lds, const bf16* A, const bf16* Bt, int M, int N, int K, const Epi& E, int G, int c, int lo, int hi, int tid) {
    pg8::Gemm g{A, Bt, M, N, K}; pg8::StaticOrder S; S.init(M, N, G, c); S.range(lo, hi);
    pg8::gemm_phase<Epi, pg8::StaticOrder, true, true>(lds, g, S, E, tid);
}

DI void transpose_item(const float* __restrict__ W, int ldw, int K, bf16* WT, int nblk, LAS float* scr, int item, int lane) {
    const int kb = item / nblk, nb = item - kb * nblk, k0 = 64 * kb, n0 = 32 * nb;
    float wv[32];
#pragma unroll
    for (int i = 0; i < 32; ++i) wv[i] = W[(size_t)(k0 + 2 * i + (lane >> 5)) * ldw + n0 + (lane & 31)];
#pragma unroll
    for (int i = 0; i < 32; ++i) scr[(2 * i + (lane >> 5)) * 33 + (lane & 31)] = wv[i];
    LDS_WAIT();
    const int c = lane & 7;
#pragma unroll
    for (int j = 0; j < 4; ++j) { const int n = (lane >> 3) + 8 * j; const LAS float* s = scr + (8 * c) * 33 + n;
        u32x4 o; o.x = cvtpk(s[0], s[33]); o.y = cvtpk(s[66], s[99]); o.z = cvtpk(s[132], s[165]); o.w = cvtpk(s[198], s[231]);
        *(u32x4*)(WT + (size_t)(n0 + n) * K + k0 + 8 * c) = o; }
    LDS_WAIT();
}
DI void phase_prologue(const Params& p, LAS unsigned char* lds, int tid, int lane, int wave) {
    unsigned char* ws = p.ws;
    float* MOD = (float*)(ws + WS_MOD);
    for (int item = blockIdx.x; item < 192; item += gridDim.x) {
        const int l = item / 96, cgp = item - l * 96;
        LAS float* sl = (LAS float*)lds; LAS float* part = sl + 9 * 1024;
        for (int i = tid; i < 9 * 1024; i += 512) { const int r = i >> 10, k = i & 1023; const float cv = r < 8 ? p.in[1][r * 1024 + k] : p.in[3][k]; sl[i] = cv / (1.f + __expf(-cv)); }
        __syncthreads();
        const float* aw = p.in[4] + (size_t)l * 1024 * NMODC + cgp * 64 + lane;
        float acc[9];
#pragma unroll
        for (int r = 0; r < 9; ++r) acc[r] = 0.f;
        const int kbase = wave * 128;
#pragma unroll 32
        for (int k = 0; k < 128; ++k) { const float w = aw[(size_t)(kbase + k) * NMODC];
#pragma unroll
            for (int r = 0; r < 9; ++r) acc[r] += sl[r * 1024 + kbase + k] * w; }
#pragma unroll
        for (int r = 0; r < 9; ++r) part[(wave * 9 + r) * 64 + lane] = acc[r];
        __syncthreads();
        for (int i = tid; i < 576; i += 512) { const int r = i >> 6, cl = i & 63; float s = p.in[5][l * NMODC + cgp * 64 + cl];
#pragma unroll
            for (int kg = 0; kg < 8; ++kg) s += part[(kg * 9 + r) * 64 + cl];
            MOD[(l * 9 + r) * NMODC + cgp * 64 + cl] = s; }
        __syncthreads();
    }
    { float* rss = (float*)(ws + WS_RSS); for (int i = blockIdx.x * 512 + tid; i < 3 * MTOT; i += gridDim.x * 512) rss[i] = 0.f; }
    { bf16* WG = (bf16*)(ws + WS_WG);
      for (int idx = blockIdx.x * 512 + tid; idx < 16 * 1024; idx += gridDim.x * 512) { const int g = idx & 15, k = idx >> 4;
          const float w = p.in[8][(size_t)k * AB_IN_W + 2048 + g]; const bf16 hi = f2bf(w); const bf16 lo = f2bf(w - bf2f(hi));
          WG[g * 1024 + k] = hi; WG[16 * 1024 + g * 1024 + k] = lo; } }
    LAS float* scr = (LAS float*)(lds + wave * 16384);
    const int gw = blockIdx.x * 8 + wave, NGW = gridDim.x * 8;
    constexpr int I0 = 16 * 64, I1 = 16 * 24, I2 = 16 * 32, I3 = 16 * 48, I4 = 16 * 32, I5 = 16 * 128, I6 = 64 * 32;
    constexpr int NITEMS = I0 + I1 + I2 + I3 + I4 + 2 * I5 + 2 * I6;
    for (int it = gw; it < NITEMS; it += NGW) {
        int r = it;
        if (r < I0) { transpose_item(p.in[8], AB_IN_W, 1024, (bf16*)(ws + WS_WIN0), 64, scr, r, lane); continue; } r -= I0;
        if (r < I1) { transpose_item(p.in[8] + 2064, AB_IN_W, 1024, (bf16*)(ws + WS_WIN0) + (size_t)2048 * 1024, 24, scr, r, lane); continue; } r -= I1;
        if (r < I2) { transpose_item(p.in[14], 1024, 1024, (bf16*)(ws + WS_WOUT0), 32, scr, r, lane); continue; } r -= I2;
        if (r < I3) { transpose_item(p.in[15], NIN1, 1024, (bf16*)(ws + WS_WIN1), 48, scr, r, lane); continue; } r -= I3;
        if (r < I4) { transpose_item(p.in[18], 1024, 1024, (bf16*)(ws + WS_WOUT1), 32, scr, r, lane); continue; } r -= I4;
        if (r < 2 * I5) { const int l = r / I5; r -= l * I5; transpose_item(p.in[19] + (size_t)l * 1024 * DFF, DFF, 1024, (bf16*)(ws + WS_W1) + (size_t)l * DFF * 1024, 128, scr, r, lane); continue; } r -= 2 * I5;
        { const int l = r / I6; r -= l * I6; transpose_item(p.in[20] + (size_t)l * DFF * 1024, 1024, DFF, (bf16*)(ws + WS_W2) + (size_t)l * DFF * 1024, 32, scr, r, lane); }
    }
}

DI float log_sigmoid(float x) { return -(fmaxf(-x, 0.f) + log1pf(__expf(-fabsf(x)))); }
template <bool GATES>
DI void phase_norm(const Params& p, LAS unsigned char* lds, const float* srcC, const float* srcL, const float* gn, const float* modL, int si, bf16* H,
                   int row_lo, int row_hi, int tid, int lane, int wave) {
    const int gw = blockIdx.x * 8 + wave, NGW = gridDim.x * 8;
    for (int row = row_lo + gw; row < row_hi; row += 2 * NGW) {
        const int rowB = row + NGW; const bool hasB = rowB < row_hi;
        const float* xa; const float* xb; int ma, mb;
        if (row < NCTX) { xa = srcC + (size_t)row * DM; ma = 8; } else { xa = srcL + (size_t)(row - NCTX) * DM; ma = (row - NCTX) >> 12; }
        const int rb = hasB ? rowB : row;
        if (rb < NCTX) { xb = srcC + (size_t)rb * DM; mb = 8; } else { xb = srcL + (size_t)(rb - NCTX) * DM; mb = (rb - NCTX) >> 12; }
        f32x4 va[4], vb[4]; float sa = 0.f, sb = 0.f;
#pragma unroll
        for (int j = 0; j < 4; ++j) { va[j] = ((const f32x4*)xa)[lane + 64 * j]; vb[j] = ((const f32x4*)xb)[lane + 64 * j]; }
        const float* sha = modL + ma * NMODC + si * DM; const float* shb = modL + mb * NMODC + si * DM;
        f32x4 gg[4], sca[4], tca[4], scb[4], tcb[4];
#pragma unroll
        for (int j = 0; j < 4; ++j) { gg[j] = ((const f32x4*)gn)[lane + 64 * j]; sca[j] = ((const f32x4*)(sha + DM))[lane + 64 * j]; tca[j] = ((const f32x4*)sha)[lane + 64 * j];
            scb[j] = ((const f32x4*)(shb + DM))[lane + 64 * j]; tcb[j] = ((const f32x4*)shb)[lane + 64 * j]; }
        asm volatile("" ::: "memory");
#pragma unroll
        for (int j = 0; j < 4; ++j) { sa += (va[j].x * va[j].x + va[j].y * va[j].y) + (va[j].z * va[j].z + va[j].w * va[j].w);
                                      sb += (vb[j].x * vb[j].x + vb[j].y * vb[j].y) + (vb[j].z * vb[j].z + vb[j].w * vb[j].w); }
#pragma unroll
        for (int o = 1; o < 64; o <<= 1) { sa += __shfl_xor(sa, o); sb += __shfl_xor(sb, o); }
        const float ra = rsqrtf(sa * (1.f / DM) + EPS), rbs = rsqrtf(sb * (1.f / DM) + EPS);
        bf16* ha = H + (size_t)row * DM; bf16* hb = H + (size_t)rb * DM;
#pragma unroll
        for (int j = 0; j < 4; ++j) {
            { const f32x4 v = va[j] * ra * gg[j] * (sca[j] + 1.f) + tca[j]; u32x2 o; o.x = cvtpk(v.x, v.y); o.y = cvtpk(v.z, v.w); ((u32x2*)ha)[lane + 64 * j] = o; }
            if (hasB) { const f32x4 v = vb[j] * rbs * gg[j] * (scb[j] + 1.f) + tcb[j]; u32x2 o; o.x = cvtpk(v.x, v.y); o.y = cvtpk(v.z, v.w); ((u32x2*)hb)[lane + 64 * j] = o; }
        }
    }
}

DI void phase_gates(const Params& p, LAS unsigned char* lds, const bf16* H, int tid, int lane, int wave, int bidx, int nblk) {
    constexpr int GP = 1032;
    LAS bf16* Ws = (LAS bf16*)lds;
    const bf16* WG = (const bf16*)(p.ws + WS_WG);
    __syncthreads();
    for (int i = tid; i < 32 * 128; i += 512) { const int rw = i >> 7, c = i & 127; *(LAS u32x4*)(Ws + rw * GP + c * 8) = *(const u32x4*)(WG + rw * 1024 + c * 8); }
    __syncthreads();
    float* GT = (float*)(p.ws + WS_GATES);
    const int r = lane & 31, hh = lane >> 5;
    const int gw = bidx * 8 + wave, NGW = nblk * 8;
    const float gb = p.in[9][r & 15];
    for (int tile = gw; tile < MTOT / 32; tile += NGW) {
        const int row0 = 32 * tile;
        const bf16* ap = H + (size_t)(row0 + r) * DM + 8 * hh;
        const LAS bf16* bh = Ws + (r & 15) * GP + 8 * hh; const LAS bf16* bl = bh + 16 * GP;
        f32x16 acc = zero16();
#pragma unroll 1
        for (int kg = 0; kg < 4; ++kg) { bf16x8 af[16];
#pragma unroll
            for (int q = 0; q < 16; ++q) af[q] = *(const bf16x8*)(ap + 16 * (16 * kg + q));
            asm volatile("" ::: "memory");
#pragma unroll
            for (int q = 0; q < 16; ++q) { const int ks = 16 * kg + q;
                acc = MFMA32(af[q], *(const LAS bf16x8*)(bh + 16 * ks), acc); acc = MFMA32(af[q], *(const LAS bf16x8*)(bl + 16 * ks), acc); } }
        if (r < 16) {
#pragma unroll
            for (int i = 0; i < 16; ++i) { float gv = acc[i] + gb; if ((r >> 2) & 1) gv = log_sigmoid(gv); GT[(size_t)(row0 + crow(i, hh)) * 16 + r] = gv; } }
    }
    __syncthreads();
}


DI void phase_bias(const Params& p, int lane, int wave) {
    const float* MOD = (const float*)(p.ws + WS_MOD); float* BIAS = (float*)(p.ws + WS_BIAS);
    const int gw = blockIdx.x * 8 + wave, NGW = gridDim.x * 8;
    for (int it = gw; it < 4096 + 1536 + 4096; it += NGW) {
        int which, n; const bf16* WT; const float* sh;
        if (it < 4096) { which = 0; n = it; WT = (const bf16*)(p.ws + WS_W1); sh = MOD + 3 * DM; }
        else if (it < 4096 + 1536) { which = 1; n = it - 4096; WT = (const bf16*)(p.ws + WS_WIN1); sh = MOD + 9 * NMODC; }
        else { which = 2; n = it - 4096 - 1536; WT = (const bf16*)(p.ws + WS_W1) + (size_t)DFF * DM; sh = MOD + 9 * NMODC + 3 * DM; }
        const u32x4 w0 = *(const u32x4*)(WT + (size_t)n * DM + lane * 16), w1 = *(const u32x4*)(WT + (size_t)n * DM + lane * 16 + 8);
        float wf[16];
        wf[0] = __uint_as_float(w0.x << 16); wf[1] = __uint_as_float(w0.x & 0xffff0000u); wf[2] = __uint_as_float(w0.y << 16); wf[3] = __uint_as_float(w0.y & 0xffff0000u);
        wf[4] = __uint_as_float(w0.z << 16); wf[5] = __uint_as_float(w0.z & 0xffff0000u); wf[6] = __uint_as_float(w0.w << 16); wf[7] = __uint_as_float(w0.w & 0xffff0000u);
        wf[8] = __uint_as_float(w1.x << 16); wf[9] = __uint_as_float(w1.x & 0xffff0000u); wf[10] = __uint_as_float(w1.y << 16); wf[11] = __uint_as_float(w1.y & 0xffff0000u);
        wf[12] = __uint_as_float(w1.z << 16); wf[13] = __uint_as_float(w1.z & 0xffff0000u); wf[14] = __uint_as_float(w1.w << 16); wf[15] = __uint_as_float(w1.w & 0xffff0000u);
        float mine = 0.f;
        f32x4 s4[9][4];
#pragma unroll
        for (int r = 0; r < 9; ++r)
#pragma unroll
            for (int q = 0; q < 4; ++q) s4[r][q] = *(const f32x4*)(sh + r * NMODC + lane * 16 + 4 * q);
        float av[9];
#pragma unroll
        for (int r = 0; r < 9; ++r) { float a = 0.f;
#pragma unroll
            for (int q = 0; q < 4; ++q) a += s4[r][q][0] * wf[4 * q] + s4[r][q][1] * wf[4 * q + 1] + s4[r][q][2] * wf[4 * q + 2] + s4[r][q][3] * wf[4 * q + 3];
            av[r] = a; }
#pragma unroll
        for (int o = 1; o < 64; o <<= 1) {
#pragma unroll
            for (int r = 0; r < 9; ++r) av[r] += __shfl_xor(av[r], o); }
#pragma unroll
        for (int r = 0; r < 9; ++r) if (lane == r) mine = av[r];
        if (lane < 9) BIAS[(which * 9 + lane) * 4096 + n] = mine;
    }
}


DI void phase_post1(bf16* QKV, const float* qg, const float* kg, bf16* K1, bf16* V1, int lane, int wave, int row_lo, int row_hi, int bidx, int nblk) {
    constexpr int HD = 128, PPA = 32, NH = 10, pitch = NIN1, R = 2;
    const int gw = bidx * 8 + wave, NGW = nblk * 8;
    const float gq0 = qg[lane], gq1 = qg[lane + 64], gk0 = kg[lane], gk1 = kg[lane + 64];
    const int fi = lane & (PPA - 1); const float invf = exp2f(-(float)fi * (13.287712379549449f / (float)PPA));
    for (int row0 = row_lo + gw; row0 < row_hi; row0 += R * NGW) {
        int rows[R]; bool ok[R], lat[R]; int bb[R], key[R]; float cs[R], sn[R]; bf16* base[R];
        float x1[R][NH], x2[R][NH], ss[R][NH]; bf16 vv[R][4];
#pragma unroll
        for (int q = 0; q < R; ++q) { rows[q] = row0 + q * NGW; ok[q] = rows[q] < row_hi; if (!ok[q]) rows[q] = row0;
            lat[q] = rows[q] >= NCTX; const int tt = (rows[q] - NCTX) & (SEQ - 1);
            if (lat[q]) { bb[q] = (rows[q] - NCTX) >> 12; key[q] = CTXL + tt; } else { bb[q] = rows[q] >> 8; key[q] = rows[q] & 255; }
            cs[q] = 1.f; sn[q] = 0.f;
            if (lat[q]) { const float ang = (float)(lane < PPA ? (tt >> 6) : (tt & 63)) * invf; cs[q] = __cosf(ang); sn[q] = __sinf(ang); }
            base[q] = QKV + (size_t)rows[q] * pitch;
#pragma unroll
            for (int hq = 0; hq < NH; ++hq) { x1[q][hq] = bf2f(base[q][hq * HD + lane]); x2[q][hq] = bf2f(base[q][hq * HD + lane + 64]); }
#pragma unroll
            for (int j = 0; j < 4; ++j) vv[q][j] = base[q][1280 + 64 * j + lane]; }
        asm volatile("" ::: "memory");
#pragma unroll
        for (int q = 0; q < R; ++q)
#pragma unroll
            for (int hq = 0; hq < NH; ++hq) ss[q][hq] = x1[q][hq] * x1[q][hq] + x2[q][hq] * x2[q][hq];
#pragma unroll
        for (int o = 1; o < 64; o <<= 1) {
#pragma unroll
            for (int q = 0; q < R; ++q)
#pragma unroll
                for (int hq = 0; hq < NH; ++hq) ss[q][hq] += __shfl_xor(ss[q][hq], o); }
#pragma unroll
        for (int q = 0; q < R; ++q) if (ok[q]) {
#pragma unroll
            for (int hq = 0; hq < NH; ++hq) if (hq >= 8 || lat[q]) {
                const float rs = rsqrtf(ss[q][hq] * (1.f / (float)HD) + EPS);
                const float y1 = x1[q][hq] * rs * (hq < 8 ? gq0 : gk0), y2 = x2[q][hq] * rs * (hq < 8 ? gq1 : gk1);
                bf16* dst = hq < 8 ? base[q] + hq * HD : K1 + ((size_t)(bb[q] * 2 + (hq - 8)) * KVLEN + key[q]) * HD;
                dst[lane] = f2bf(y1 * cs[q] - y2 * sn[q]); dst[lane + 64] = f2bf(y2 * cs[q] + y1 * sn[q]); }
            bf16* vd0 = V1 + ((size_t)(bb[q] * 2) * KVLEN + key[q]) * HD; bf16* vd1 = V1 + ((size_t)(bb[q] * 2 + 1) * KVLEN + key[q]) * HD;
            vd0[lane] = vv[q][0]; vd0[lane + 64] = vv[q][1]; vd1[lane] = vv[q][2]; vd1[lane + 64] = vv[q][3]; }
    }
}

template <int HD>
DI void phase_post(bf16* QKV, int pitch, int qcol, int nq, int kcol, int nk, int vcol, const float* qg, const float* kg, bf16* VT, bool q_for_ctx,
                   LAS unsigned char* lds, int tid, int lane, int wave, int row_lo = 0, int row_hi = MTOT, int tile_lo = 0, int tile_hi = MTOT / 64) {
    constexpr int PPA = HD / 4, NH = 10, R = 2;
    const int gw = blockIdx.x * 8 + wave, NGW = gridDim.x * 8;
    float gq0, gq1 = 0.f, gk0, gk1 = 0.f;
    gq0 = qg[lane]; gk0 = kg[lane]; if (HD == 128) { gq1 = qg[lane + 64]; gk1 = kg[lane + 64]; }
    const int jj = (HD == 64) ? (lane & 31) : lane;
    const float invf = exp2f(-(float)(jj & (PPA - 1)) * (13.287712379549449f / (float)PPA));
    for (int row0 = row_lo + gw; row0 < row_hi; row0 += R * NGW) {
        int rows[R]; bool ok[R], lat[R]; int h0[R]; float cs[R], sn[R]; bf16* base[R];
        float x1[R][NH], x2[R][NH], ss[R][NH];
#pragma unroll
        for (int q = 0; q < R; ++q) { rows[q] = row0 + q * NGW; ok[q] = rows[q] < row_hi; if (!ok[q]) rows[q] = row0;
            lat[q] = rows[q] >= NCTX; const int tt = (rows[q] - NCTX) & (SEQ - 1);
            cs[q] = 1.f; sn[q] = 0.f;
            if (lat[q]) { const float ang = (float)(jj < PPA ? (tt >> 6) : (tt & 63)) * invf; cs[q] = __cosf(ang); sn[q] = __sinf(ang); }
            h0[q] = (lat[q] || q_for_ctx) ? 0 : nq;
            base[q] = QKV + (size_t)rows[q] * pitch + qcol;
#pragma unroll
            for (int hq = 0; hq < NH; ++hq) { x1[q][hq] = bf2f(base[q][hq * HD + lane]); x2[q][hq] = 0.f; if (HD == 128) x2[q][hq] = bf2f(base[q][hq * HD + lane + 64]); } }
        asm volatile("" ::: "memory");
#pragma unroll
        for (int q = 0; q < R; ++q)
#pragma unroll
            for (int hq = 0; hq < NH; ++hq) ss[q][hq] = x1[q][hq] * x1[q][hq] + x2[q][hq] * x2[q][hq];
#pragma unroll
        for (int o = 1; o < 64; o <<= 1) {
#pragma unroll
            for (int q = 0; q < R; ++q)
#pragma unroll
                for (int hq = 0; hq < NH; ++hq) ss[q][hq] += __shfl_xor(ss[q][hq], o); }
#pragma unroll
        for (int q = 0; q < R; ++q) {
#pragma unroll
            for (int hq = 0; hq < NH; ++hq) if (hq >= h0[q]) {
                const float rs = rsqrtf(ss[q][hq] * (1.f / (float)HD) + EPS);
                if (HD == 64) { const float y = x1[q][hq] * rs * (hq < 8 ? gq0 : gk0); const float pr = __shfl_xor(y, 32);
                    if (ok[q]) base[q][hq * HD + lane] = f2bf(lane < 32 ? y * cs[q] - pr * sn[q] : y * cs[q] + pr * sn[q]); }
                else { const float y1 = x1[q][hq] * rs * (hq < 8 ? gq0 : gk0), y2 = x2[q][hq] * rs * (hq < 8 ? gq1 : gk1);
                    if (ok[q]) { base[q][hq * HD + lane] = f2bf(y1 * cs[q] - y2 * sn[q]); base[q][hq * HD + lane + 64] = f2bf(y2 * cs[q] + y1 * sn[q]); } }
            } }
    }
    constexpr int NV = 2 * HD, TP = NV + 2;
    LAS bf16* tile = (LAS bf16*)lds;
    for (int tk = tile_lo + blockIdx.x; tk < tile_hi; tk += gridDim.x) {
        const int row0 = 64 * tk; int b, key0;
        if (row0 < NCTX) { b = row0 >> 8; key0 = row0 & 255; } else { const int lr = row0 - NCTX; b = lr >> 12; key0 = 256 + (lr & 4095); }
        { constexpr int NIT = 64 * NV / 512; bf16 tv[NIT];
#pragma unroll
          for (int i = 0; i < NIT; ++i) { const int idx = tid + 512 * i, tok = idx / NV, c = idx - tok * NV; tv[i] = QKV[(size_t)(row0 + tok) * pitch + vcol + c]; }
#pragma unroll
          for (int i = 0; i < NIT; ++i) { const int idx = tid + 512 * i, tok = idx / NV, c = idx - tok * NV; tile[tok * TP + c] = tv[i]; } }
        __syncthreads();
        for (int idx = tid; idx < 64 * NV; idx += 512) { const int rr = idx >> 6, key = idx & 63; VT[(size_t)(b * NV + rr) * KVLEN + key0 + key] = tile[key * TP + rr]; }
        __syncthreads();
    }
}

constexpr int MP = 136;
constexpr int ML_VT = 0, ML_VWT = 40 * MP * 2, ML_CT = 2 * 40 * MP * 2, ML_Q = 3 * 40 * MP * 2, ML_K = ML_Q + 128 * MP * 2, ML_KT = ML_K + 128 * MP * 2, ML_SC = ML_KT + 128 * MP * 2;
static_assert(ML_SC + 5120 <= LDS_BYTES, "mLSTM LDS map");
DI void mlstm_item(const Params& p, LAS unsigned char* lds, int item, int tid, int lane, int wave) {
    const int dvq = item & 3, dir = (item >> 2) & 1, head = (item >> 3) & 3, b = item >> 5;
    const bf16* QKV = (const bf16*)(p.ws + WS_BIG); const float* GT = (const float*)(p.ws + WS_GATES);
    float* XC = (float*)(p.ws + WS_XC);
    LAS bf16* VTs = (LAS bf16*)(lds + ML_VT); LAS bf16* VWTs = (LAS bf16*)(lds + ML_VWT); LAS bf16* CTs = (LAS bf16*)(lds + ML_CT);
    LAS bf16* Qs = (LAS bf16*)(lds + ML_Q); LAS bf16* Ks = (LAS bf16*)(lds + ML_K); LAS bf16* KTs = (LAS bf16*)(lds + ML_KT); LAS bf16* Ss = Ks;
    LAS float* sc = (LAS float*)(lds + ML_SC);
    LAS float* s_ic = sc; LAS float* s_fc = sc + 128; LAS float* s_a = sc + 256; LAS float* s_rt = sc + 384; LAS float* s_iw = sc + 512;
    LAS float* s_w = sc + 640; LAS float* s_emt = sc + 768; LAS float* s_den = sc + 896; LAS float* s_misc = sc + 1024;
    const int r = lane & 31, h = lane >> 5, ti = wave >> 1, tj = wave & 1;
    const float KSCALE = 0.08838834764831845f;
    for (int i = tid; i < 40 * MP; i += 512) CTs[i] = 0;
    if (tid < 128) VTs[32 * MP + tid] = 0x3F80;
    f32x16 accC = zero16(); float m = 0.f;
    __syncthreads();
    for (int ci = 0; ci < 34; ++ci) {
        int base;
        if (ci < 2) { const int cc = dir ? 1 - ci : ci; base = b * 256 + cc * 128; }
        else { const int cc = dir ? 31 - (ci - 2) : (ci - 2); base = NCTX + b * 4096 + cc * 128; }
#pragma unroll
        for (int i = 0; i < 4; ++i) { const int id = tid + 512 * i, rr = id >> 4, c = id & 15; const size_t grow = base + (dir ? 127 - rr : rr);
            const bf16* src = QKV + grow * NIN0 + head * 128 + c * 8;
            *(LAS u32x4*)(Qs + rr * MP + c * 8) = *(const u32x4*)src; *(LAS u32x4*)(Ks + rr * MP + c * 8) = *(const u32x4*)(src + 512); }
        { const int rr = tid >> 2, c = tid & 3; const size_t grow = base + (dir ? 127 - rr : rr);
            const u32x4 v = *(const u32x4*)(QKV + grow * NIN0 + 1024 + head * 128 + dvq * 32 + c * 8);
            LAS bf16* d = VTs + (c * 8) * MP + rr;
            d[0] = (bf16)(v.x & 0xffffu); d[MP] = (bf16)(v.x >> 16); d[2 * MP] = (bf16)(v.y & 0xffffu); d[3 * MP] = (bf16)(v.y >> 16);
            d[4 * MP] = (bf16)(v.z & 0xffffu); d[5 * MP] = (bf16)(v.z >> 16); d[6 * MP] = (bf16)(v.w & 0xffffu); d[7 * MP] = (bf16)(v.w >> 16); }
        if (tid < 256) { const int rr = tid & 127; const size_t grow = base + (dir ? 127 - rr : rr); const int gi = (dir ? 2 : 0) + (tid >> 7);
            const float gv = GT[grow * 16 + gi * 4 + head]; if (tid < 128) s_ic[rr] = gv; else s_fc[rr] = gv; }
        __syncthreads();
        { const int d = tid & 127, sg = tid >> 7;
#pragma unroll
            for (int s8 = 0; s8 < 4; ++s8) { const LAS bf16* kp = Ks + (32 * sg + 8 * s8) * MP + d;
                u32x4 o; o.x = (unsigned)kp[0] | ((unsigned)kp[MP] << 16); o.y = (unsigned)kp[2 * MP] | ((unsigned)kp[3 * MP] << 16);
                o.z = (unsigned)kp[4 * MP] | ((unsigned)kp[5 * MP] << 16); o.w = (unsigned)kp[6 * MP] | ((unsigned)kp[7 * MP] << 16);
                *(LAS u32x4*)(KTs + d * MP + 32 * sg + 8 * s8) = o; } }
        if (wave == 0) {
            const float f0 = s_fc[2 * lane], f1 = s_fc[2 * lane + 1], i0 = s_ic[2 * lane], i1 = s_ic[2 * lane + 1];
            float S = f0 + f1;
#pragma unroll
            for (int o = 1; o < 64; o <<= 1) { const float t = __shfl_up(S, o); if (lane >= o) S += t; }
            const float bc1 = S, bc0 = S - f1, a0 = i0 - bc0, a1 = i1 - bc1;
            float P = fmaxf(a0, a1);
#pragma unroll
            for (int o = 1; o < 64; o <<= 1) { const float t = __shfl_up(P, o); if (lane >= o) P = fmaxf(P, t); }
            float Pex = __shfl_up(P, 1); if (lane == 0) Pex = -INFINITY;
            const float pm0 = fmaxf(Pex, a0), pm1 = P;
            const float blast = __shfl(bc1, 63), Mall = __shfl(P, 63);
            const float mnew = blast + fmaxf(m, Mall);
            const float rt0 = -fmaxf(m, pm0), rt1 = -fmaxf(m, pm1);
            s_a[2 * lane] = a0; s_a[2 * lane + 1] = a1; s_rt[2 * lane] = rt0; s_rt[2 * lane + 1] = rt1;
            s_iw[2 * lane] = __expf(m + rt0); s_iw[2 * lane + 1] = __expf(m + rt1);
            s_w[2 * lane] = __expf(a0 + blast - mnew) * KSCALE; s_w[2 * lane + 1] = __expf(a1 + blast - mnew) * KSCALE;
            s_emt[2 * lane] = __expf(rt0 - bc0); s_emt[2 * lane + 1] = __expf(rt1 - bc1);
            if (lane == 0) { s_misc[0] = __expf(blast + m - mnew); s_misc[1] = mnew; }
        }
        __syncthreads();
        const float carry = s_misc[0], mnew = s_misc[1];
        for (int idx = tid; idx < 33 * 128; idx += 512) { const int e = idx >> 7, s = idx & 127; VWTs[e * MP + s] = f2bf(bf2f(VTs[e * MP + s]) * s_w[s]); }
        float sv[2][16];
#pragma unroll
        for (int tt = 0; tt < 2; ++tt) { const int tjs = (wave & 1) * 2 + tt;
            if (tjs <= ti) { f32x16 acc = zero16(); mma32(acc, Qs + 32 * ti * MP, MP, Ks + 32 * tjs * MP, MP, 128, lane);
                const int scol = 32 * tjs + r; const float as = s_a[scol];
#pragma unroll
                for (int i = 0; i < 16; ++i) { const int trow = 32 * ti + crow(i, h); const float e = (scol <= trow) ? __expf(as + s_rt[trow]) : 0.f; sv[tt][i] = acc[i] * KSCALE * e; } } }
        __syncthreads();
#pragma unroll
        for (int tt = 0; tt < 2; ++tt) { const int tjs = (wave & 1) * 2 + tt;
            if (tjs <= ti) { const int scol = 32 * tjs + r;
#pragma unroll
                for (int i = 0; i < 16; ++i) Ss[(32 * ti + crow(i, h)) * MP + scol] = f2bf(sv[tt][i]); } }
        __syncthreads();
        f32x16 a1 = zero16(), a2 = zero16(), up = zero16();
        mma32(a1, Qs + 32 * ti * MP, MP, CTs + 32 * tj * MP, MP, 128, lane);
        mma32(a2, Ss + 32 * ti * MP, MP, VTs + 32 * tj * MP, MP, 32 * (ti + 1), lane);
        float num[16];
#pragma unroll
        for (int i = 0; i < 16; ++i) num[i] = s_iw[32 * ti + crow(i, h)] * a1[i] + a2[i];
        if (tj == 1 && r == 0) {
#pragma unroll
            for (int i = 0; i < 16; ++i) s_den[32 * ti + crow(i, h)] = num[i]; }
        mma32(up, KTs + 32 * ti * MP, MP, VWTs + 32 * tj * MP, MP, 128, lane);
#pragma unroll
        for (int i = 0; i < 16; ++i) accC[i] = carry * accC[i] + up[i];
        __syncthreads();
        if (tj == 0) {
#pragma unroll
            for (int i = 0; i < 16; ++i) { const int trow = 32 * ti + crow(i, h); const float hv = num[i] / fmaxf(fabsf(s_den[trow]), s_emt[trow]);
                const int grow = base + (dir ? 127 - trow : trow);
                float* dst = grow < NCTX ? XC + (size_t)grow * DM : p.out + (size_t)(grow - NCTX) * DM;
                dst[dir * 512 + head * 128 + dvq * 32 + r] = hv; } }
        if (tj == 0 || r == 0) {
#pragma unroll
            for (int g = 0; g < 4; ++g) { u32x2 o; o.x = cvtpk(accC[4 * g], accC[4 * g + 1]); o.y = cvtpk(accC[4 * g + 2], accC[4 * g + 3]);
                *(LAS u32x2*)(CTs + (32 * tj + r) * MP + 32 * ti + 8 * g + 4 * h) = o; } }
        m = mnew;
    }
    __syncthreads();
}


constexpr int NCH = 34, UROWS = 129;
constexpr size_t WS_MSC = WS_GATES + 2560 * 1024;
DI int chunk_base(int b, int cp) { return cp < 2 ? b * CTXL + cp * 128 : NCTX + b * SEQ + (cp - 2) * 128; }
DI float shfl_up_l(float v, int o, int lane) { return __int_as_float(__builtin_amdgcn_ds_bpermute((lane >= o ? lane - o : lane) << 2, __float_as_int(v))); }
DI void chunk_scan(int dir, const LAS float* ic, const LAS float* fc, int lane, float& a0, float& a1, float& pm0, float& pm1, float& bc0, float& bc1, float& blast, float& Mall, int& u0, int& u1) {
    u0 = dir ? 127 - 2 * lane : 2 * lane; u1 = dir ? u0 - 1 : u0 + 1;
    const float f0 = fc[u0], f1 = fc[u1], i0 = ic[u0], i1 = ic[u1];
    float S = f0 + f1;
#pragma unroll
    for (int o = 1; o < 64; o <<= 1) { const float t = shfl_up_l(S, o, lane); if (lane >= o) S += t; }
    bc1 = S; bc0 = S - f1; a0 = i0 - bc0; a1 = i1 - bc1;
    float P = fmaxf(a0, a1);
#pragma unroll
    for (int o = 1; o < 64; o <<= 1) { const float t = shfl_up_l(P, o, lane); if (lane >= o) P = fmaxf(P, t); }
    float Pex = shfl_up_l(P, 1, lane); if (lane == 0) Pex = -INFINITY;
    pm0 = fmaxf(Pex, a0); pm1 = P;
    blast = __int_as_float(__builtin_amdgcn_readlane(__float_as_int(bc1), 63)); Mall = __int_as_float(__builtin_amdgcn_readlane(__float_as_int(P), 63));
}
constexpr int X_VT = 0, X_VWT = UROWS * MP * 2, X_KT = 2 * UROWS * MP * 2, X_SC = X_KT + 128 * MP * 2;
DI void mlstm_x1(const Params& p, LAS unsigned char* lds, int item, int tid_in, int lane_in, int wave) {
    int tid = tid_in; asm volatile("" : "+v"(tid)); const int lane = tid & 63; (void)lane_in;
    const int cp = item % NCH, head = (item / NCH) & 3, b = item / (NCH * 4);
    const bf16* QKV = (const bf16*)(p.ws + WS_BIG); const float* GT = (const float*)(p.ws + WS_GATES);
    bf16* UT = (bf16*)p.out; float* SC = (float*)(p.ws + WS_MSC);
    LAS bf16* VTs = (LAS bf16*)(lds + X_VT); LAS bf16* VWTs = (LAS bf16*)(lds + X_VWT); LAS bf16* KTs = (LAS bf16*)(lds + X_KT);
    LAS float* sc = (LAS float*)(lds + X_SC);
    LAS float* s_w = sc + 512;
    const int base = chunk_base(b, cp);
    const int r = lane & 31, h = lane >> 5;
    const float KSCALE = 0.08838834764831845f;
    __syncthreads();
#pragma unroll
    for (int i = 0; i < 4; ++i) { const int id = tid + 512 * i, rr = id & 127, c = id >> 7;
        const bf16* src = QKV + (size_t)(base + rr) * NIN0 + head * 128 + c * 8;
        const u32x4 k = *(const u32x4*)(src + 512), v = *(const u32x4*)(src + 1024);
        LAS bf16* dk = KTs + (c * 8) * MP + rr; LAS bf16* dv = VTs + (c * 8) * MP + rr;
        dk[0] = (bf16)(k.x & 0xffffu); dk[MP] = (bf16)(k.x >> 16); dk[2 * MP] = (bf16)(k.y & 0xffffu); dk[3 * MP] = (bf16)(k.y >> 16);
        dk[4 * MP] = (bf16)(k.z & 0xffffu); dk[5 * MP] = (bf16)(k.z >> 16); dk[6 * MP] = (bf16)(k.w & 0xffffu); dk[7 * MP] = (bf16)(k.w >> 16);
        dv[0] = (bf16)(v.x & 0xffffu); dv[MP] = (bf16)(v.x >> 16); dv[2 * MP] = (bf16)(v.y & 0xffffu); dv[3 * MP] = (bf16)(v.y >> 16);
        dv[4 * MP] = (bf16)(v.z & 0xffffu); dv[5 * MP] = (bf16)(v.z >> 16); dv[6 * MP] = (bf16)(v.w & 0xffffu); dv[7 * MP] = (bf16)(v.w >> 16); }
    { const int u = tid & 127, gi = tid >> 7; sc[gi * 128 + u] = GT[(size_t)(base + u) * 16 + gi * 4 + head]; }
    __syncthreads();
    if (wave < 2) { const int dir = wave; float a0, a1, pm0, pm1, bc0, bc1, blast, Mall; int u0, u1;
        chunk_scan(dir, sc + dir * 256, sc + dir * 256 + 128, lane, a0, a1, pm0, pm1, bc0, bc1, blast, Mall, u0, u1);
        s_w[dir * 128 + u0] = __expf(a0 - Mall) * KSCALE; s_w[dir * 128 + u1] = __expf(a1 - Mall) * KSCALE;
        if (lane == 0) { float* o = SC + ((size_t)((b * 4 + head) * 2 + dir) * NCH + cp) * 2; o[0] = blast; o[1] = Mall; } }
    __syncthreads();
    for (int dir = 0; dir < 2; ++dir) {
        for (int idx = tid; idx < UROWS * 16; idx += 512) { const int e = idx >> 4, c8 = (idx & 15) * 8;
            const u32x4 v = e < 128 ? *(const LAS u32x4*)(VTs + e * MP + c8) : (u32x4){0x3F803F80u, 0x3F803F80u, 0x3F803F80u, 0x3F803F80u};
            const f32x4 w0 = *(const LAS f32x4*)(s_w + dir * 128 + c8), w1 = *(const LAS f32x4*)(s_w + dir * 128 + c8 + 4);
            u32x4 o; o.x = cvtpk(__uint_as_float(v.x << 16) * w0[0], __uint_as_float(v.x & 0xffff0000u) * w0[1]); o.y = cvtpk(__uint_as_float(v.y << 16) * w0[2], __uint_as_float(v.y & 0xffff0000u) * w0[3]);
            o.z = cvtpk(__uint_as_float(v.z << 16) * w1[0], __uint_as_float(v.z & 0xffff0000u) * w1[1]); o.w = cvtpk(__uint_as_float(v.w << 16) * w1[2], __uint_as_float(v.w & 0xffff0000u) * w1[3]);
            *(LAS u32x4*)(VWTs + e * MP + c8) = o; }
        __syncthreads();
        bf16* Uo = UT + ((size_t)((b * 4 + head) * 2 + dir) * NCH + cp) * (UROWS * 128);
        for (int tile = wave; tile < 20; tile += 8) { const int td = tile & 3, te = tile >> 2;
            f32x16 acc = zero16();
            const LAS bf16* bp = VWTs + (te < 4 ? (32 * te + r) : 128) * MP + 8 * h; const LAS bf16* ap = KTs + (32 * td + r) * MP + 8 * h;
#pragma unroll
            for (int k0 = 0; k0 < 128; k0 += 16) acc = MFMA32(*(const LAS bf16x8*)(ap + k0), *(const LAS bf16x8*)(bp + k0), acc);
            if (te < 4 || r == 0) { bf16* dst = Uo + (size_t)(te < 4 ? 32 * te + r : 128) * 128 + 32 * td + 4 * h;
#pragma unroll
                for (int g = 0; g < 4; ++g) { u32x2 o; o.x = cvtpk(acc[4 * g], acc[4 * g + 1]); o.y = cvtpk(acc[4 * g + 2], acc[4 * g + 3]); *(u32x2*)(dst + 8 * g) = o; } } }
        __syncthreads();
    }
}
DI void mlstm_x2(const Params& p, int tid) {
    const bf16* __restrict__ UT = (const bf16*)p.out; const float* __restrict__ SC = (const float*)(p.ws + WS_MSC); float* __restrict__ MST = (float*)(p.ws + WS_MSC) + 64 * NCH * 2;
    bf16* __restrict__ CT = (bf16*)(p.ws + WS_BIG) + (size_t)MTOT * NIN0;
    constexpr int SZ = UROWS * 128;
    for (int item = blockIdx.x; item < 256; item += gridDim.x) {
        const int chain = item >> 2, part = item & 3, dir = chain & 1;
        const int g1 = part * 512 + tid; const bool has2 = (part == 0) && (tid < 16); const int g2 = 2048 + (tid & 15);
        float c[8], c2[8];
#pragma unroll
        for (int j = 0; j < 8; ++j) { c[j] = 0.f; c2[j] = 0.f; }
        float m = 0.f;
        const size_t cb = (size_t)chain * NCH;
#pragma unroll 1
        for (int half = 0; half < 2; ++half) {
            u32x4 uv[17], uw[17]; f32x2 scv[17];
#pragma unroll
            for (int j = 0; j < 17; ++j) { const int ci = half * 17 + j, cp = dir ? (ci < 2 ? 1 - ci : 35 - ci) : ci;
                uv[j] = *(const u32x4*)(UT + (cb + cp) * SZ + g1 * 8);
                uw[j] = has2 ? *(const u32x4*)(UT + (cb + cp) * SZ + g2 * 8) : (u32x4){0u, 0u, 0u, 0u};
                scv[j] = *(const f32x2*)(SC + (cb + cp) * 2); }
            asm volatile("" ::: "memory");
#pragma unroll
            for (int j = 0; j < 17; ++j) { const int ci = half * 17 + j, cp = dir ? (ci < 2 ? 1 - ci : 35 - ci) : ci;
                const float blast = scv[j].x, Mall = scv[j].y;
                u32x4 o; o.x = cvtpk(c[0], c[1]); o.y = cvtpk(c[2], c[3]); o.z = cvtpk(c[4], c[5]); o.w = cvtpk(c[6], c[7]);
                *(u32x4*)(CT + (cb + cp) * SZ + g1 * 8) = o;
                if (has2) { u32x4 o2; o2.x = cvtpk(c2[0], c2[1]); o2.y = cvtpk(c2[2], c2[3]); o2.z = cvtpk(c2[4], c2[5]); o2.w = cvtpk(c2[6], c2[7]); *(u32x4*)(CT + (cb + cp) * SZ + g2 * 8) = o2; }
                if (part == 0 && tid == 0) MST[cb + cp] = m;
                const float mnew = blast + fmaxf(m, Mall), cw = __expf(blast + m - mnew), uwt = __expf(blast + Mall - mnew);
                const u32x4 a = uv[j], b2 = uw[j];
                c[0] = cw * c[0] + uwt * __uint_as_float(a.x << 16); c[1] = cw * c[1] + uwt * __uint_as_float(a.x & 0xffff0000u);
                c[2] = cw * c[2] + uwt * __uint_as_float(a.y << 16); c[3] = cw * c[3] + uwt * __uint_as_float(a.y & 0xffff0000u);
                c[4] = cw * c[4] + uwt * __uint_as_float(a.z << 16); c[5] = cw * c[5] + uwt * __uint_as_float(a.z & 0xffff0000u);
                c[6] = cw * c[6] + uwt * __uint_as_float(a.w << 16); c[7] = cw * c[7] + uwt * __uint_as_float(a.w & 0xffff0000u);
                c2[0] = cw * c2[0] + uwt * __uint_as_float(b2.x << 16); c2[1] = cw * c2[1] + uwt * __uint_as_float(b2.x & 0xffff0000u);
                c2[2] = cw * c2[2] + uwt * __uint_as_float(b2.y << 16); c2[3] = cw * c2[3] + uwt * __uint_as_float(b2.y & 0xffff0000u);
                c2[4] = cw * c2[4] + uwt * __uint_as_float(b2.z << 16); c2[5] = cw * c2[5] + uwt * __uint_as_float(b2.z & 0xffff0000u);
                c2[6] = cw * c2[6] + uwt * __uint_as_float(b2.w << 16); c2[7] = cw * c2[7] + uwt * __uint_as_float(b2.w & 0xffff0000u);
                m = mnew; }
        }
    }
}
constexpr int Y_VT = 0, Y_S = UROWS * MP * 2, Y_C = Y_S + 128 * MP * 2, Y_SC = Y_C + 2 * UROWS * MP * 2;
static_assert(Y_SC + 7168 <= LDS_BYTES - 16, "X3 LDS map");
DI void mlstm_x3(const Params& p, LAS unsigned char* lds, int item, int tid_in, int lane_in, int wave) {
    (void)tid_in; (void)lane_in;
    int tid = wave * 64 + fresh_lane(); asm volatile("" : "+v"(tid)); const int lane = tid & 63;
    const int cp = item % NCH, head = (item / NCH) & 3, b = item / (NCH * 4);
    const bf16* QKV = (const bf16*)(p.ws + WS_BIG); const float* GT = (const float*)(p.ws + WS_GATES);
    const float* MST = (const float*)(p.ws + WS_MSC) + 64 * NCH * 2;
    const bf16* CT = (const bf16*)(p.ws + WS_BIG) + (size_t)MTOT * NIN0;
    bf16* OC = (bf16*)(p.ws + WS_OCAT);
    { size_t z0 = 0; asm volatile("" : "+s"(z0)); QKV += z0; CT += z0; OC += z0; GT += z0; }
    LAS bf16* VTs = (LAS bf16*)(lds + Y_VT); LAS bf16* Ss = (LAS bf16*)(lds + Y_S);
    LAS float* sc = (LAS float*)(lds + Y_SC);
    LAS float* s_dir = sc + 512; LAS float* s_ssq = sc + 512 + 1024;
    LAS bf16* Cs = (LAS bf16*)(lds + Y_C);
    const int base = chunk_base(b, cp);
    const int r_ = lane & 31, h = lane >> 5, ti = wave >> 1, eh = wave & 1;
    const float KSCALE = 0.08838834764831845f;
    __syncthreads();
    const float mst0 = MST[(size_t)((b * 4 + head) * 2) * NCH + cp], mst1 = MST[(size_t)((b * 4 + head) * 2 + 1) * NCH + cp];
    u32x4 vr[4];
#pragma unroll
    for (int i = 0; i < 4; ++i) { const int id = tid + 512 * i, rr = id & 127, c = id >> 7; vr[i] = *(const u32x4*)(QKV + (size_t)(base + rr) * NIN0 + 1024 + head * 128 + c * 8); }
    const float gval = GT[(size_t)(base + (tid & 127)) * 16 + (tid >> 7) * 4 + head];
    u32x4 cb[9];
    { const bf16* C0 = CT + ((size_t)((b * 4 + head) * 2) * NCH + cp) * (UROWS * 128);
#pragma unroll
      for (int i = 0; i < 9; ++i) { const int id = tid + 512 * i; const int idc = id < 2 * UROWS * 16 ? id : 0; const int dd = idc >= UROWS * 16, q = idc - dd * UROWS * 16;
          cb[i] = *(const u32x4*)(C0 + (size_t)dd * NCH * (UROWS * 128) + q * 8); } }
    bf16x8 qf[8], kf[2][8];
    { const bf16* qp = QKV + (size_t)(base + 32 * ti + r_) * NIN0 + head * 128 + 8 * h;
#pragma unroll
        for (int ks = 0; ks < 8; ++ks) qf[ks] = *(const bf16x8*)(qp + 16 * ks); }
#pragma unroll
    for (int tt = 0; tt < 2; ++tt) { const bf16* kp = QKV + (size_t)(base + 32 * (2 * eh + tt) + r_) * NIN0 + 512 + head * 128 + 8 * h;
#pragma unroll
        for (int ks = 0; ks < 8; ++ks) kf[tt][ks] = *(const bf16x8*)(kp + 16 * ks); }
    asm volatile("" ::: "memory");
#pragma unroll
    for (int i = 0; i < 4; ++i) { const int id = tid + 512 * i, rr = id & 127, c = id >> 7; const u32x4 v = vr[i];
        LAS bf16* dv = VTs + (c * 8) * MP + rr;
        dv[0] = (bf16)(v.x & 0xffffu); dv[MP] = (bf16)(v.x >> 16); dv[2 * MP] = (bf16)(v.y & 0xffffu); dv[3 * MP] = (bf16)(v.y >> 16);
        dv[4 * MP] = (bf16)(v.z & 0xffffu); dv[5 * MP] = (bf16)(v.z >> 16); dv[6 * MP] = (bf16)(v.w & 0xffffu); dv[7 * MP] = (bf16)(v.w >> 16); }
    if (tid < 128) VTs[128 * MP + tid] = 0x3F80;
    sc[(tid >> 7) * 128 + (tid & 127)] = gval;
#pragma unroll
    for (int i = 0; i < 9; ++i) { const int id = tid + 512 * i; if (id < 2 * UROWS * 16) { const int dd = id >= UROWS * 16, q = id - dd * UROWS * 16, e = q >> 4, c8 = (q & 15) * 8;
        *(LAS u32x4*)(Cs + (dd * UROWS + e) * MP + c8) = cb[i]; } }
    unsigned spk[2][8];
#pragma unroll
    for (int tt = 0; tt < 2; ++tt) { f32x16 sraw = zero16();
#pragma unroll
        for (int ks = 0; ks < 8; ++ks) sraw = MFMA32(qf[ks], kf[tt][ks], sraw);
#pragma unroll
        for (int i = 0; i < 8; ++i) spk[tt][i] = cvtpk(sraw[2 * i], sraw[2 * i + 1]); }
    __syncthreads();
    if (wave < 2) { const int dir = wave; float a0, a1, pm0, pm1, bc0, bc1, blast, Mall; int u0, u1;
        chunk_scan(dir, sc + dir * 256, sc + dir * 256 + 128, lane, a0, a1, pm0, pm1, bc0, bc1, blast, Mall, u0, u1);
        const float m = dir ? mst1 : mst0;
        const float rt0 = -fmaxf(m, pm0), rt1 = -fmaxf(m, pm1);
        LAS float* d = s_dir + dir * 512;
        d[u0] = a0; d[u1] = a1; d[128 + u0] = rt0; d[128 + u1] = rt1; d[256 + u0] = __expf(m + rt0); d[256 + u1] = __expf(m + rt1);
        d[384 + u0] = __expf(rt0 - bc0); d[384 + u1] = __expf(rt1 - bc1); }
    f32x16 hs[2]; hs[0] = zero16(); hs[1] = zero16();
#pragma unroll 1
    for (int dir = 0; dir < 2; ++dir) {
        __syncthreads();
        const LAS float* d = s_dir + dir * 512;
        int r = r_; asm volatile("" : "+v"(r));
#pragma unroll
        for (int tt = 0; tt < 2; ++tt) { const int tj = 2 * eh + tt; const bool need = dir ? (tj >= ti) : (tj <= ti);
            if (need) {
                const int scol = 32 * tj + r; const float as = d[scol];
#pragma unroll
                for (int i = 0; i < 16; ++i) { const int trow = 32 * ti + crow(i, h); const bool ok = dir ? (scol >= trow) : (scol <= trow);
                    const float e = ok ? __expf(as + d[128 + trow]) * KSCALE : 0.f;
                    const float sv = (i & 1) ? __uint_as_float(spk[tt][i >> 1] & 0xffff0000u) : __uint_as_float(spk[tt][i >> 1] << 16); Ss[trow * MP + scol] = f2bf(sv * e); } } }
        __syncthreads();
        asm volatile("" ::: "memory");
        const LAS bf16* Cb = Cs + dir * UROWS * MP;
        const int klo = dir ? 32 * ti : 0, khi = dir ? 128 : 32 * (ti + 1);
        const LAS bf16* sp = Ss + (32 * ti + r) * MP + 8 * h;
        {
            f32x16 a1 = zero16(), a2 = zero16();
            const LAS bf16* cpp = Cb + 128 * MP + 8 * h;
#pragma unroll
            for (int ks = 0; ks < 8; ++ks) a1 = MFMA32(qf[ks], *(const LAS bf16x8*)(cpp + 16 * ks), a1);
            const LAS bf16* vp = VTs + 128 * MP + 8 * h;
#pragma unroll 1
            for (int k0 = klo; k0 < khi; k0 += 16) a2 = MFMA32(*(const LAS bf16x8*)(sp + k0), *(const LAS bf16x8*)(vp + k0), a2);
            if (r == 0) {
#pragma unroll
            for (int i = 0; i < 16; ++i) { const int trow = 32 * ti + crow(i, h); sc[trow] = 1.f / fmaxf(fabsf(d[256 + trow] * a1[i] + a2[i]), d[384 + trow]); } }
        }
        asm volatile("" ::: "memory");
#pragma unroll
        for (int tt = 0; tt < 2; ++tt) { const int te = 2 * eh + tt;
            f32x16 a1 = zero16(), a2 = zero16();
            const LAS bf16* cpp = Cb + (32 * te + r) * MP + 8 * h;
#pragma unroll
            for (int ks = 0; ks < 8; ++ks) a1 = MFMA32(qf[ks], *(const LAS bf16x8*)(cpp + 16 * ks), a1);
            const LAS bf16* vp = VTs + (32 * te + r) * MP + 8 * h;
#pragma unroll 1
            for (int k0 = klo; k0 < khi; k0 += 16) a2 = MFMA32(*(const LAS bf16x8*)(sp + k0), *(const LAS bf16x8*)(vp + k0), a2);
#pragma unroll
            for (int i = 0; i < 16; ++i) { const int trow = 32 * ti + crow(i, h); hs[tt][i] += (d[256 + trow] * a1[i] + a2[i]) * sc[trow]; }
            asm volatile("" ::: "memory"); }
    }
#pragma unroll
    for (int i = 0; i < 16; ++i) { float q = hs[0][i] * hs[0][i] + hs[1][i] * hs[1][i];
#pragma unroll
        for (int o = 1; o < 32; o <<= 1) q += __int_as_float(__builtin_amdgcn_ds_bpermute((lane ^ o) << 2, __float_as_int(q)));
        if (r_ == 0) s_ssq[(32 * ti + crow(i, h)) * 2 + eh] = q; }
    __syncthreads();
    LAS float* Hs = (LAS float*)(lds + Y_C);
#pragma unroll
    for (int i = 0; i < 16; ++i) { const int trow = 32 * ti + crow(i, h);
        const float rs = rsqrtf((s_ssq[trow * 2] + s_ssq[trow * 2 + 1]) * (1.f / 128.f) + EPS);
        Hs[trow * 132 + 32 * (2 * eh) + r_] = hs[0][i] * rs; Hs[trow * 132 + 32 * (2 * eh + 1) + r_] = hs[1][i] * rs; }
    __syncthreads();
    const float* gn = p.in[10] + head * 128;
    const int c8o = (tid & 15) * 8;
    const f32x4 g0 = *(const f32x4*)(gn + c8o), g1 = *(const f32x4*)(gn + c8o + 4);
    u32x4 oav[4];
#pragma unroll
    for (int it = 0; it < 4; ++it) { const int row = (tid + 512 * it) >> 4; oav[it] = *(const u32x4*)(QKV + (size_t)(base + row) * NIN0 + 1536 + head * 128 + c8o); }
    asm volatile("" ::: "memory");
#pragma unroll
    for (int it = 0; it < 4; ++it) { const int row = (tid + 512 * it) >> 4; const size_t grow = base + row; const u32x4 oa = oav[it];
        const f32x4 v0 = *(const LAS f32x4*)(Hs + row * 132 + c8o), v1 = *(const LAS f32x4*)(Hs + row * 132 + c8o + 4);
        float o[8]; o[0] = __uint_as_float(oa.x << 16); o[1] = __uint_as_float(oa.x & 0xffff0000u); o[2] = __uint_as_float(oa.y << 16); o[3] = __uint_as_float(oa.y & 0xffff0000u);
        o[4] = __uint_as_float(oa.z << 16); o[5] = __uint_as_float(oa.z & 0xffff0000u); o[6] = __uint_as_float(oa.w << 16); o[7] = __uint_as_float(oa.w & 0xffff0000u);
        u32x4 w;
        w.x = cvtpk(v0[0] * g0[0] / (1.f + __expf(-o[0])), v0[1] * g0[1] / (1.f + __expf(-o[1]))); w.y = cvtpk(v0[2] * g0[2] / (1.f + __expf(-o[2])), v0[3] * g0[3] / (1.f + __expf(-o[3])));
        w.z = cvtpk(v1[0] * g1[0] / (1.f + __expf(-o[4])), v1[1] * g1[1] / (1.f + __expf(-o[5]))); w.w = cvtpk(v1[2] * g1[2] / (1.f + __expf(-o[6])), v1[3] * g1[3] / (1.f + __expf(-o[7])));
        *(u32x4*)(OC + grow * DM + head * 128 + c8o) = w; }
}

template <int D, int MODE, int NSUB>
DI void attn_item(const bf16* QKV, int pitch, int qcol0, int kcol0, const bf16* VT, bf16* O, int ocol0, const float* sink,
                  LAS unsigned char* lds, int item, int tid_in, int lane_in, int wave) {
    (void)tid_in; (void)lane_in;
    int tid = wave * 64 + fresh_lane(); asm volatile("" : "+v"(tid)); const int lane = tid & 63;
    constexpr int KT = 64 * NSUB, KP = D + 8, VP = KT + 4, KBYTES = KT * KP * 2, VBYTES = D * VP * 2, BUF = KBYTES + VBYTES, NPT = NSUB * D / 64, NKS = D / 16, NDT = D / 32, CPR = D / 8, VCR = 8 * NSUB;
    static_assert(2 * BUF <= LDS_BYTES - 16, "attention LDS");
    const int r = lane & 31, h = lane >> 5;
    int b, kvh, head, qrow, qpos = 0, nt, wstart = 0;
    if (MODE == 0) { const int qb = item & 15; head = (item >> 4) & 7; b = item >> 7; kvh = head >> 2; qrow = NCTX + b * SEQ + qb * 256 + 32 * wave; nt = KVLEN / KT; }
    else if (MODE == 1) { const int nb = item & 31, hp = (item >> 5) & 1; kvh = (item >> 6) & 1; b = item >> 7; head = kvh * 4 + hp * 2 + (wave >> 2);
        qpos = nb * 128 + (wave & 3) * 32 + r; qrow = NCTX + b * SEQ + nb * 128 + (wave & 3) * 32;
        wstart = nb > 0 ? (nb - 1) * 128 : 0; const int wend = nb < 31 ? (nb + 2) * 128 : SEQ; nt = (CTXL + wend - wstart) / KT; }
    else { const int qh = item & 1, hp = (item >> 1) & 1; kvh = (item >> 2) & 1; b = item >> 3; head = kvh * 4 + hp * 2 + (wave >> 2); qrow = b * 256 + qh * 128 + (wave & 3) * 32; nt = CTXL / KT; }
    const bf16* VTb = VT + (size_t)(b * 2 + kvh) * D * KVLEN;
    const int kcol = kcol0 + kvh * D;
    bf16x8 qf[NKS];
    { const bf16* qp = QKV + (size_t)(qrow + r) * pitch + qcol0 + head * D + 8 * h;
#pragma unroll
        for (int ks = 0; ks < NKS; ++ks) qf[ks] = *(const bf16x8*)(qp + 16 * ks); }
    const float scl = (D == 64 ? 0.125f : 0.08838834764831845f) * LOG2E;
    constexpr float THR2 = 11.0f;
    float mrun, lrun;
    if (MODE == 0) { mrun = -INFINITY; lrun = 0.f; } else { mrun = sink[head] * LOG2E; lrun = h == 0 ? 1.f : 0.f; }
    f32x16 o[NDT];
#pragma unroll
    for (int dt = 0; dt < NDT; ++dt) o[dt] = zero16();
    u32x4 kr[NPT], vr[NPT];
#define ATT_TILE(t, krow0, vkey0) do { const int key0 = KT * (t); if (MODE == 0) { krow0 = key0 < CTXL ? b * CTXL + key0 : NCTX + b * SEQ + key0 - CTXL; vkey0 = key0; } \
        else if (key0 < CTXL) { krow0 = b * CTXL + key0; vkey0 = key0; } else { const int kp_ = wstart + key0 - CTXL; krow0 = NCTX + b * SEQ + kp_; vkey0 = CTXL + kp_; } } while (0)
#define ATT_LOAD(t) do { int krow0, vkey0; ATT_TILE(t, krow0, vkey0); _Pragma("unroll") for (int i = 0; i < NPT; ++i) { const int id = tid + 512 * i; \
        kr[i] = *(const u32x4*)(QKV + (size_t)(krow0 + id / CPR) * pitch + kcol + (id % CPR) * 8); \
        vr[i] = *(const u32x4*)(VTb + (size_t)(id / VCR) * KVLEN + vkey0 + (id % VCR) * 8); } } while (0)
#define ATT_STORE(bi) do { LAS bf16* Kd = (LAS bf16*)(lds + (bi) * BUF); LAS bf16* Vd = (LAS bf16*)(lds + (bi) * BUF + KBYTES); _Pragma("unroll") for (int i = 0; i < NPT; ++i) { const int id = tid + 512 * i; \
        *(LAS u32x4*)(Kd + (id / CPR) * KP + (id % CPR) * 8) = kr[i]; { LAS u32x2* vd_ = (LAS u32x2*)(Vd + (id / VCR) * VP + (id % VCR) * 8); vd_[0] = (u32x2){vr[i].x, vr[i].y}; vd_[1] = (u32x2){vr[i].z, vr[i].w}; } } } while (0)
    ATT_LOAD(0); ATT_STORE(0);
    __syncthreads();
    for (int t = 0; t < nt; ++t) {
        if (t + 1 < nt) ATT_LOAD(t + 1);
        const LAS bf16* Kt = (const LAS bf16*)(lds + (t & 1) * BUF); const LAS bf16* Vt = (const LAS bf16*)(lds + (t & 1) * BUF + KBYTES);
#pragma unroll
        for (int sub = 0; sub < NSUB; ++sub) {
        f32x16 s[2];
#pragma unroll
        for (int q = 0; q < 2; ++q) { s[q] = zero16(); const LAS bf16* kp = Kt + (64 * sub + 32 * q + r) * KP + 8 * h;
#pragma unroll
            for (int ks = 0; ks < NKS; ++ks) s[q] = MFMA32(*(const LAS bf16x8*)(kp + 16 * ks), qf[ks], s[q]); }
        if (MODE == 1 && KT * t >= CTXL) { const int kp0 = wstart + KT * t + 64 * sub - CTXL - qpos;
#pragma unroll
            for (int q = 0; q < 2; ++q)
#pragma unroll
                for (int i = 0; i < 16; ++i) { const int d0 = kp0 + 32 * q + crow(i, h); if (d0 > 128 || d0 < -128) s[q][i] = -INFINITY; } }
        float mx = s[0][0];
#pragma unroll
        for (int q = 0; q < 2; ++q)
#pragma unroll
            for (int i = 0; i < 16; ++i) mx = fmaxf(mx, s[q][i]);
        mx = fmaxf(mx, __shfl_xor(mx, 32)) * scl;
        if (!__all(mx - mrun <= THR2)) {
            const float mnew = fmaxf(mrun, mx), alpha = __builtin_amdgcn_exp2f(mrun - mnew);
            lrun *= alpha; mrun = mnew;
#pragma unroll
            for (int dt = 0; dt < NDT; ++dt)
#pragma unroll
                for (int i = 0; i < 16; ++i) o[dt][i] *= alpha;
        }
        float ls = 0.f; const float nm = -mrun;
#pragma unroll
        for (int q = 0; q < 2; ++q)
#pragma unroll
            for (int i = 0; i < 16; ++i) { s[q][i] = __builtin_amdgcn_exp2f(fmaf(s[q][i], scl, nm)); ls += s[q][i]; }
        lrun += ls;
#pragma unroll
        for (int q = 0; q < 2; ++q)
#pragma unroll
            for (int s2 = 0; s2 < 2; ++s2) {
                u32x4 pw; pw.x = cvtpk(s[q][8 * s2], s[q][8 * s2 + 1]); pw.y = cvtpk(s[q][8 * s2 + 2], s[q][8 * s2 + 3]); pw.z = cvtpk(s[q][8 * s2 + 4], s[q][8 * s2 + 5]); pw.w = cvtpk(s[q][8 * s2 + 6], s[q][8 * s2 + 7]);
                const bf16x8 pb = __builtin_bit_cast(bf16x8, pw);
#pragma unroll
                for (int dt = 0; dt < NDT; ++dt) { const LAS bf16* vp = Vt + (32 * dt + r) * VP + 64 * sub + 32 * q + 16 * s2 + 4 * h;
                    const s16x4 lo = *(const LAS s16x4*)vp, hi = *(const LAS s16x4*)(vp + 8);
                    const bf16x8 a = __builtin_shufflevector(lo, hi, 0, 1, 2, 3, 4, 5, 6, 7);
                    o[dt] = MFMA32(a, pb, o[dt]); }
            }
        }
        if (t + 1 < nt) ATT_STORE((t + 1) & 1);
        __syncthreads();
    }
#undef ATT_TILE
#undef ATT_LOAD
#undef ATT_STORE
    const float inv = 1.f / (lrun + __shfl_xor(lrun, 32));
    bf16* op = O + (size_t)(qrow + r) * DM + ocol0 + head * D + 4 * h;
#pragma unroll
    for (int dt = 0; dt < NDT; ++dt)
#pragma unroll
        for (int g = 0; g < 4; ++g) { u32x2 w; w.x = cvtpk(o[dt][4 * g] * inv, o[dt][4 * g + 1] * inv); w.y = cvtpk(o[dt][4 * g + 2] * inv, o[dt][4 * g + 3] * inv);
            *(u32x2*)(op + 32 * dt + 8 * g) = w; }
}


namespace adb {
using bf16 = unsigned short;
using bf16x8 = __attribute__((ext_vector_type(8))) short;
using s16x4  = __attribute__((ext_vector_type(4))) short;
using f32x16 = __attribute__((ext_vector_type(16))) float;
using u32x4  = __attribute__((ext_vector_type(4))) unsigned;
using ::crow; using ::cvtpk;
constexpr int   D = 128, NW = 8, QBLK = 32, KVBLK = 64;
constexpr float SCALE = 0.088388347648318440f;
constexpr float THR = 8.f;
constexpr int SDEPTH = 2;
constexpr int LDQ = 1536, LDK = 128, LDO = 1024;
constexpr size_t SHM_V = KVBLK * D * 2, SHM_K = KVBLK * D * 2, SHM_ATTN = 2 * SHM_V + 2 * SHM_K + NW * 64 * 4;
#define KSWZ(row, colB) ((row) * 256 + ((colB) ^ (((row) & 7) << 4)))
#define SBAR() __builtin_amdgcn_sched_barrier(0)
template <typename TIn> struct Stage;
template <> struct Stage<bf16>  { using T = bf16x8;
  __device__ static __forceinline__ T ld8(const bf16* p) { return *reinterpret_cast<const bf16x8*>(p); }
  __device__ static __forceinline__ bf16x8 tobf(T x) { return x; } };

__device__ __forceinline__ void partialSM(f32x16& p0, f32x16& p1, float& m_reg, float& mn, float& alpha) {
  constexpr float C = SCALE * 1.4426950408889634f;
  float pmax = p0[0]; for (int r = 1; r < 16; ++r) pmax = fmaxf(pmax, p0[r]); for (int r = 0; r < 16; ++r) pmax = fmaxf(pmax, p1[r]);
  { auto rr = __builtin_amdgcn_permlane32_swap(__float_as_uint(pmax), __float_as_uint(pmax), false, false);
    pmax = fmaxf(__uint_as_float(rr[0]), __uint_as_float(rr[1])); }
  if (__builtin_expect(__all(pmax - m_reg <= THR / SCALE), 1)) { mn = m_reg; alpha = 1.f; }
  else { mn = fmaxf(m_reg, pmax); alpha = __builtin_amdgcn_exp2f((m_reg - mn) * C); m_reg = mn; }
  float mnC = -mn * C;
  for (int r = 0; r < 16; ++r) p0[r] = fmaf(p0[r], C, mnC); for (int r = 0; r < 16; ++r) p1[r] = fmaf(p1[r], C, mnC);
  for (int r = 0; r < 16; ++r) p0[r] = __builtin_amdgcn_exp2f(p0[r]);
}
__device__ __forceinline__ void finishSM(f32x16& p0, f32x16& p1, float alpha, float& l_reg, bf16x8& pa0, bf16x8& pa1, bf16x8& pa2, bf16x8& pa3) {
  for (int r = 0; r < 16; ++r) p1[r] = __builtin_amdgcn_exp2f(p1[r]);
  float ps = 0; for (int r = 0; r < 16; ++r) ps += p0[r]; for (int r = 0; r < 16; ++r) ps += p1[r];
  { auto rr = __builtin_amdgcn_permlane32_swap(__float_as_uint(ps), __float_as_uint(ps), false, false);
    ps = __uint_as_float(rr[0]) + __uint_as_float(rr[1]); }
  l_reg = l_reg * alpha + ps;
#define PK4(P, BASE, OUT) do { unsigned a0 = cvtpk(P[BASE + 0], P[BASE + 1]), a1 = cvtpk(P[BASE + 2], P[BASE + 3]);   \
    unsigned b0 = cvtpk(P[BASE + 4], P[BASE + 5]), b1 = cvtpk(P[BASE + 6], P[BASE + 7]);                              \
    auto r0 = __builtin_amdgcn_permlane32_swap(a0, b0, false, false); auto r1 = __builtin_amdgcn_permlane32_swap(a1, b1, false, false); \
    u32x4 w = {r0[0], r1[0], r0[1], r1[1]}; OUT = *reinterpret_cast<bf16x8*>(&w); } while (0)
  PK4(p0, 0, pa0); PK4(p0, 8, pa1); PK4(p1, 0, pa2); PK4(p1, 8, pa3);
#undef PK4
}
__device__ __forceinline__ void qkt(f32x16& p0, f32x16& p1, const bf16* Ks, const bf16x8* qr, int r32, int hi) {
  p0 = f32x16{}; p1 = f32x16{};
  for (int d0 = 0; d0 < 8; ++d0) { int cb = (d0 * 16 + hi * 8) * 2;
    bf16x8 b0 = *reinterpret_cast<const bf16x8*>((const char*)Ks + KSWZ(r32, cb));
    bf16x8 b1 = *reinterpret_cast<const bf16x8*>((const char*)Ks + KSWZ(32 + r32, cb));
    p0 = __builtin_amdgcn_mfma_f32_32x32x16_bf16(b0, qr[d0], p0, 0, 0, 0);
    p1 = __builtin_amdgcn_mfma_f32_32x32x16_bf16(b1, qr[d0], p1, 0, 0, 0); }
}
__device__ __forceinline__ int v_st(int k, int c) { const int kk = (k & ~0xC) | ((k & 4) << 1) | ((k & 8) >> 1); return ((kk >> 3) * 4 + (c >> 5)) * 512 + ((kk & 7) * 32 + (c & 31)) * 2; }
__device__ __forceinline__ int v_rd_base(int lane) { return ((lane & 3) << 3) | (((lane >> 2) & 3) << 6) | (((lane >> 4) & 1) << 5) | (((lane >> 5) & 1) << 8); }
constexpr int v_rd_off(int d0, int ks, int half) { return d0 * 512 + ks * 4096 + half * 2048; }
template <int OFF> __device__ __forceinline__ s16x4 tr_read(int vb) {
  s16x4 r; asm volatile("ds_read_b64_tr_b16 %0, %1 offset:%2" : "=&v"(r) : "v"(vb), "i"(OFF) : "memory"); return r;
}
template <int D0> __device__ __forceinline__ void pv_one(f32x16& od, int vb, bf16x8 pa0, bf16x8 pa1, bf16x8 pa2, bf16x8 pa3) {
  const s16x4 l0 = tr_read<v_rd_off(D0, 0, 0)>(vb), h0 = tr_read<v_rd_off(D0, 0, 1)>(vb), l1 = tr_read<v_rd_off(D0, 1, 0)>(vb), h1 = tr_read<v_rd_off(D0, 1, 1)>(vb);
  const s16x4 l2 = tr_read<v_rd_off(D0, 2, 0)>(vb), h2 = tr_read<v_rd_off(D0, 2, 1)>(vb), l3 = tr_read<v_rd_off(D0, 3, 0)>(vb), h3 = tr_read<v_rd_off(D0, 3, 1)>(vb);
  asm volatile("s_waitcnt lgkmcnt(0)" ::: "memory"); SBAR();
#define PK(L, H) (bf16x8){L[0], L[1], L[2], L[3], H[0], H[1], H[2], H[3]}
  od = __builtin_amdgcn_mfma_f32_32x32x16_bf16(pa0, PK(l0, h0), od, 0, 0, 0);
  od = __builtin_amdgcn_mfma_f32_32x32x16_bf16(pa1, PK(l1, h1), od, 0, 0, 0);
  od = __builtin_amdgcn_mfma_f32_32x32x16_bf16(pa2, PK(l2, h2), od, 0, 0, 0);
  od = __builtin_amdgcn_mfma_f32_32x32x16_bf16(pa3, PK(l3, h3), od, 0, 0, 0);
#undef PK
}
__device__ __forceinline__ void pv_d0(f32x16* o, int vb, bf16x8 pa0, bf16x8 pa1, bf16x8 pa2, bf16x8 pa3) {
  pv_one<0>(o[0], vb, pa0, pa1, pa2, pa3); pv_one<1>(o[1], vb, pa0, pa1, pa2, pa3); pv_one<2>(o[2], vb, pa0, pa1, pa2, pa3); pv_one<3>(o[3], vb, pa0, pa1, pa2, pa3);
}

template <typename TQ>
__device__ __forceinline__ void attn_dense_body(const TQ* __restrict__ Qb, const bf16* __restrict__ Kh, const bf16* __restrict__ Vh,
                                                bf16* __restrict__ Ob, int seq, char* lds, const int tid) {
  using St = Stage<bf16>; using SQ = Stage<TQ>;
  const int wid = __builtin_amdgcn_readfirstlane(tid >> 6), lane = tid & 63, r32 = lane & 31, hi = lane >> 5;
  bf16* V_lds = (bf16*)lds; bf16* K_lds = (bf16*)(lds + 2 * SHM_V);
  float* ws = (float*)(lds + 2 * SHM_V + 2 * SHM_K) + wid * 64; float* li_l = ws; float* al_l = ws + 32;
  float m_reg = -1e30f, l_reg = 0; f32x16 o[4] = {}; bf16x8 qr[8];
  const TQ* Qw = Qb + (long)(wid * QBLK + r32) * LDQ + hi * 8;
#pragma unroll
  for (int d0 = 0; d0 < 8; ++d0) qr[d0] = SQ::tobf(SQ::ld8(Qw + d0 * 16));
  const int sr = tid >> 4, sc = (tid & 15) * 8, vst0 = v_st(sr, sc), vst1 = v_st(32 + sr, sc);
  const int vb0 = (int)(uintptr_t)V_lds + v_rd_base(lane);
  struct { typename St::T vs0, vs1, ks0, ks1; } sr_[SDEPTH];
#define SLOAD(i, k0) do { sr_[i].vs0 = St::ld8(&Vh[(long)((k0) + sr) * LDK + sc]); sr_[i].vs1 = St::ld8(&Vh[(long)((k0) + 32 + sr) * LDK + sc]); \
    sr_[i].ks0 = St::ld8(&Kh[(long)((k0) + sr) * LDK + sc]); sr_[i].ks1 = St::ld8(&Kh[(long)((k0) + 32 + sr) * LDK + sc]); } while (0)
#define SWRITE(b, i) do { *(bf16x8*)((char*)V_lds + (b) * SHM_V + vst0) = St::tobf(sr_[i].vs0);          \
    *(bf16x8*)((char*)V_lds + (b) * SHM_V + vst1) = St::tobf(sr_[i].vs1); int kc = sc * 2;               \
    *(bf16x8*)((char*)K_lds + (b) * SHM_K + KSWZ(sr, kc)) = St::tobf(sr_[i].ks0);                       \
    *(bf16x8*)((char*)K_lds + (b) * SHM_K + KSWZ(32 + sr, kc)) = St::tobf(sr_[i].ks1); } while (0)
#define SWAIT() do { if constexpr (SDEPTH == 2) asm volatile("s_waitcnt vmcnt(4)" ::: "memory"); else asm volatile("s_waitcnt vmcnt(0)" ::: "memory"); } while (0)
#define RESC(a) do { if (__any((a) < 1.f)) { if (hi == 0) al_l[r32] = (a); asm volatile("s_waitcnt lgkmcnt(0)" ::: "memory"); \
    for (int d = 0; d < 4; ++d) for (int r = 0; r < 16; ++r) o[d][r] *= al_l[crow(r, hi)]; } } while (0)
  f32x16 pA0, pA1, pB0, pB1; float mnA, mnB, alA, alB; bf16x8 pa0, pa1, pa2, pa3; const int NT = seq / KVBLK;
  constexpr int SE = 0, SO = SDEPTH - 1;
  SLOAD(SE, 0); asm volatile("s_waitcnt vmcnt(0)" ::: "memory"); SWRITE(0, SE); __syncthreads();
  qkt(pA0, pA1, K_lds, qr, r32, hi); partialSM(pA0, pA1, m_reg, mnA, alA);
  SLOAD(SO, KVBLK); if constexpr (SDEPTH == 2) { if (2 < NT) SLOAD(SE, 2 * KVBLK); }
  SWAIT(); SWRITE(1, SO); __syncthreads();
  for (int j = 1; j + 1 < NT; j += 2) {
    SBAR(); qkt(pB0, pB1, (bf16*)((char*)K_lds + SHM_K), qr, r32, hi);
    finishSM(pA0, pA1, alA, l_reg, pa0, pa1, pa2, pa3); SBAR();
    SLOAD(SO, (j + SDEPTH) * KVBLK); SBAR();
    pv_d0(o, vb0, pa0, pa1, pa2, pa3); partialSM(pB0, pB1, m_reg, mnB, alB);
    __syncthreads(); SWAIT(); SWRITE(0, SE);
    RESC(alB); __syncthreads();
    SBAR(); qkt(pA0, pA1, K_lds, qr, r32, hi);
    finishSM(pB0, pB1, alB, l_reg, pa0, pa1, pa2, pa3); SBAR();
    if (SDEPTH == 1 || j + 3 < NT) SLOAD(SE, (j + 1 + SDEPTH) * KVBLK); SBAR();
    pv_d0(o, vb0 + (int)SHM_V, pa0, pa1, pa2, pa3); partialSM(pA0, pA1, m_reg, mnA, alA);
    __syncthreads(); SWAIT(); SWRITE(1, SO);
    RESC(alA); __syncthreads();
  }
  SBAR(); qkt(pB0, pB1, (bf16*)((char*)K_lds + SHM_K), qr, r32, hi);
  finishSM(pA0, pA1, alA, l_reg, pa0, pa1, pa2, pa3); SBAR();
  pv_d0(o, vb0, pa0, pa1, pa2, pa3); partialSM(pB0, pB1, m_reg, mnB, alB);
  __syncthreads(); RESC(alB);
  finishSM(pB0, pB1, alB, l_reg, pa0, pa1, pa2, pa3); SBAR();
  pv_d0(o, vb0 + (int)SHM_V, pa0, pa1, pa2, pa3);
  if (hi == 0) li_l[r32] = l_reg; asm volatile("s_waitcnt lgkmcnt(0)" ::: "memory");
  float rli[16];
#pragma unroll
  for (int r = 0; r < 16; ++r) rli[r] = __builtin_amdgcn_rcpf(li_l[crow(r, hi)]);
  bf16* Ow = Ob + (long)(wid * QBLK) * LDO;
#pragma unroll
  for (int r = 0; r < 16; ++r) { int orow = crow(r, hi);
    for (int d0 = 0; d0 < 4; ++d0) Ow[(long)orow * LDO + d0 * 32 + r32] = (bf16)(::cvtpk(o[d0][r] * rli[r], 0.f) & 0xffffu); }
#undef SLOAD
#undef SWRITE
#undef SWAIT
#undef RESC
}
#undef SBAR
#undef KSWZ
}

DI void phase_mlstm_out(const Params& p, int lane, int wave) {
    const bf16* QKV = (const bf16*)(p.ws + WS_BIG); bf16* OC = (bf16*)(p.ws + WS_OCAT); const float* XC = (const float*)(p.ws + WS_XC);
    const float* gn = p.in[10];
    const int gw = blockIdx.x * 8 + wave, NGW = gridDim.x * 8;
    for (int row = gw; row < MTOT; row += NGW) {
        const float* hp = row < NCTX ? XC + (size_t)row * DM : p.out + (size_t)(row - NCTX) * DM;
        const bf16* oa = QKV + (size_t)row * NIN0 + 1536;
        bf16* dst = OC + (size_t)row * DM;
#pragma unroll
        for (int hd = 0; hd < 4; ++hd) { const int c0 = hd * 128 + lane, c1 = c0 + 64;
            const float v0 = hp[c0] + hp[512 + c0], v1 = hp[c1] + hp[512 + c1];
            const float rs = rsqrtf(wave_sum(v0 * v0 + v1 * v1) * (1.f / 128.f) + EPS);
            const float o0 = bf2f(oa[c0]), o1 = bf2f(oa[c1]);
            dst[c0] = f2bf(v0 * rs * gn[c0] / (1.f + __expf(-o0))); dst[c1] = f2bf(v1 * rs * gn[c1] / (1.f + __expf(-o1))); }
    }
}


#define XB_TMO      128
#define XB_XCNT(j)  (256  + 64 * (j))
#define XB_XSUB(j)  (1280 + 64 * (j))
#define XB_XGEN(j)  (2304 + 64 * (j))
#define XB_TOP      3328
#define XB_TOPGEN   3392
#define XCD_BAR_WORDS 3456
#define XB_SPIN_CAP (1u << 18)
DI unsigned xb_ld(unsigned* p)              { return __hip_atomic_load(p, __ATOMIC_RELAXED, __HIP_MEMORY_SCOPE_AGENT); }
DI unsigned xb_add(unsigned* p, unsigned v) { return __hip_atomic_fetch_add(p, v, __ATOMIC_RELAXED, __HIP_MEMORY_SCOPE_AGENT); }
DI unsigned xb_xcc_id() { return (unsigned)__builtin_amdgcn_s_getreg((3 << 11) | 20) & 0xFu; }
#define XB_SPIN(cond, bar) do { unsigned _sp = 0; while (cond) { __builtin_amdgcn_s_sleep(1); \
    if ((++_sp & 255u) == 0u) { if (xb_ld(&(bar)[XB_TMO])) break; if (_sp > XB_SPIN_CAP) { atomicAdd(&(bar)[XB_TMO], 1u); break; } } } } while (0)
struct XcdBarrier { unsigned* bar; unsigned x; volatile LAS unsigned* st; };
DI XcdBarrier xcd_barrier_post(unsigned* bar, volatile LAS unsigned* st, int tid) {
    XcdBarrier b; b.bar = bar; b.x = xb_xcc_id(); b.st = st;
    if (tid == 0) (void)xb_add(&bar[XB_XCNT(b.x)], 1u);
    return b;
}
DI void xcd_barrier_complete(unsigned* bar, unsigned x, unsigned& nloc, unsigned& nx) {
    const unsigned G = gridDim.x * gridDim.y * gridDim.z;
    unsigned sum, cnt, mine, sp = 0u;
    for (;;) {
        sum = 0u; cnt = 0u; mine = 0u;
#pragma unroll
        for (unsigned j = 0; j < 16; ++j) { const unsigned c = xb_ld(&bar[XB_XCNT(j)]); sum += c; cnt += (c > 0u) ? 1u : 0u; mine = (j == x) ? c : mine; }
        if (sum == G) break;
        __builtin_amdgcn_s_sleep(1);
        if ((++sp & 255u) == 0u) { if (xb_ld(&bar[XB_TMO])) break; if (sp > XB_SPIN_CAP) { atomicAdd(&bar[XB_TMO], 1u); break; } }
    }
    nloc = mine > 0u ? mine : 1u; nx = cnt > 0u ? cnt : 1u;
}
DI void xcd_barrier(const XcdBarrier& b, int tid) {
    asm volatile("s_waitcnt vmcnt(0)" ::: "memory");
    __syncthreads();
    if (tid == 0) {
        unsigned* bar = b.bar;
        __builtin_amdgcn_s_waitcnt(0);
        unsigned nloc = b.st[0], nx = b.st[1];
        if (nloc == 0u) { xcd_barrier_complete(bar, b.x, nloc, nx); b.st[0] = nloc; b.st[1] = nx; }
        const unsigned old = xb_add(&bar[XB_XSUB(b.x)], 1u);
        const unsigned gen = old / nloc;
        if (old + 1u == (gen + 1u) * nloc) {
            __builtin_amdgcn_fence(__ATOMIC_RELEASE, "agent");
            asm volatile("s_waitcnt vmcnt(0)" ::: "memory");
            const unsigned og = xb_add(&bar[XB_TOP], 1u);
            const unsigned tg = og / nx;
            if (og + 1u == (tg + 1u) * nx) xb_add(&bar[XB_TOPGEN], 1u);
            else XB_SPIN(xb_ld(&bar[XB_TOPGEN]) == tg, bar);
            __builtin_amdgcn_fence(__ATOMIC_ACQUIRE, "agent");
            xb_add(&bar[XB_XGEN(b.x)], 1u);
            asm volatile("s_waitcnt vmcnt(0)" ::: "memory");
        } else {
            XB_SPIN(xb_ld(&bar[XB_XGEN(b.x)]) == gen, bar);
            __builtin_amdgcn_fence(__ATOMIC_ACQUIRE, "agent");
            asm volatile("s_waitcnt vmcnt(0)" ::: "memory");
        }
    }
    __syncthreads();
}
DI void sub_barrier(unsigned* cnt, unsigned n, int tid) {
    asm volatile("s_waitcnt vmcnt(0)" ::: "memory");
    __syncthreads();
    if (tid == 0) {
        __builtin_amdgcn_fence(__ATOMIC_RELEASE, "agent");
        asm volatile("s_waitcnt vmcnt(0)" ::: "memory");
        (void)xb_add(cnt, 1u);
        unsigned sp = 0u; while (xb_ld(cnt) < n) { __builtin_amdgcn_s_sleep(1); if (++sp > (1u << 22)) break; }
        __builtin_amdgcn_fence(__ATOMIC_ACQUIRE, "agent");
        asm volatile("s_waitcnt vmcnt(0)" ::: "memory");
    }
    __syncthreads();
}
#ifndef REP_X1
#define REP_X1 1
#endif
#ifndef REP_X2
#define REP_X2 1
#endif
#ifndef REP_X3
#define REP_X3 1
#endif
#ifndef REP_SYNC
#define REP_SYNC 1
#endif
#ifndef REP_ATTNC
#define REP_ATTNC 1
#endif
#ifndef REP_MLSTM
#define REP_MLSTM 1
#endif
#ifndef REP_SWA
#define REP_SWA 1
#endif
#ifndef REP_UP1
#define REP_UP1 1
#endif
#ifndef REP_NORM
#define REP_NORM 1
#endif
#ifndef REP_PROL
#define REP_PROL 1
#endif
#define GSYNC() do { FRESH_IDS(); for (int s_ = 0; s_ < REP_SYNC; ++s_) xcd_barrier(xbar, tid); } while (0)
__global__ void __launch_bounds__(512, 2) fwd_kernel(Params p) {
    extern __shared__ __attribute__((aligned(16))) unsigned char lds_raw[];
    LAS unsigned char* lds = (LAS unsigned char*)lds_raw;
    cg::grid_group grid = cg::this_grid();
#define FRESH_IDS() int tid_ = wave_s * 64 + fresh_lane(); asm volatile("" : "+v"(tid_)); const int tid = tid_, lane = tid & 63, wave = wave_s; (void)tid; (void)lane; (void)wave
#define run_gemm(...) run_gemm_rng_(__VA_ARGS__, (int)gridDim.x, (int)blockIdx.x, 0, 0x7fffffff, tid)
#define run_gemm_gc(...) run_gemm_rng_(__VA_ARGS__, 0, 0x7fffffff, tid)
#define run_gemm_rng(...) run_gemm_rng_(__VA_ARGS__, tid)
    const int wave_s = __builtin_amdgcn_readfirstlane((int)threadIdx.x >> 6);
    unsigned char* ws = p.ws;
    bf16* WIN0 = (bf16*)(ws + WS_WIN0); bf16* WOUT0 = (bf16*)(ws + WS_WOUT0); bf16* WIN1 = (bf16*)(ws + WS_WIN1); bf16* WOUT1 = (bf16*)(ws + WS_WOUT1);
    bf16* W1 = (bf16*)(ws + WS_W1); bf16* W2 = (bf16*)(ws + WS_W2);
    const float* MOD0 = (const float*)(ws + WS_MOD); const float* MOD1 = MOD0 + 9 * NMODC;
    float* XC = (float*)(ws + WS_XC); bf16* VT = (bf16*)(ws + WS_VT); bf16* H = (bf16*)(ws + WS_H); bf16* OC = (bf16*)(ws + WS_OCAT); bf16* BIG = (bf16*)(ws + WS_BIG);
    const float* x = p.in[0]; const float* ctx = p.in[2];

    unsigned* barw = (unsigned*)(ws + WS_BAR);
    volatile LAS unsigned* bst = (volatile LAS unsigned*)(lds + LDS_BYTES - 16);
    { FRESH_IDS();
      if (tid < 2) bst[tid] = 0u;
      if (blockIdx.x == 0) for (int i = tid; i < 4096; i += 512) barw[i] = 0u; }
    for (int rep_ = 0; rep_ < REP_PROL; ++rep_) { FRESH_IDS();
        phase_prologue(p, lds, tid, lane, wave);
    }
    grid.sync();
    XcdBarrier xbar; { FRESH_IDS(); xbar = xcd_barrier_post(barw, bst, tid); }
    float* RSS = (float*)(ws + WS_RSS); const float* BIAS = (const float*)(ws + WS_BIAS);
    for (int rep_ = 0; rep_ < REP_NORM; ++rep_) { FRESH_IDS(); __syncthreads();
        phase_norm<false>(p, lds, ctx, x, p.in[6], MOD0, 0, H, 0, MTOT, tid, lane, wave);
        phase_bias(p, lane, wave);
    }
    GSYNC();
    { FRESH_IDS();
        run_gemm(lds, H, WIN0, MTOT, NIN0, DM, EpiStore<0>{BIG, NIN0});
        phase_gates(p, lds, H, tid, lane, wave, (int)blockIdx.x, (int)gridDim.x);
    }
    GSYNC();
    for (int rep_ = 0; rep_ < REP_MLSTM; ++rep_) {
    { FRESH_IDS();
        if (rep_ == 0) phase_post<64>(BIG, NIN0, 2048, 8, 2560, 2, 2688, p.in[11], p.in[12], VT, true, lds, tid, lane, wave);
        for (int rx_ = 0; rx_ < REP_X1; ++rx_) for (int item = blockIdx.x; item < 32 * NCH; item += gridDim.x) mlstm_x1(p, lds, item, tid, lane, wave);
    }
    GSYNC();
    { FRESH_IDS();
        const int G_ = (int)gridDim.x, first = ((int)blockIdx.x + G_ - (G_ >> 2)) % G_;
        if (((int)blockIdx.x & 1) == 0) for (int rx_ = 0; rx_ < REP_X2; ++rx_) mlstm_x2(p, tid);
        for (int rep_s = 0; rep_s < REP_SWA; ++rep_s)
        for (int item = first; item < 1024 + 64; item += G_) {
            if (item < 1024) attn_item<64, 1, 2>(BIG, NIN0, 2048, 2560, VT, OC, 512, p.in[13], lds, item, tid, lane, wave);
            else attn_item<64, 2, 2>(BIG, NIN0, 2048, 2560, VT, OC, 512, p.in[13], lds, item - 1024, tid, lane, wave);
        }
        if (((int)blockIdx.x & 1) == 1) for (int rx_ = 0; rx_ < REP_X2; ++rx_) mlstm_x2(p, tid);
    }
    GSYNC();
    { FRESH_IDS();
        for (int rx_ = 0; rx_ < REP_X3; ++rx_) for (int item = blockIdx.x; item < 32 * NCH; item += gridDim.x) mlstm_x3(p, lds, item, tid, lane, wave);
    }
    }
    GSYNC();
    { FRESH_IDS();
        run_gemm(lds, OC + (size_t)NCTX * DM, WOUT0, NLAT, DM, DM, EpiResidN{ctx, x, XC, p.out, MOD0, 2, NCTX, p.in[7], MOD0, 3, H, RSS});
    }
    GSYNC();
    { FRESH_IDS();
        const int NG1 = 32, bid = (int)blockIdx.x, G = (int)gridDim.x;
        const EpiStoreN<1> eup{BIG + (size_t)NCTX * DFF, DFF, RSS, BIAS, NCTX};
        if (bid < NG1) {
            run_gemm_gc(lds, OC, WOUT0, NCTX, DM, DM, EpiResidN{ctx, x, XC, p.out, MOD0, 2, 0, p.in[7], MOD0, 3, H, RSS}, NG1, bid);
            sub_barrier(barw + 3584, NG1, tid);
            run_gemm_gc(lds, H, W1, NCTX, DFF, DM, EpiStoreN<1>{BIG, DFF, RSS, BIAS, 0}, NG1, bid);
            run_gemm_rng(lds, H + (size_t)NCTX * DM, W1, NLAT, DFF, DM, eup, NG1, bid, 0, 96);
        } else {
            run_gemm_rng(lds, H + (size_t)NCTX * DM, W1, NLAT, DFF, DM, eup, G - NG1, bid - NG1, 96, 0x7fffffff);
        }
    }
    GSYNC();
    bf16* BIG1 = BIG + (size_t)16 * 1024 * 1024;
    const int GC = 32;
    { FRESH_IDS();
        run_gemm(lds, BIG + (size_t)NCTX * DFF, W2, NLAT, DM, DFF, EpiResidN{XC, p.out, XC, p.out, MOD0, 5, NCTX, p.in[6] + DM, MOD1, 0, H, RSS + MTOT});
    }
    GSYNC();
    { FRESH_IDS();
        if ((int)blockIdx.x < GC) run_gemm_gc(lds, BIG, W2, NCTX, DM, DFF, EpiResidN{XC, p.out, XC, p.out, MOD0, 5, 0, p.in[6] + DM, MOD1, 0, H, RSS + MTOT}, GC, (int)blockIdx.x);
        else run_gemm_gc(lds, H + (size_t)NCTX * DM, WIN1, NLAT, NIN1, DM, EpiStoreN<0>{BIG1 + (size_t)NCTX * NIN1, NIN1, RSS + MTOT, BIAS + 9 * 4096, NCTX}, (int)gridDim.x - GC, (int)blockIdx.x - GC);
    }
    GSYNC();
    { FRESH_IDS();
        if ((int)blockIdx.x < 48) { run_gemm_gc(lds, H, WIN1, NCTX, NIN1, DM, EpiStoreN<0>{BIG1, NIN1, RSS + MTOT, BIAS + 9 * 4096, 0}, 48, (int)blockIdx.x);
            sub_barrier(barw + 3600, 48, tid);
            phase_post1(BIG1, p.in[16], p.in[17], VT, (bf16*)(ws + WS_V1), lane, wave, 0, NCTX, (int)blockIdx.x, 48); }
        else phase_post1(BIG1, p.in[16], p.in[17], VT, (bf16*)(ws + WS_V1), lane, wave, NCTX, MTOT, (int)blockIdx.x - 48, (int)gridDim.x - 48);
    }
    GSYNC();
    for (int rep_ = 0; rep_ < REP_ATTNC; ++rep_) { FRESH_IDS();
        const int G_ = (int)gridDim.x, vcu = (G_ % 8 == 0) ? ((int)blockIdx.x & 7) * (G_ >> 3) + ((int)blockIdx.x >> 3) : (int)blockIdx.x;
        for (int item = vcu; item < 1024; item += G_) {
            const int qb = item & 15, head = (item >> 4) & 7, b = item >> 7, kvh = head >> 2;
            int tl = wave * 64 + fresh_lane(); asm volatile("" : "+v"(tl));
            const size_t qrow = (size_t)NCTX + (size_t)b * SEQ + qb * 256;
            __syncthreads();
            adb::attn_dense_body<adb::bf16>(BIG1 + qrow * NIN1 + head * 128, VT + (size_t)(b * 2 + kvh) * KVLEN * 128, (const bf16*)(ws + WS_V1) + (size_t)(b * 2 + kvh) * KVLEN * 128,
                                            OC + qrow * DM + head * 128, KVLEN, (char*)lds, tl);
        }
    }
    GSYNC();
    { FRESH_IDS();
        run_gemm(lds, OC + (size_t)NCTX * DM, WOUT1, NLAT, DM, DM, EpiResidN{XC, p.out, XC, p.out, MOD1, 2, NCTX, p.in[7] + DM, MOD1, 3, H, RSS + 2 * MTOT});
    }
    GSYNC();
    for (int rep_ = 0; rep_ < REP_UP1; ++rep_) { FRESH_IDS();
        run_gemm(lds, H + (size_t)NCTX * DM, W1 + (size_t)DFF * DM, NLAT, DFF, DM, EpiStoreN<1>{BIG, DFF, RSS + 2 * MTOT, BIAS + 2 * 9 * 4096, NCTX});
    }
    GSYNC();
    { FRESH_IDS();
        run_gemm(lds, BIG, W2 + (size_t)DFF * DM, NLAT, DM, DFF, EpiResid{XC, p.out, XC, p.out, MOD1, 5, NCTX});
    }
}

extern "C" void kernel_launch(void* const* d_in, const int* in_sizes, int n_in, void* d_out, int out_size, void* d_ws, size_t ws_size, hipStream_t stream) {
    static int grid = 0;
    if (grid == 0) {
        if (n_in != 21 || out_size != NLAT * DM || ws_size < WS_END) { fprintf(stderr, "kernel_launch: unexpected shapes (n_in %d out %d ws %zu)\n", n_in, out_size, ws_size); grid = -1; return; }
        int dev = 0, cus = 0, per_cu = 0;
        hipGetDevice(&dev); hipDeviceGetAttribute(&cus, hipDeviceAttributeMultiprocessorCount, dev);
        hipFuncSetAttribute((const void*)fwd_kernel, hipFuncAttributeMaxDynamicSharedMemorySize, LDS_BYTES);
        hipOccupancyMaxActiveBlocksPerMultiprocessor(&per_cu, (const void*)fwd_kernel, 512, LDS_BYTES);
        if (per_cu < 1) { fprintf(stderr, "kernel_launch: occupancy query says %d blocks per CU\n", per_cu); per_cu = 1; }
        grid = cus * per_cu;
    }
    if (grid < 0) return;
    Params p{};
    for (int i = 0; i < 21; ++i) p.in[i] = (const float*)d_in[i];
    p.out = (float*)d_out; p.ws = (unsigned char*)d_ws;
    void* args[] = {&p};
    hipError_t e = hipLaunchCooperativeKernel((const void*)fwd_kernel, dim3(grid), dim3(512), args, LDS_BYTES, stream);
    if (e != hipSuccess) fprintf(stderr, "cooperative launch failed: %s (grid %d)\n", hipGetErrorString(e), grid);
}
```

```cpp
#include <hip/hip_runtime.h>
#include <hip/hip_cooperative_groups.h>
#include <cstdio>
#include <cstdint>
namespace cg = cooperative_groups;
namespace pg8 {
#define PG8_LAS __attribute__((address_space(3)))
typedef unsigned short bf16_t;
typedef short bf16x8 __attribute__((ext_vector_type(8)));
typedef float f32x4 __attribute__((ext_vector_type(4)));
typedef unsigned u32x4 __attribute__((ext_vector_type(4)));
constexpr int BM = 256, BK = 64, HALF = 128, HTB = HALF * BK * 2  , STAGE_BYTES = 8 * HTB, NXCD = 8, WGM = 8;

__host__ __device__ __forceinline__ int lds_byte(int r, int c) { const int st = (r >> 4) * 2 + (c >> 5), rr = r & 15, cc = c & 31, ob = rr * 64 + cc * 2; return st * 1024 + (ob ^ (((ob >> 9) & 1) << 5)); }
__host__ __device__ __forceinline__ void stage_rc(int b, int& R, int& C) { const int st = b / 1024, sb = b % 1024, swz = sb ^ (((sb >> 9) & 1) << 5); R = (st >> 1) * 16 + swz / 64; C = (st & 1) * 32 + (swz % 64) / 2; }
__host__ __device__ __forceinline__ int perm32(int rho) { const int n = rho >> 4, i = rho & 15; return 8 * (i >> 2) + 4 * n + (i & 3); }

struct Unit { int pm, pn; };
struct Gemm { const bf16_t* A; const bf16_t* Bt; int M, N, K; };

struct StaticOrder {
    int nM, nN, nwg, G, c, lo, hi;
    __host__ __device__ void init(int M, int N, int G_, int c_) { nM = M / BM; nN = N / BM; nwg = nM * nN; G = G_; c = c_; lo = 0; hi = nwg; }
    __host__ __device__ void range(int lo_, int hi_) { lo = lo_; hi = hi_ < nwg ? hi_ : nwg; }
    __host__ __device__ bool next(int i, Unit& u) const {
        const long L = (long)lo + (long)i * G + c; if (L >= hi) return false;
        int wgid = (int)L; { const int q = nwg / NXCD, r = nwg % NXCD, xcd = wgid % NXCD, off = wgid / NXCD; wgid = (xcd < r ? xcd * (q + 1) : r * (q + 1) + (xcd - r) * q) + off; }
        const int nig = WGM * nN, gid = wgid / nig, fm = gid * WGM, gsz = (nM - fm) < WGM ? (nM - fm) : WGM;
        u.pm = fm + ((wgid % nig) % gsz); u.pn = (wgid % nig) / gsz; return true;
    }
    __device__ __forceinline__ void a_ready(const Unit&) const {}
    __device__ __forceinline__ void done(const Unit&) const {}
};
}
namespace pg8 {

template <class Epi, class Sched, bool ALIGN_EPI = false, bool SP2 = false>
__device__ __forceinline__ void gemm_phase(PG8_LAS unsigned char* lds, const Gemm g, const Sched& S, const Epi& E, const int tid_in) {
    int tid_ = tid_in; asm volatile("" : "+v"(tid_)); const int tid = tid_, wid = __builtin_amdgcn_readfirstlane(tid >> 6), lane = tid & 63, wr = wid >> 2, wc = wid & 3, fr = lane & 15, fq = lane >> 4;
    const int K = g.K, nt = K / BK;
    unsigned voffA[2], voffB[2];
#pragma unroll
    for (int i = 0; i < 2; ++i) { int R, C; stage_rc(tid * 16 + i * 8192, R, C); const int Rb = Epi::PERM ? ((R & ~31) + perm32(R & 31)) : R;
        voffA[i] = (unsigned)(R * K + C) * 2u; voffB[i] = (unsigned)(Rb * K + C) * 2u; }
    const size_t kstep = (size_t)(BK * 2);
    const size_t hstep = (size_t)HALF * K * 2;
    const size_t tstep = 2 * hstep;
    const unsigned ldsw = (unsigned)wid * 1024u;
    const int aoff = lds_byte(wr * 64 + fr, fq * 8), boff = lds_byte(wc * 32 + fr, fq * 8);
#define PG8_SA(b, h) (((b) * 2 + (h)) * HTB)
#define PG8_SB(b, h) ((4 + (b) * 2 + (h)) * HTB)
#define PG8_STAGE(bufoff, gbase, voff) do { _Pragma("unroll") for (int _i = 0; _i < 2; ++_i) \
        __builtin_amdgcn_global_load_lds((const unsigned*)((const char*)(gbase) + (voff)[_i]), (PG8_LAS unsigned*)(lds + (bufoff) + ldsw + _i * 8192), 16, 0, 0); } while (0)
#define PG8_LDA(dst, b, h) do { _Pragma("unroll") for (int m = 0; m < 4; ++m) _Pragma("unroll") for (int k = 0; k < 2; ++k) dst[m][k] = *(const PG8_LAS bf16x8*)(lds + PG8_SA(b, h) + aoff + m * 2048 + k * 1024); } while (0)
#define PG8_LDB(dst, b, h) do { _Pragma("unroll") for (int n = 0; n < 2; ++n) _Pragma("unroll") for (int k = 0; k < 2; ++k) dst[n][k] = *(const PG8_LAS bf16x8*)(lds + PG8_SB(b, h) + boff + n * 2048 + k * 1024); } while (0)
#define PG8_MMA(ai, bj, At, Bt) do { __builtin_amdgcn_s_setprio(1); _Pragma("unroll") for (int m = 0; m < 4; ++m) _Pragma("unroll") for (int n = 0; n < 2; ++n) _Pragma("unroll") for (int k = 0; k < 2; ++k) \
        acc[ai][bj][m][n] = __builtin_amdgcn_mfma_f32_16x16x32_bf16(Bt[n][k], At[m][k], acc[ai][bj][m][n], 0, 0, 0); __builtin_amdgcn_s_setprio(0); } while (0)
#define PG8_WAIT_V(n) asm volatile("s_waitcnt vmcnt(" #n ")" ::: "memory")
#define PG8_WAIT_L(n) asm volatile("s_waitcnt lgkmcnt(" #n ")" ::: "memory")
#define PG8_BAR __builtin_amdgcn_s_barrier()
#define PG8_SCHED __builtin_amdgcn_sched_barrier(0)
    Unit cur, nxt; int ui = 0;
    if (!S.next(0, cur)) return;
    f32x4 acc[2][2][4][2];
#pragma unroll
    for (int a = 0; a < 2; ++a)
#pragma unroll
        for (int b = 0; b < 2; ++b)
#pragma unroll
            for (int m = 0; m < 4; ++m)
#pragma unroll
                for (int n = 0; n < 2; ++n) acc[a][b][m][n] = (f32x4){0.f, 0.f, 0.f, 0.f};
    bf16x8 At[4][2], B0[2][2], B1[2][2];
    const char* cA = (const char*)g.A + (size_t)cur.pm * tstep; const char* cB = (const char*)g.Bt + (size_t)cur.pn * tstep;
    S.a_ready(cur);
    if constexpr (SP2) {
        PG8_STAGE(PG8_SB(0, 0), cB, voffB); PG8_STAGE(PG8_SB(0, 1), cB + hstep, voffB); PG8_STAGE(PG8_SA(0, 0), cA, voffA); PG8_STAGE(PG8_SA(0, 1), cA + hstep, voffA);
        if (wr == 1) PG8_BAR;
        PG8_WAIT_V(2); PG8_BAR;
        PG8_STAGE(PG8_SB(1, 0), cB + kstep, voffB); PG8_STAGE(PG8_SA(1, 0), cA + kstep, voffA); PG8_STAGE(PG8_SB(1, 1), cB + hstep + kstep, voffB);
        PG8_WAIT_V(6); PG8_BAR;
    } else {
        PG8_STAGE(PG8_SB(0, 0), cB, voffB); PG8_STAGE(PG8_SA(0, 0), cA, voffA); PG8_STAGE(PG8_SB(0, 1), cB + hstep, voffB); PG8_STAGE(PG8_SA(0, 1), cA + hstep, voffA);
        if (wr == 1) PG8_BAR;
        PG8_WAIT_V(4); PG8_BAR;
        PG8_STAGE(PG8_SB(1, 0), cB + kstep, voffB); PG8_STAGE(PG8_SA(1, 0), cA + kstep, voffA); PG8_STAGE(PG8_SB(1, 1), cB + hstep + kstep, voffB);
        PG8_WAIT_V(6); PG8_BAR;
    }
    for (;;) {
        const bool has_next = S.next(ui + 1, nxt);
        const char* nA = has_next ? (const char*)g.A + (size_t)nxt.pm * tstep : cA; const char* nB = has_next ? (const char*)g.Bt + (size_t)nxt.pn * tstep : cB;
        for (int t = 0; t < nt; t += 2) {
            const bool last = (t == nt - 2);
            const char* a1 = cA + (size_t)(t + 1) * kstep;
            const char* a2 = last ? nA : cA + (size_t)(t + 2) * kstep; const char* b2 = last ? nB : cB + (size_t)(t + 2) * kstep;
            const char* a3 = a2 + kstep; const char* b3 = b2 + kstep;
            if (last && has_next) S.a_ready(nxt);
            if constexpr (SP2) {
            PG8_LDB(B0, 0, 0); PG8_LDB(B1, 0, 1); PG8_SCHED; PG8_LDA(At, 0, 0); PG8_STAGE(PG8_SA(1, 1), a1 + hstep, voffA);
            PG8_WAIT_V(8); PG8_WAIT_L(0); PG8_BAR; PG8_MMA(0, 0, At, B0); PG8_MMA(0, 1, At, B1); PG8_BAR; PG8_SCHED;
            PG8_LDA(At, 0, 1); PG8_STAGE(PG8_SB(0, 0), b2, voffB); PG8_STAGE(PG8_SB(0, 1), b2 + hstep, voffB); PG8_STAGE(PG8_SA(0, 0), a2, voffA);
            PG8_WAIT_V(8); PG8_WAIT_L(0); PG8_BAR; PG8_MMA(1, 0, At, B0); PG8_MMA(1, 1, At, B1); PG8_BAR; PG8_SCHED;
            PG8_LDB(B0, 1, 0); PG8_LDB(B1, 1, 1); PG8_SCHED; PG8_LDA(At, 1, 0); PG8_STAGE(PG8_SA(0, 1), a2 + hstep, voffA);
            PG8_WAIT_V(8); PG8_WAIT_L(0); PG8_BAR; PG8_MMA(0, 0, At, B0); PG8_MMA(0, 1, At, B1); PG8_BAR; PG8_SCHED;
            PG8_LDA(At, 1, 1); PG8_STAGE(PG8_SB(1, 0), b3, voffB); PG8_STAGE(PG8_SB(1, 1), b3 + hstep, voffB); PG8_STAGE(PG8_SA(1, 0), a3, voffA);
            PG8_WAIT_V(8); PG8_WAIT_L(0); PG8_BAR; PG8_MMA(1, 0, At, B0); PG8_MMA(1, 1, At, B1); PG8_BAR; PG8_SCHED;
            } else {
            PG8_LDB(B0, 0, 0); PG8_SCHED; PG8_LDA(At, 0, 0); PG8_STAGE(PG8_SA(1, 1), a1 + hstep, voffA);
            PG8_WAIT_L(8); PG8_BAR; PG8_WAIT_L(0); PG8_MMA(0, 0, At, B0); PG8_BAR; PG8_SCHED;
            PG8_LDB(B1, 0, 1); PG8_STAGE(PG8_SB(0, 0), b2, voffB);
            PG8_BAR; PG8_WAIT_L(0); PG8_MMA(0, 1, At, B1); PG8_BAR;
            PG8_LDA(At, 0, 1); PG8_STAGE(PG8_SA(0, 0), a2, voffA);
            PG8_BAR; PG8_WAIT_L(0); PG8_MMA(1, 0, At, B0); PG8_BAR; PG8_SCHED;
            PG8_STAGE(PG8_SB(0, 1), b2 + hstep, voffB);
            PG8_WAIT_V(6); PG8_BAR; PG8_MMA(1, 1, At, B1); PG8_BAR;
            PG8_LDB(B0, 1, 0); PG8_SCHED; PG8_LDA(At, 1, 0); PG8_STAGE(PG8_SA(0, 1), a2 + hstep, voffA);
            PG8_WAIT_L(8); PG8_BAR; PG8_WAIT_L(0); PG8_MMA(0, 0, At, B0); PG8_BAR; PG8_SCHED;
            PG8_LDB(B1, 1, 1); PG8_STAGE(PG8_SB(1, 0), b3, voffB);
            PG8_BAR; PG8_WAIT_L(0); PG8_MMA(0, 1, At, B1); PG8_BAR;
            PG8_LDA(At, 1, 1); PG8_STAGE(PG8_SA(1, 0), a3, voffA);
            PG8_BAR; PG8_WAIT_L(0); PG8_MMA(1, 0, At, B0); PG8_BAR; PG8_SCHED;
            PG8_STAGE(PG8_SB(1, 1), b3 + hstep, voffB);
            PG8_WAIT_V(6); PG8_BAR; PG8_MMA(1, 1, At, B1); PG8_BAR;
            }
        }
        if constexpr (ALIGN_EPI) { if (wr == 0) PG8_BAR; }
        if constexpr (!Epi::AFTER_DRAIN) { E(acc, cur, wr, wc, fr, fq); S.done(cur); }
        if (!has_next) break;
#pragma unroll
        for (int a = 0; a < 2; ++a)
#pragma unroll
            for (int b = 0; b < 2; ++b)
#pragma unroll
                for (int m = 0; m < 4; ++m)
#pragma unroll
                    for (int n = 0; n < 2; ++n) acc[a][b][m][n] = (f32x4){0.f, 0.f, 0.f, 0.f};
        cur = nxt; cA = nA; cB = nB; ++ui;
        if constexpr (ALIGN_EPI) { if (wr == 1) PG8_BAR; }
    }
    PG8_WAIT_V(0);
    if constexpr (!ALIGN_EPI) { if (wr == 0) PG8_BAR; }
    PG8_BAR;
    if constexpr (Epi::AFTER_DRAIN) { E.fused(acc, cur, wr, wc, fr, fq, lds, wid, lane); S.done(cur); }
#undef PG8_SA
#undef PG8_SB
#undef PG8_STAGE
#undef PG8_LDA
#undef PG8_LDB
#undef PG8_MMA
#undef PG8_WAIT_V
#undef PG8_WAIT_L
#undef PG8_BAR
#undef PG8_SCHED
}
}

#define DI __device__ __forceinline__
#define LAS __attribute__((address_space(3)))
typedef unsigned short bf16;
typedef short bf16x8 __attribute__((ext_vector_type(8)));
typedef short s16x4 __attribute__((ext_vector_type(4)));
typedef float f32x2 __attribute__((ext_vector_type(2)));
typedef float f32x4 __attribute__((ext_vector_type(4)));
typedef float f32x16 __attribute__((ext_vector_type(16)));
typedef unsigned u32x2 __attribute__((ext_vector_type(2)));
typedef unsigned u32x4 __attribute__((ext_vector_type(4)));
typedef __bf16 bf16x2_t __attribute__((ext_vector_type(2)));
#define LDS_WAIT() asm volatile("s_waitcnt lgkmcnt(0)" ::: "memory")
#define MFMA32(a, b, c) __builtin_amdgcn_mfma_f32_32x32x16_bf16((a), (b), (c), 0, 0, 0)

constexpr int DM = 1024, NBATCH = 8, SEQ = 4096, CTXL = 256, NCTX = NBATCH * CTXL, NLAT = NBATCH * SEQ, MTOT = NCTX + NLAT;
constexpr int NIN0 = 2816, NIN1 = 1536, DFF = 4096, KVLEN = CTXL + SEQ, AB_IN_W = 2832, NMODC = 6144;
constexpr float EPS = 1e-6f, LOG2E = 1.4426950408889634f;
constexpr size_t MiB = 1u << 20;
constexpr size_t WS_WIN0 = 0, WS_WOUT0 = 6 * MiB, WS_WIN1 = 8 * MiB, WS_WOUT1 = 11 * MiB, WS_W1 = 13 * MiB, WS_W2 = 29 * MiB, WS_MOD = 45 * MiB,
                 WS_GATES = 46 * MiB, WS_XC = 49 * MiB, WS_VT = 57 * MiB, WS_H = 74 * MiB, WS_OCAT = 142 * MiB, WS_BIG = 210 * MiB, WS_BAR = 482 * MiB, WS_RSS = 483 * MiB, WS_BIAS = 484 * MiB, WS_V1 = 485 * MiB, WS_END = 502 * MiB;
constexpr size_t WS_WG = 45 * MiB + 512 * 1024;
constexpr int LDS_BYTES = 147456;

struct Params { const float* in[21]; float* out; unsigned char* ws; };

DI unsigned cvtpk(float lo, float hi) { f32x2 v = {lo, hi}; bf16x2_t b = __builtin_convertvector(v, bf16x2_t); return __builtin_bit_cast(unsigned, b); }
DI bf16 f2bf(float x) { return (bf16)(cvtpk(x, 0.f) & 0xffffu); }
DI float bf2f(bf16 b) { return __uint_as_float(((unsigned)b) << 16); }
DI float wave_sum(float v) {
#pragma unroll
    for (int o = 1; o < 64; o <<= 1) v += __shfl_xor(v, o);
    return v;
}
DI int fresh_lane() { int l; asm volatile("v_mbcnt_lo_u32_b32 %0, -1, 0\n\tv_mbcnt_hi_u32_b32 %0, -1, %0" : "=v"(l)); return l; }
DI int crow(int i, int h) { return (i & 3) + 8 * (i >> 2) + 4 * h; }
DI f32x16 zero16() { f32x16 z; for (int i = 0; i < 16; ++i) z[i] = 0.f; return z; }

DI void mma32(f32x16& acc, const LAS bf16* A, int lda, const LAS bf16* B, int ldb, int K, int lane) {
    const int r = lane & 31, h = lane >> 5;
    const LAS bf16* ap = A + r * lda + 8 * h; const LAS bf16* bp = B + r * ldb + 8 * h;
#pragma unroll 1
    for (int k0 = 0; k0 < K; k0 += 16) {
        const bf16x8 a = *(const LAS bf16x8*)(ap + k0); const bf16x8 b = *(const LAS bf16x8*)(bp + k0);
        acc = MFMA32(a, b, acc);
    }
}

template <int ACT> struct EpiStore {
    static constexpr bool PERM = true, AFTER_DRAIN = false;
    bf16* O; int ldc;
    DI void operator()(const f32x4 (&acc)[2][2][4][2], const pg8::Unit& u, int wr, int wc, int fr, int fq) const {
        const int row0 = u.pm * 256 + wr * 64 + fr, col0 = u.pn * 256 + wc * 32 + 8 * fq;
#pragma unroll
        for (int ai = 0; ai < 2; ++ai)
#pragma unroll
            for (int m = 0; m < 4; ++m) { bf16* rowp = O + (size_t)(row0 + ai * 128 + m * 16) * ldc + col0;
#pragma unroll
                for (int bj = 0; bj < 2; ++bj) { f32x4 v0 = acc[ai][bj][m][0], v1 = acc[ai][bj][m][1];
                    if (ACT == 1) {
#pragma unroll
                        for (int e = 0; e < 4; ++e) { float a = fmaxf(v0[e], 0.f), b = fmaxf(v1[e], 0.f); v0[e] = a * a; v1[e] = b * b; } }
                    u32x4 w; w.x = cvtpk(v0[0], v0[1]); w.y = cvtpk(v0[2], v0[3]); w.z = cvtpk(v1[0], v1[1]); w.w = cvtpk(v1[2], v1[3]);
                    *(u32x4*)(rowp + bj * 128) = w; } }
    }
};
struct EpiResid {
    static constexpr bool PERM = true, AFTER_DRAIN = false;
    const float* srcC; const float* srcL; float* dstC; float* dstL; const float* mod; int gi; int row_base;
    DI void operator()(const f32x4 (&acc)[2][2][4][2], const pg8::Unit& u, int wr, int wc, int fr, int fq) const {
        const int grow0 = row_base + u.pm * 256;
        const float* s; float* d; int mrow;
        if (grow0 < NCTX) { s = srcC + (size_t)grow0 * DM; d = dstC + (size_t)grow0 * DM; mrow = 8; }
        else { const int lr = grow0 - NCTX; s = srcL + (size_t)lr * DM; d = dstL + (size_t)lr * DM; mrow = lr >> 12; }
        const float* gp = mod + mrow * NMODC + gi * DM;
#pragma unroll
        for (int bj = 0; bj < 2; ++bj) { const int col = u.pn * 256 + bj * 128 + wc * 32 + 8 * fq;
            const f32x4 g0 = *(const f32x4*)(gp + col), g1 = *(const f32x4*)(gp + col + 4);
#pragma unroll
            for (int ai = 0; ai < 2; ++ai) {
            f32x4 rr0[4], rr1[4];
#pragma unroll
                for (int m = 0; m < 4; ++m) { const int ro = (ai * 128 + wr * 64 + m * 16 + fr) * DM + col; rr0[m] = *(const f32x4*)(s + ro); rr1[m] = *(const f32x4*)(s + ro + 4); }
            asm volatile("" ::: "memory");
#pragma unroll
                for (int m = 0; m < 4; ++m) { const int ro = (ai * 128 + wr * 64 + m * 16 + fr) * DM + col;
                    *(f32x4*)(d + ro) = rr0[m] + g0 * acc[ai][bj][m][0]; *(f32x4*)(d + ro + 4) = rr1[m] + g1 * acc[ai][bj][m][1]; } } }
    }
};
struct EpiResidN {
    static constexpr bool PERM = true, AFTER_DRAIN = false;
    const float* srcC; const float* srcL; float* dstC; float* dstL; const float* mod; int gi; int row_base;
    const float* gnext; const float* modn; int sin; bf16* Hn; float* rss;
    DI void operator()(const f32x4 (&acc)[2][2][4][2], const pg8::Unit& u, int wr, int wc, int fr, int fq) const {
        const int grow0 = row_base + u.pm * 256;
        const float* s; float* d; int mrow;
        if (grow0 < NCTX) { s = srcC + (size_t)grow0 * DM; d = dstC + (size_t)grow0 * DM; mrow = 8; }
        else { const int lr = grow0 - NCTX; s = srcL + (size_t)lr * DM; d = dstL + (size_t)lr * DM; mrow = lr >> 12; }
        const float* gp = mod + mrow * NMODC + gi * DM; const float* scp = modn + mrow * NMODC + (sin + 1) * DM;
        bf16* hb = Hn + (size_t)grow0 * DM;
        float ssq[2][4];
#pragma unroll
        for (int ai = 0; ai < 2; ++ai)
#pragma unroll
            for (int m = 0; m < 4; ++m) ssq[ai][m] = 0.f;
#pragma unroll
        for (int bj = 0; bj < 2; ++bj) { const int col = u.pn * 256 + bj * 128 + wc * 32 + 8 * fq;
            const f32x4 g0 = *(const f32x4*)(gp + col), g1 = *(const f32x4*)(gp + col + 4);
            const f32x4 w0 = *(const f32x4*)(gnext + col) * (*(const f32x4*)(scp + col) + 1.f), w1 = *(const f32x4*)(gnext + col + 4) * (*(const f32x4*)(scp + col + 4) + 1.f);
#pragma unroll
            for (int ai = 0; ai < 2; ++ai) {
            f32x4 rr0[4], rr1[4];
#pragma unroll
                for (int m = 0; m < 4; ++m) { const int ro = (ai * 128 + wr * 64 + m * 16 + fr) * DM + col; rr0[m] = *(const f32x4*)(s + ro); rr1[m] = *(const f32x4*)(s + ro + 4); }
            asm volatile("" ::: "memory");
#pragma unroll
                for (int m = 0; m < 4; ++m) { const int ro = (ai * 128 + wr * 64 + m * 16 + fr) * DM + col;
                    const f32x4 r0 = rr0[m], r1 = rr1[m];
                    const f32x4 x0 = r0 + g0 * acc[ai][bj][m][0], x1 = r1 + g1 * acc[ai][bj][m][1];
                    *(f32x4*)(d + ro) = x0; *(f32x4*)(d + ro + 4) = x1;
                    ssq[ai][m] += (x0[0] * x0[0] + x0[1] * x0[1]) + (x0[2] * x0[2] + x0[3] * x0[3]) + (x1[0] * x1[0] + x1[1] * x1[1]) + (x1[2] * x1[2] + x1[3] * x1[3]);
                    const f32x4 h0 = x0 * w0, h1 = x1 * w1;
                    u32x4 w; w.x = cvtpk(h0[0], h0[1]); w.y = cvtpk(h0[2], h0[3]); w.z = cvtpk(h1[0], h1[1]); w.w = cvtpk(h1[2], h1[3]);
                    *(u32x4*)(hb + ro) = w; } } }
#pragma unroll
        for (int ai = 0; ai < 2; ++ai)
#pragma unroll
            for (int m = 0; m < 4; ++m) { float q = ssq[ai][m]; q += __shfl_xor(q, 16); q += __shfl_xor(q, 32);
                if (fq == 0) atomicAdd(rss + grow0 + ai * 128 + wr * 64 + m * 16 + fr, q); }
    }
};
template <int ACT> struct EpiStoreN {
    static constexpr bool PERM = true, AFTER_DRAIN = false;
    bf16* O; int ldc; const float* rss; const float* bias; int row_base;
    DI void operator()(const f32x4 (&acc)[2][2][4][2], const pg8::Unit& u, int wr, int wc, int fr, int fq) const {
        const int lrow0 = u.pm * 256 + wr * 64 + fr, grow0 = row_base + u.pm * 256, col0 = u.pn * 256 + wc * 32 + 8 * fq;
        bf16* Ou = O + (size_t)(u.pm * 256) * ldc + u.pn * 256;
        const int mrow = grow0 < NCTX ? 8 : (grow0 - NCTX) >> 12;
        float rstd[2][4];
#pragma unroll
        for (int ai = 0; ai < 2; ++ai)
#pragma unroll
            for (int m = 0; m < 4; ++m) rstd[ai][m] = rsqrtf(rss[row_base + lrow0 + ai * 128 + m * 16] * (1.f / DM) + EPS);
        const float* bp = bias + mrow * 4096 + col0;
        f32x4 bb[2][2];
#pragma unroll
        for (int bj = 0; bj < 2; ++bj) { bb[bj][0] = *(const f32x4*)(bp + bj * 128); bb[bj][1] = *(const f32x4*)(bp + bj * 128 + 4); }
        asm volatile("" ::: "memory");
#pragma unroll
        for (int bj = 0; bj < 2; ++bj) { const f32x4 b0 = bb[bj][0], b1 = bb[bj][1];
#pragma unroll
            for (int ai = 0; ai < 2; ++ai)
#pragma unroll
                for (int m = 0; m < 4; ++m) {
                    f32x4 v0 = acc[ai][bj][m][0] * rstd[ai][m] + b0, v1 = acc[ai][bj][m][1] * rstd[ai][m] + b1;
                    if (ACT == 1) {
#pragma unroll
                        for (int e = 0; e < 4; ++e) { float a = fmaxf(v0[e], 0.f), b = fmaxf(v1[e], 0.f); v0[e] = a * a; v1[e] = b * b; } }
                    u32x4 w; w.x = cvtpk(v0[0], v0[1]); w.y = cvtpk(v0[2], v0[3]); w.z = cvtpk(v1[0], v1[1]); w.w = cvtpk(v1[2], v1[3]);
                    *(u32x4*)(Ou + (wr * 64 + fr + ai * 128 + m * 16) * ldc + wc * 32 + 8 * fq + bj * 128) = w; } }
    }
};
template <class Epi> DI void run_gemm_rng_(LAS unsigned char* lds, const bf16* A, const bf16* Bt, int M, int N, int K, const Epi& E, int G, int c, int lo, int hi, int tid) {
    pg8::Gemm g{A, Bt, M, N, K}; pg8::StaticOrder S; S.init(M, N, G, c); S.range(lo, hi);
    pg8::gemm_phase<Epi, pg8::StaticOrder, true, true>(lds, g, S, E, tid);
}

DI void transpose_item(const float* __restrict__ W, int ldw, int K, bf16* WT, int nblk, LAS float* scr, int item, int lane) {
    const int kb = item / nblk, nb = item - kb * nblk, k0 = 64 * kb, n0 = 32 * nb;
    float wv[32];
#pragma unroll
    for (int i = 0; i < 32; ++i) wv[i] = W[(size_t)(k0 + 2 * i + (lane >> 5)) * ldw + n0 + (lane & 31)];
#pragma unroll
    for (int i = 0; i < 32; ++i) scr[(2 * i + (lane >> 5)) * 33 + (lane & 31)] = wv[i];
    LDS_WAIT();
    const int c = lane & 7;
#pragma unroll
    for (int j = 0; j < 4; ++j) { const int n = (lane >> 3) + 8 * j; const LAS float* s = scr + (8 * c) * 33 + n;
        u32x4 o; o.x = cvtpk(s[0], s[33]); o.y = cvtpk(s[66], s[99]); o.z = cvtpk(s[132], s[165]); o.w = cvtpk(s[198], s[231]);
        *(u32x4*)(WT + (size_t)(n0 + n) * K + k0 + 8 * c) = o; }
    LDS_WAIT();
}
DI void phase_prologue(const Params& p, LAS unsigned char* lds, int tid, int lane, int wave) {
    unsigned char* ws = p.ws;
    float* MOD = (float*)(ws + WS_MOD);
    for (int item = blockIdx.x; item < 192; item += gridDim.x) {
        const int l = item / 96, cgp = item - l * 96;
        LAS float* sl = (LAS float*)lds; LAS float* part = sl + 9 * 1024;
        for (int i = tid; i < 9 * 1024; i += 512) { const int r = i >> 10, k = i & 1023; const float cv = r < 8 ? p.in[1][r * 1024 + k] : p.in[3][k]; sl[i] = cv / (1.f + __expf(-cv)); }
        __syncthreads();
        const float* aw = p.in[4] + (size_t)l * 1024 * NMODC + cgp * 64 + lane;
        float acc[9];
#pragma unroll
        for (int r = 0; r < 9; ++r) acc[r] = 0.f;
        const int kbase = wave * 128;
#pragma unroll 32
        for (int k = 0; k < 128; ++k) { const float w = aw[(size_t)(kbase + k) * NMODC];
#pragma unroll
            for (int r = 0; r < 9; ++r) acc[r] += sl[r * 1024 + kbase + k] * w; }
#pragma unroll
        for (int r = 0; r < 9; ++r) part[(wave * 9 + r) * 64 + lane] = acc[r];
        __syncthreads();
        for (int i = tid; i < 576; i += 512) { const int r = i >> 6, cl = i & 63; float s = p.in[5][l * NMODC + cgp * 64 + cl];
#pragma unroll
            for (int kg = 0; kg < 8; ++kg) s += part[(kg * 9 + r) * 64 + cl];
            MOD[(l * 9 + r) * NMODC + cgp * 64 + cl] = s; }
        __syncthreads();
    }
    { float* rss = (float*)(ws + WS_RSS); for (int i = blockIdx.x * 512 + tid; i < 3 * MTOT; i += gridDim.x * 512) rss[i] = 0.f; }
    { bf16* WG = (bf16*)(ws + WS_WG);
      for (int idx = blockIdx.x * 512 + tid; idx < 16 * 1024; idx += gridDim.x * 512) { const int g = idx & 15, k = idx >> 4;
          const float w = p.in[8][(size_t)k * AB_IN_W + 2048 + g]; const bf16 hi = f2bf(w); const bf16 lo = f2bf(w - bf2f(hi));
          WG[g * 1024 + k] = hi; WG[16 * 1024 + g * 1024 + k] = lo; } }
    LAS float* scr = (LAS float*)(lds + wave * 16384);
    const int gw = blockIdx.x * 8 + wave, NGW = gridDim.x * 8;
    constexpr int I0 = 16 * 64, I1 = 16 * 24, I2 = 16 * 32, I3 = 16 * 48, I4 = 16 * 32, I5 = 16 * 128, I6 = 64 * 32;
    constexpr int NITEMS = I0 + I1 + I2 + I3 + I4 + 2 * I5 + 2 * I6;
    for (int it = gw; it < NITEMS; it += NGW) {
        int r = it;
        if (r < I0) { transpose_item(p.in[8], AB_IN_W, 1024, (bf16*)(ws + WS_WIN0), 64, scr, r, lane); continue; } r -= I0;
        if (r < I1) { transpose_item(p.in[8] + 2064, AB_IN_W, 1024, (bf16*)(ws + WS_WIN0) + (size_t)2048 * 1024, 24, scr, r, lane); continue; } r -= I1;
        if (r < I2) { transpose_item(p.in[14], 1024, 1024, (bf16*)(ws + WS_WOUT0), 32, scr, r, lane); continue; } r -= I2;
        if (r < I3) { transpose_item(p.in[15], NIN1, 1024, (bf16*)(ws + WS_WIN1), 48, scr, r, lane); continue; } r -= I3;
        if (r < I4) { transpose_item(p.in[18], 1024, 1024, (bf16*)(ws + WS_WOUT1), 32, scr, r, lane); continue; } r -= I4;
        if (r < 2 * I5) { const int l = r / I5; r -= l * I5; transpose_item(p.in[19] + (size_t)l * 1024 * DFF, DFF, 1024, (bf16*)(ws + WS_W1) + (size_t)l * DFF * 1024, 128, scr, r, lane); continue; } r -= 2 * I5;
        { const int l = r / I6; r -= l * I6; transpose_item(p.in[20] + (size_t)l * DFF * 1024, 1024, DFF, (bf16*)(ws + WS_W2) + (size_t)l * DFF * 1024, 32, scr, r, lane); }
    }
}

DI float log_sigmoid(float x) { return -(fmaxf(-x, 0.f) + log1pf(__expf(-fabsf(x)))); }
template <bool GATES>
DI void phase_norm(const Params& p, LAS unsigned char* lds, const float* srcC, const float* srcL, const float* gn, const float* modL, int si, bf16* H,
                   int row_lo, int row_hi, int tid, int lane, int wave) {
    const int gw = blockIdx.x * 8 + wave, NGW = gridDim.x * 8;
    for (int row = row_lo + gw; row < row_hi; row += 2 * NGW) {
        const int rowB = row + NGW; const bool hasB = rowB < row_hi;
        const float* xa; const float* xb; int ma, mb;
        if (row < NCTX) { xa = srcC + (size_t)row * DM; ma = 8; } else { xa = srcL + (size_t)(row - NCTX) * DM; ma = (row - NCTX) >> 12; }
        const int rb = hasB ? rowB : row;
        if (rb < NCTX) { xb = srcC + (size_t)rb * DM; mb = 8; } else { xb = srcL + (size_t)(rb - NCTX) * DM; mb = (rb - NCTX) >> 12; }
        f32x4 va[4], vb[4]; float sa = 0.f, sb = 0.f;
#pragma unroll
        for (int j = 0; j < 4; ++j) { va[j] = ((const f32x4*)xa)[lane + 64 * j]; vb[j] = ((const f32x4*)xb)[lane + 64 * j]; }
        const float* sha = modL + ma * NMODC + si * DM; const float* shb = modL + mb * NMODC + si * DM;
        f32x4 gg[4], sca[4], tca[4], scb[4], tcb[4];
#pragma unroll
        for (int j = 0; j < 4; ++j) { gg[j] = ((const f32x4*)gn)[lane + 64 * j]; sca[j] = ((const f32x4*)(sha + DM))[lane + 64 * j]; tca[j] = ((const f32x4*)sha)[lane + 64 * j];
            scb[j] = ((const f32x4*)(shb + DM))[lane + 64 * j]; tcb[j] = ((const f32x4*)shb)[lane + 64 * j]; }
        asm volatile("" ::: "memory");
#pragma unroll
        for (int j = 0; j < 4; ++j) { sa += (va[j].x * va[j].x + va[j].y * va[j].y) + (va[j].z * va[j].z + va[j].w * va[j].w);
                                      sb += (vb[j].x * vb[j].x + vb[j].y * vb[j].y) + (vb[j].z * vb[j].z + vb[j].w * vb[j].w); }
#pragma unroll
        for (int o = 1; o < 64; o <<= 1) { sa += __shfl_xor(sa, o); sb += __shfl_xor(sb, o); }
        const float ra = rsqrtf(sa * (1.f / DM) + EPS), rbs = rsqrtf(sb * (1.f / DM) + EPS);
        bf16* ha = H + (size_t)row * DM; bf16* hb = H + (size_t)rb * DM;
#pragma unroll
        for (int j = 0; j < 4; ++j) {
            { const f32x4 v = va[j] * ra * gg[j] * (sca[j] + 1.f) + tca[j]; u32x2 o; o.x = cvtpk(v.x, v.y); o.y = cvtpk(v.z, v.w); ((u32x2*)ha)[lane + 64 * j] = o; }
            if (hasB) { const f32x4 v = vb[j] * rbs * gg[j] * (scb[j] + 1.f) + tcb[j]; u32x2 o; o.x = cvtpk(v.x, v.y); o.y = cvtpk(v.z, v.w); ((u32x2*)hb)[lane + 64 * j] = o; }
        }
    }
}

DI void phase_gates(const Params& p, LAS unsigned char* lds, const bf16* H, int tid, int lane, int wave, int bidx, int nblk) {
    constexpr int GP = 1032;
    LAS bf16* Ws = (LAS bf16*)lds;
    const bf16* WG = (const bf16*)(p.ws + WS_WG);
    __syncthreads();
    for (int i = tid; i < 32 * 128; i += 512) { const int rw = i >> 7, c = i & 127; *(LAS u32x4*)(Ws + rw * GP + c * 8) = *(const u32x4*)(WG + rw * 1024 + c * 8); }
    __syncthreads();
    float* GT = (float*)(p.ws + WS_GATES);
    const int r = lane & 31, hh = lane >> 5;
    const int gw = bidx * 8 + wave, NGW = nblk * 8;
    const float gb = p.in[9][r & 15];
    for (int tile = gw; tile < MTOT / 32; tile += NGW) {
        const int row0 = 32 * tile;
        const bf16* ap = H + (size_t)(row0 + r) * DM + 8 * hh;
        const LAS bf16* bh = Ws + (r & 15) * GP + 8 * hh; const LAS bf16* bl = bh + 16 * GP;
        f32x16 acc = zero16();
#pragma unroll 1
        for (int kg = 0; kg < 4; ++kg) { bf16x8 af[16];
#pragma unroll
            for (int q = 0; q < 16; ++q) af[q] = *(const bf16x8*)(ap + 16 * (16 * kg + q));
            asm volatile("" ::: "memory");
#pragma unroll
            for (int q = 0; q < 16; ++q) { const int ks = 16 * kg + q;
                acc = MFMA32(af[q], *(const LAS bf16x8*)(bh + 16 * ks), acc); acc = MFMA32(af[q], *(const LAS bf16x8*)(bl + 16 * ks), acc); } }
        if (r < 16) {
#pragma unroll
            for (int i = 0; i < 16; ++i) { float gv = acc[i] + gb; if ((r >> 2) & 1) gv = log_sigmoid(gv); GT[(size_t)(row0 + crow(i, hh)) * 16 + r] = gv; } }
    }
    __syncthreads();
}


DI void phase_bias(const Params& p, int lane, int wave) {
    const float* MOD = (const float*)(p.ws + WS_MOD); float* BIAS = (float*)(p.ws + WS_BIAS);
    const int gw = blockIdx.x * 8 + wave, NGW = gridDim.x * 8;
    for (int it = gw; it < 4096 + 1536 + 4096; it += NGW) {
        int which, n; const bf16* WT; const float* sh;
        if (it < 4096) { which = 0; n = it; WT = (const bf16*)(p.ws + WS_W1); sh = MOD + 3 * DM; }
        else if (it < 4096 + 1536) { which = 1; n = it - 4096; WT = (const bf16*)(p.ws + WS_WIN1); sh = MOD + 9 * NMODC; }
        else { which = 2; n = it - 4096 - 1536; WT = (const bf16*)(p.ws + WS_W1) + (size_t)DFF * DM; sh = MOD + 9 * NMODC + 3 * DM; }
        const u32x4 w0 = *(const u32x4*)(WT + (size_t)n * DM + lane * 16), w1 = *(const u32x4*)(WT + (size_t)n * DM + lane * 16 + 8);
        float wf[16];
        wf[0] = __uint_as_float(w0.x << 16); wf[1] = __uint_as_float(w0.x & 0xffff0000u); wf[2] = __uint_as_float(w0.y << 16); wf[3] = __uint_as_float(w0.y & 0xffff0000u);
        wf[4] = __uint_as_float(w0.z << 16); wf[5] = __uint_as_float(w0.z & 0xffff0000u); wf[6] = __uint_as_float(w0.w << 16); wf[7] = __uint_as_float(w0.w & 0xffff0000u);
        wf[8] = __uint_as_float(w1.x << 16); wf[9] = __uint_as_float(w1.x & 0xffff0000u); wf[10] = __uint_as_float(w1.y << 16); wf[11] = __uint_as_float(w1.y & 0xffff0000u);
        wf[12] = __uint_as_float(w1.z << 16); wf[13] = __uint_as_float(w1.z & 0xffff0000u); wf[14] = __uint_as_float(w1.w << 16); wf[15] = __uint_as_float(w1.w & 0xffff0000u);
        float mine = 0.f;
        f32x4 s4[9][4];
#pragma unroll
        for (int r = 0; r < 9; ++r)
#pragma unroll
            for (int q = 0; q < 4; ++q) s4[r][q] = *(const f32x4*)(sh + r * NMODC + lane * 16 + 4 * q);
        float av[9];
#pragma unroll
        for (int r = 0; r < 9; ++r) { float a = 0.f;
#pragma unroll
            for (int q = 0; q < 4; ++q) a += s4[r][q][0] * wf[4 * q] + s4[r][q][1] * wf[4 * q + 1] + s4[r][q][2] * wf[4 * q + 2] + s4[r][q][3] * wf[4 * q + 3];
            av[r] = a; }
#pragma unroll
        for (int o = 1; o < 64; o <<= 1) {
#pragma unroll
            for (int r = 0; r < 9; ++r) av[r] += __shfl_xor(av[r], o); }
#pragma unroll
        for (int r = 0; r < 9; ++r) if (lane == r) mine = av[r];
        if (lane < 9) BIAS[(which * 9 + lane) * 4096 + n] = mine;
    }
}


DI void phase_post1(bf16* QKV, const float* qg, const float* kg, bf16* K1, bf16* V1, int lane, int wave, int row_lo, int row_hi, int bidx, int nblk) {
    constexpr int HD = 128, PPA = 32, NH = 10, pitch = NIN1, R = 2;
    const int gw = bidx * 8 + wave, NGW = nblk * 8;
    const float gq0 = qg[lane], gq1 = qg[lane + 64], gk0 = kg[lane], gk1 = kg[lane + 64];
    const int fi = lane & (PPA - 1); const float invf = exp2f(-(float)fi * (13.287712379549449f / (float)PPA));
    for (int row0 = row_lo + gw; row0 < row_hi; row0 += R * NGW) {
        int rows[R]; bool ok[R], lat[R]; int bb[R], key[R]; float cs[R], sn[R]; bf16* base[R];
        float x1[R][NH], x2[R][NH], ss[R][NH]; bf16 vv[R][4];
#pragma unroll
        for (int q = 0; q < R; ++q) { rows[q] = row0 + q * NGW; ok[q] = rows[q] < row_hi; if (!ok[q]) rows[q] = row0;
            lat[q] = rows[q] >= NCTX; const int tt = (rows[q] - NCTX) & (SEQ - 1);
            if (lat[q]) { bb[q] = (rows[q] - NCTX) >> 12; key[q] = CTXL + tt; } else { bb[q] = rows[q] >> 8; key[q] = rows[q] & 255; }
            cs[q] = 1.f; sn[q] = 0.f;
            if (lat[q]) { const float ang = (float)(lane < PPA ? (tt >> 6) : (tt & 63)) * invf; cs[q] = __cosf(ang); sn[q] = __sinf(ang); }
            base[q] = QKV + (size_t)rows[q] * pitch;
#pragma unroll
            for (int hq = 0; hq < NH; ++hq) { x1[q][hq] = bf2f(base[q][hq * HD + lane]); x2[q][hq] = bf2f(base[q][hq * HD + lane + 64]); }
#pragma unroll
            for (int j = 0; j < 4; ++j) vv[q][j] = base[q][1280 + 64 * j + lane]; }
        asm volatile("" ::: "memory");
#pragma unroll
        for (int q = 0; q < R; ++q)
#pragma unroll
            for (int hq = 0; hq < NH; ++hq) ss[q][hq] = x1[q][hq] * x1[q][hq] + x2[q][hq] * x2[q][hq];
#pragma unroll
        for (int o = 1; o < 64; o <<= 1) {
#pragma unroll
            for (int q = 0; q < R; ++q)
#pragma unroll
                for (int hq = 0; hq < NH; ++hq) ss[q][hq] += __shfl_xor(ss[q][hq], o); }
#pragma unroll
        for (int q = 0; q < R; ++q) if (ok[q]) {
#pragma unroll
            for (int hq = 0; hq < NH; ++hq) if (hq >= 8 || lat[q]) {
                const float rs = rsqrtf(ss[q][hq] * (1.f / (float)HD) + EPS);
                const float y1 = x1[q][hq] * rs * (hq < 8 ? gq0 : gk0), y2 = x2[q][hq] * rs * (hq < 8 ? gq1 : gk1);
                bf16* dst = hq < 8 ? base[q] + hq * HD : K1 + ((size_t)(bb[q] * 2 + (hq - 8)) * KVLEN + key[q]) * HD;
                dst[lane] = f2bf(y1 * cs[q] - y2 * sn[q]); dst[lane + 64] = f2bf(y2 * cs[q] + y1 * sn[q]); }
            bf16* vd0 = V1 + ((size_t)(bb[q] * 2) * KVLEN + key[q]) * HD; bf16* vd1 = V1 + ((size_t)(bb[q] * 2 + 1) * KVLEN + key[q]) * HD;
            vd0[lane] = vv[q][0]; vd0[lane + 64] = vv[q][1]; vd1[lane] = vv[q][2]; vd1[lane + 64] = vv[q][3]; }
    }
}

template <int HD>
DI void phase_post(bf16* QKV, int pitch, int qcol, int nq, int kcol, int nk, int vcol, const float* qg, const float* kg, bf16* VT, bool q_for_ctx,
                   LAS unsigned char* lds, int tid, int lane, int wave, int row_lo = 0, int row_hi = MTOT, int tile_lo = 0, int tile_hi = MTOT / 64) {
    constexpr int PPA = HD / 4, NH = 10, R = 2;
    const int gw = blockIdx.x * 8 + wave, NGW = gridDim.x * 8;
    float gq0, gq1 = 0.f, gk0, gk1 = 0.f;
    gq0 = qg[lane]; gk0 = kg[lane]; if (HD == 128) { gq1 = qg[lane + 64]; gk1 = kg[lane + 64]; }
    const int jj = (HD == 64) ? (lane & 31) : lane;
    const float invf = exp2f(-(float)(jj & (PPA - 1)) * (13.287712379549449f / (float)PPA));
    for (int row0 = row_lo + gw; row0 < row_hi; row0 += R * NGW) {
        int rows[R]; bool ok[R], lat[R]; int h0[R]; float cs[R], sn[R]; bf16* base[R];
        float x1[R][NH], x2[R][NH], ss[R][NH];
#pragma unroll
        for (int q = 0; q < R; ++q) { rows[q] = row0 + q * NGW; ok[q] = rows[q] < row_hi; if (!ok[q]) rows[q] = row0;
            lat[q] = rows[q] >= NCTX; const int tt = (rows[q] - NCTX) & (SEQ - 1);
            cs[q] = 1.f; sn[q] = 0.f;
            if (lat[q]) { const float ang = (float)(jj < PPA ? (tt >> 6) : (tt & 63)) * invf; cs[q] = __cosf(ang); sn[q] = __sinf(ang); }
            h0[q] = (lat[q] || q_for_ctx) ? 0 : nq;
            base[q] = QKV + (size_t)rows[q] * pitch + qcol;
#pragma unroll
            for (int hq = 0; hq < NH; ++hq) { x1[q][hq] = bf2f(base[q][hq * HD + lane]); x2[q][hq] = 0.f; if (HD == 128) x2[q][hq] = bf2f(base[q][hq * HD + lane + 64]); } }
        asm volatile("" ::: "memory");
#pragma unroll
        for (int q = 0; q < R; ++q)
#pragma unroll
            for (int hq = 0; hq < NH; ++hq) ss[q][hq] = x1[q][hq] * x1[q][hq] + x2[q][hq] * x2[q][hq];
#pragma unroll
        for (int o = 1; o < 64; o <<= 1) {
#pragma unroll
            for (int q = 0; q < R; ++q)
#pragma unroll
                for (int hq = 0; hq < NH; ++hq) ss[q][hq] += __shfl_xor(ss[q][hq], o); }
#pragma unroll
        for (int q = 0; q < R; ++q) {
#pragma unroll
            for (int hq = 0; hq < NH; ++hq) if (hq >= h0[q]) {
                const float rs = rsqrtf(ss[q][hq] * (1.f / (float)HD) + EPS);
                if (HD == 64) { const float y = x1[q][hq] * rs * (hq < 8 ? gq0 : gk0); const float pr = __shfl_xor(y, 32);
                    if (ok[q]) base[q][hq * HD + lane] = f2bf(lane < 32 ? y * cs[q] - pr * sn[q] : y * cs[q] + pr * sn[q]); }
                else { const float y1 = x1[q][hq] * rs * (hq < 8 ? gq0 : gk0), y2 = x2[q][hq] * rs * (hq < 8 ? gq1 : gk1);
                    if (ok[q]) { base[q][hq * HD + lane] = f2bf(y1 * cs[q] - y2 * sn[q]); base[q][hq * HD + lane + 64] = f2bf(y2 * cs[q] + y1 * sn[q]); } }
            } }
    }
    constexpr int NV = 2 * HD, TP = NV + 2;
    LAS bf16* tile = (LAS bf16*)lds;
    for (int tk = tile_lo + blockIdx.x; tk < tile_hi; tk += gridDim.x) {
        const int row0 = 64 * tk; int b, key0;
        if (row0 < NCTX) { b = row0 >> 8; key0 = row0 & 255; } else { const int lr = row0 - NCTX; b = lr >> 12; key0 = 256 + (lr & 4095); }
        { constexpr int NIT = 64 * NV / 512; bf16 tv[NIT];
#pragma unroll
          for (int i = 0; i < NIT; ++i) { const int idx = tid + 512 * i, tok = idx / NV, c = idx - tok * NV; tv[i] = QKV[(size_t)(row0 + tok) * pitch + vcol + c]; }
#pragma unroll
          for (int i = 0; i < NIT; ++i) { const int idx = tid + 512 * i, tok = idx / NV, c = idx - tok * NV; tile[tok * TP + c] = tv[i]; } }
        __syncthreads();
        for (int idx = tid; idx < 64 * NV; idx += 512) { const int rr = idx >> 6, key = idx & 63; VT[(size_t)(b * NV + rr) * KVLEN + key0 + key] = tile[key * TP + rr]; }
        __syncthreads();
    }
}

constexpr int MP = 136;
constexpr int ML_VT = 0, ML_VWT = 40 * MP * 2, ML_CT = 2 * 40 * MP * 2, ML_Q = 3 * 40 * MP * 2, ML_K = ML_Q + 128 * MP * 2, ML_KT = ML_K + 128 * MP * 2, ML_SC = ML_KT + 128 * MP * 2;
static_assert(ML_SC + 5120 <= LDS_BYTES, "mLSTM LDS map");
DI void mlstm_item(const Params& p, LAS unsigned char* lds, int item, int tid, int lane, int wave) {
    const int dvq = item & 3, dir = (item >> 2) & 1, head = (item >> 3) & 3, b = item >> 5;
    const bf16* QKV = (const bf16*)(p.ws + WS_BIG); const float* GT = (const float*)(p.ws + WS_GATES);
    float* XC = (float*)(p.ws + WS_XC);
    LAS bf16* VTs = (LAS bf16*)(lds + ML_VT); LAS bf16* VWTs = (LAS bf16*)(lds + ML_VWT); LAS bf16* CTs = (LAS bf16*)(lds + ML_CT);
    LAS bf16* Qs = (LAS bf16*)(lds + ML_Q); LAS bf16* Ks = (LAS bf16*)(lds + ML_K); LAS bf16* KTs = (LAS bf16*)(lds + ML_KT); LAS bf16* Ss = Ks;
    LAS float* sc = (LAS float*)(lds + ML_SC);
    LAS float* s_ic = sc; LAS float* s_fc = sc + 128; LAS float* s_a = sc + 256; LAS float* s_rt = sc + 384; LAS float* s_iw = sc + 512;
    LAS float* s_w = sc + 640; LAS float* s_emt = sc + 768; LAS float* s_den = sc + 896; LAS float* s_misc = sc + 1024;
    const int r = lane & 31, h = lane >> 5, ti = wave >> 1, tj = wave & 1;
    const float KSCALE = 0.08838834764831845f;
    for (int i = tid; i < 40 * MP; i += 512) CTs[i] = 0;
    if (tid < 128) VTs[32 * MP + tid] = 0x3F80;
    f32x16 accC = zero16(); float m = 0.f;
    __syncthreads();
    for (int ci = 0; ci < 34; ++ci) {
        int base;
        if (ci < 2) { const int cc = dir ? 1 - ci : ci; base = b * 256 + cc * 128; }
        else { const int cc = dir ? 31 - (ci - 2) : (ci - 2); base = NCTX + b * 4096 + cc * 128; }
#pragma unroll
        for (int i = 0; i < 4; ++i) { const int id = tid + 512 * i, rr = id >> 4, c = id & 15; const size_t grow = base + (dir ? 127 - rr : rr);
            const bf16* src = QKV + grow * NIN0 + head * 128 + c * 8;
            *(LAS u32x4*)(Qs + rr * MP + c * 8) = *(const u32x4*)src; *(LAS u32x4*)(Ks + rr * MP + c * 8) = *(const u32x4*)(src + 512); }
        { const int rr = tid >> 2, c = tid & 3; const size_t grow = base + (dir ? 127 - rr : rr);
            const u32x4 v = *(const u32x4*)(QKV + grow * NIN0 + 1024 + head * 128 + dvq * 32 + c * 8);
            LAS bf16* d = VTs + (c * 8) * MP + rr;
            d[0] = (bf16)(v.x & 0xffffu); d[MP] = (bf16)(v.x >> 16); d[2 * MP] = (bf16)(v.y & 0xffffu); d[3 * MP] = (bf16)(v.y >> 16);
            d[4 * MP] = (bf16)(v.z & 0xffffu); d[5 * MP] = (bf16)(v.z >> 16); d[6 * MP] = (bf16)(v.w & 0xffffu); d[7 * MP] = (bf16)(v.w >> 16); }
        if (tid < 256) { const int rr = tid & 127; const size_t grow = base + (dir ? 127 - rr : rr); const int gi = (dir ? 2 : 0) + (tid >> 7);
            const float gv = GT[grow * 16 + gi * 4 + head]; if (tid < 128) s_ic[rr] = gv; else s_fc[rr] = gv; }
        __syncthreads();
        { const int d = tid & 127, sg = tid >> 7;
#pragma unroll
            for (int s8 = 0; s8 < 4; ++s8) { const LAS bf16* kp = Ks + (32 * sg + 8 * s8) * MP + d;
                u32x4 o; o.x = (unsigned)kp[0] | ((unsigned)kp[MP] << 16); o.y = (unsigned)kp[2 * MP] | ((unsigned)kp[3 * MP] << 16);
                o.z = (unsigned)kp[4 * MP] | ((unsigned)kp[5 * MP] << 16); o.w = (unsigned)kp[6 * MP] | ((unsigned)kp[7 * MP] << 16);
                *(LAS u32x4*)(KTs + d * MP + 32 * sg + 8 * s8) = o; } }
        if (wave == 0) {
            const float f0 = s_fc[2 * lane], f1 = s_fc[2 * lane + 1], i0 = s_ic[2 * lane], i1 = s_ic[2 * lane + 1];
            float S = f0 + f1;
#pragma unroll
            for (int o = 1; o < 64; o <<= 1) { const float t = __shfl_up(S, o); if (lane >= o) S += t; }
            const float bc1 = S, bc0 = S - f1, a0 = i0 - bc0, a1 = i1 - bc1;
            float P = fmaxf(a0, a1);
#pragma unroll
            for (int o = 1; o < 64; o <<= 1) { const float t = __shfl_up(P, o); if (lane >= o) P = fmaxf(P, t); }
            float Pex = __shfl_up(P, 1); if (lane == 0) Pex = -INFINITY;
            const float pm0 = fmaxf(Pex, a0), pm1 = P;
            const float blast = __shfl(bc1, 63), Mall = __shfl(P, 63);
            const float mnew = blast + fmaxf(m, Mall);
            const float rt0 = -fmaxf(m, pm0), rt1 = -fmaxf(m, pm1);
            s_a[2 * lane] = a0; s_a[2 * lane + 1] = a1; s_rt[2 * lane] = rt0; s_rt[2 * lane + 1] = rt1;
            s_iw[2 * lane] = __expf(m + rt0); s_iw[2 * lane + 1] = __expf(m + rt1);
            s_w[2 * lane] = __expf(a0 + blast - mnew) * KSCALE; s_w[2 * lane + 1] = __expf(a1 + blast - mnew) * KSCALE;
            s_emt[2 * lane] = __expf(rt0 - bc0); s_emt[2 * lane + 1] = __expf(rt1 - bc1);
            if (lane == 0) { s_misc[0] = __expf(blast + m - mnew); s_misc[1] = mnew; }
        }
        __syncthreads();
        const float carry = s_misc[0], mnew = s_misc[1];
        for (int idx = tid; idx < 33 * 128; idx += 512) { const int e = idx >> 7, s = idx & 127; VWTs[e * MP + s] = f2bf(bf2f(VTs[e * MP + s]) * s_w[s]); }
        float sv[2][16];
#pragma unroll
        for (int tt = 0; tt < 2; ++tt) { const int tjs = (wave & 1) * 2 + tt;
            if (tjs <= ti) { f32x16 acc = zero16(); mma32(acc, Qs + 32 * ti * MP, MP, Ks + 32 * tjs * MP, MP, 128, lane);
                const int scol = 32 * tjs + r; const float as = s_a[scol];
#pragma unroll
                for (int i = 0; i < 16; ++i) { const int trow = 32 * ti + crow(i, h); const float e = (scol <= trow) ? __expf(as + s_rt[trow]) : 0.f; sv[tt][i] = acc[i] * KSCALE * e; } } }
        __syncthreads();
#pragma unroll
        for (int tt = 0; tt < 2; ++tt) { const int tjs = (wave & 1) * 2 + tt;
            if (tjs <= ti) { const int scol = 32 * tjs + r;
#pragma unroll
                for (int i = 0; i < 16; ++i) Ss[(32 * ti + crow(i, h)) * MP + scol] = f2bf(sv[tt][i]); } }
        __syncthreads();
        f32x16 a1 = zero16(), a2 = zero16(), up = zero16();
        mma32(a1, Qs + 32 * ti * MP, MP, CTs + 32 * tj * MP, MP, 128, lane);
        mma32(a2, Ss + 32 * ti * MP, MP, VTs + 32 * tj * MP, MP, 32 * (ti + 1), lane);
        float num[16];
#pragma unroll
        for (int i = 0; i < 16; ++i) num[i] = s_iw[32 * ti + crow(i, h)] * a1[i] + a2[i];
        if (tj == 1 && r == 0) {
#pragma unroll
            for (int i = 0; i < 16; ++i) s_den[32 * ti + crow(i, h)] = num[i]; }
        mma32(up, KTs + 32 * ti * MP, MP, VWTs + 32 * tj * MP, MP, 128, lane);
#pragma unroll
        for (int i = 0; i < 16; ++i) accC[i] = carry * accC[i] + up[i];
        __syncthreads();
        if (tj == 0) {
#pragma unroll
            for (int i = 0; i < 16; ++i) { const int trow = 32 * ti + crow(i, h); const float hv = num[i] / fmaxf(fabsf(s_den[trow]), s_emt[trow]);
                const int grow = base + (dir ? 127 - trow : trow);
                float* dst = grow < NCTX ? XC + (size_t)grow * DM : p.out + (size_t)(grow - NCTX) * DM;
                dst[dir * 512 + head * 128 + dvq * 32 + r] = hv; } }
        if (tj == 0 || r == 0) {
#pragma unroll
            for (int g = 0; g < 4; ++g) { u32x2 o; o.x = cvtpk(accC[4 * g], accC[4 * g + 1]); o.y = cvtpk(accC[4 * g + 2], accC[4 * g + 3]);
                *(LAS u32x2*)(CTs + (32 * tj + r) * MP + 32 * ti + 8 * g + 4 * h) = o; } }
        m = mnew;
    }
    __syncthreads();
}


constexpr int NCH = 34, UROWS = 129;
constexpr size_t WS_MSC = WS_GATES + 2560 * 1024;
DI int chunk_base(int b, int cp) { return cp < 2 ? b * CTXL + cp * 128 : NCTX + b * SEQ + (cp - 2) * 128; }
DI float shfl_up_l(float v, int o, int lane) { return __int_as_float(__builtin_amdgcn_ds_bpermute((lane >= o ? lane - o : lane) << 2, __float_as_int(v))); }
DI void chunk_scan(int dir, const LAS float* ic, const LAS float* fc, int lane, float& a0, float& a1, float& pm0, float& pm1, float& bc0, float& bc1, float& blast, float& Mall, int& u0, int& u1) {
    u0 = dir ? 127 - 2 * lane : 2 * lane; u1 = dir ? u0 - 1 : u0 + 1;
    const float f0 = fc[u0], f1 = fc[u1], i0 = ic[u0], i1 = ic[u1];
    float S = f0 + f1;
#pragma unroll
    for (int o = 1; o < 64; o <<= 1) { const float t = shfl_up_l(S, o, lane); if (lane >= o) S += t; }
    bc1 = S; bc0 = S - f1; a0 = i0 - bc0; a1 = i1 - bc1;
    float P = fmaxf(a0, a1);
#pragma unroll
    for (int o = 1; o < 64; o <<= 1) { const float t = shfl_up_l(P, o, lane); if (lane >= o) P = fmaxf(P, t); }
    float Pex = shfl_up_l(P, 1, lane); if (lane == 0) Pex = -INFINITY;
    pm0 = fmaxf(Pex, a0); pm1 = P;
    blast = __int_as_float(__builtin_amdgcn_readlane(__float_as_int(bc1), 63)); Mall = __int_as_float(__builtin_amdgcn_readlane(__float_as_int(P), 63));
}
constexpr int X_VT = 0, X_VWT = UROWS * MP * 2, X_KT = 2 * UROWS * MP * 2, X_SC = X_KT + 128 * MP * 2;
DI void mlstm_x1(const Params& p, LAS unsigned char* lds, int item, int tid_in, int lane_in, int wave) {
    int tid = tid_in; asm volatile("" : "+v"(tid)); const int lane = tid & 63; (void)lane_in;
    const int cp = item % NCH, head = (item / NCH) & 3, b = item / (NCH * 4);
    const bf16* QKV = (const bf16*)(p.ws + WS_BIG); const float* GT = (const float*)(p.ws + WS_GATES);
    bf16* UT = (bf16*)p.out; float* SC = (float*)(p.ws + WS_MSC);
    LAS bf16* VTs = (LAS bf16*)(lds + X_VT); LAS bf16* VWTs = (LAS bf16*)(lds + X_VWT); LAS bf16* KTs = (LAS bf16*)(lds + X_KT);
    LAS float* sc = (LAS float*)(lds + X_SC);
    LAS float* s_w = sc + 512;
    const int base = chunk_base(b, cp);
    const int r = lane & 31, h = lane >> 5;
    const float KSCALE = 0.08838834764831845f;
    __syncthreads();
#pragma unroll
    for (int i = 0; i < 4; ++i) { const int id = tid + 512 * i, rr = id & 127, c = id >> 7;
        const bf16* src = QKV + (size_t)(base + rr) * NIN0 + head * 128 + c * 8;
        const u32x4 k = *(const u32x4*)(src + 512), v = *(const u32x4*)(src + 1024);
        LAS bf16* dk = KTs + (c * 8) * MP + rr; LAS bf16* dv = VTs + (c * 8) * MP + rr;
        dk[0] = (bf16)(k.x & 0xffffu); dk[MP] = (bf16)(k.x >> 16); dk[2 * MP] = (bf16)(k.y & 0xffffu); dk[3 * MP] = (bf16)(k.y >> 16);
        dk[4 * MP] = (bf16)(k.z & 0xffffu); dk[5 * MP] = (bf16)(k.z >> 16); dk[6 * MP] = (bf16)(k.w & 0xffffu); dk[7 * MP] = (bf16)(k.w >> 16);
        dv[0] = (bf16)(v.x & 0xffffu); dv[MP] = (bf16)(v.x >> 16); dv[2 * MP] = (bf16)(v.y & 0xffffu); dv[3 * MP] = (bf16)(v.y >> 16);
        dv[4 * MP] = (bf16)(v.z & 0xffffu); dv[5 * MP] = (bf16)(v.z >> 16); dv[6 * MP] = (bf16)(v.w & 0xffffu); dv[7 * MP] = (bf16)(v.w >> 16); }
    { const int u = tid & 127, gi = tid >> 7; sc[gi * 128 + u] = GT[(size_t)(base + u) * 16 + gi * 4 + head]; }
    __syncthreads();
    if (wave < 2) { const int dir = wave; float a0, a1, pm0, pm1, bc0, bc1, blast, Mall; int u0, u1;
        chunk_scan(dir, sc + dir * 256, sc + dir * 256 + 128, lane, a0, a1, pm0, pm1, bc0, bc1, blast, Mall, u0, u1);
        s_w[dir * 128 + u0] = __expf(a0 - Mall) * KSCALE; s_w[dir * 128 + u1] = __expf(a1 - Mall) * KSCALE;
        if (lane == 0) { float* o = SC + ((size_t)((b * 4 + head) * 2 + dir) * NCH + cp) * 2; o[0] = blast; o[1] = Mall; } }
    __syncthreads();
    for (int dir = 0; dir < 2; ++dir) {
        for (int idx = tid; idx < UROWS * 16; idx += 512) { const int e = idx >> 4, c8 = (idx & 15) * 8;
            const u32x4 v = e < 128 ? *(const LAS u32x4*)(VTs + e * MP + c8) : (u32x4){0x3F803F80u, 0x3F803F80u, 0x3F803F80u, 0x3F803F80u};
            const f32x4 w0 = *(const LAS f32x4*)(s_w + dir * 128 + c8), w1 = *(const LAS f32x4*)(s_w + dir * 128 + c8 + 4);
            u32x4 o; o.x = cvtpk(__uint_as_float(v.x << 16) * w0[0], __uint_as_float(v.x & 0xffff0000u) * w0[1]); o.y = cvtpk(__uint_as_float(v.y << 16) * w0[2], __uint_as_float(v.y & 0xffff0000u) * w0[3]);
            o.z = cvtpk(__uint_as_float(v.z << 16) * w1[0], __uint_as_float(v.z & 0xffff0000u) * w1[1]); o.w = cvtpk(__uint_as_float(v.w << 16) * w1[2], __uint_as_float(v.w & 0xffff0000u) * w1[3]);
            *(LAS u32x4*)(VWTs + e * MP + c8) = o; }
        __syncthreads();
        bf16* Uo = UT + ((size_t)((b * 4 + head) * 2 + dir) * NCH + cp) * (UROWS * 128);
        for (int tile = wave; tile < 20; tile += 8) { const int td = tile & 3, te = tile >> 2;
            f32x16 acc = zero16();
            const LAS bf16* bp = VWTs + (te < 4 ? (32 * te + r) : 128) * MP + 8 * h; const LAS bf16* ap = KTs + (32 * td + r) * MP + 8 * h;
#pragma unroll
            for (int k0 = 0; k0 < 128; k0 += 16) acc = MFMA32(*(const LAS bf16x8*)(ap + k0), *(const LAS bf16x8*)(bp + k0), acc);
            if (te < 4 || r == 0) { bf16* dst = Uo + (size_t)(te < 4 ? 32 * te + r : 128) * 128 + 32 * td + 4 * h;
#pragma unroll
                for (int g = 0; g < 4; ++g) { u32x2 o; o.x = cvtpk(acc[4 * g], acc[4 * g + 1]); o.y = cvtpk(acc[4 * g + 2], acc[4 * g + 3]); *(u32x2*)(dst + 8 * g) = o; } } }
        __syncthreads();
    }
}
DI void mlstm_x2(const Params& p, int tid) {
    const bf16* __restrict__ UT = (const bf16*)p.out; const float* __restrict__ SC = (const float*)(p.ws + WS_MSC); float* __restrict__ MST = (float*)(p.ws + WS_MSC) + 64 * NCH * 2;
    bf16* __restrict__ CT = (bf16*)(p.ws + WS_BIG) + (size_t)MTOT * NIN0;
    constexpr int SZ = UROWS * 128;
    for (int item = blockIdx.x; item < 256; item += gridDim.x) {
        const int chain = item >> 2, part = item & 3, dir = chain & 1;
        const int g1 = part * 512 + tid; const bool has2 = (part == 0) && (tid < 16); const int g2 = 2048 + (tid & 15);
        float c[8], c2[8];
#pragma unroll
        for (int j = 0; j < 8; ++j) { c[j] = 0.f; c2[j] = 0.f; }
        float m = 0.f;
        const size_t cb = (size_t)chain * NCH;
#pragma unroll 1
        for (int half = 0; half < 2; ++half) {
            u32x4 uv[17], uw[17]; f32x2 scv[17];
#pragma unroll
            for (int j = 0; j < 17; ++j) { const int ci = half * 17 + j, cp = dir ? (ci < 2 ? 1 - ci : 35 - ci) : ci;
                uv[j] = *(const u32x4*)(UT + (cb + cp) * SZ + g1 * 8);
                uw[j] = has2 ? *(const u32x4*)(UT + (cb + cp) * SZ + g2 * 8) : (u32x4){0u, 0u, 0u, 0u};
                scv[j] = *(const f32x2*)(SC + (cb + cp) * 2); }
            asm volatile("" ::: "memory");
#pragma unroll
            for (int j = 0; j < 17; ++j) { const int ci = half * 17 + j, cp = dir ? (ci < 2 ? 1 - ci : 35 - ci) : ci;
                const float blast = scv[j].x, Mall = scv[j].y;
                u32x4 o; o.x = cvtpk(c[0], c[1]); o.y = cvtpk(c[2], c[3]); o.z = cvtpk(c[4], c[5]); o.w = cvtpk(c[6], c[7]);
                *(u32x4*)(CT + (cb + cp) * SZ + g1 * 8) = o;
                if (has2) { u32x4 o2; o2.x = cvtpk(c2[0], c2[1]); o2.y = cvtpk(c2[2], c2[3]); o2.z = cvtpk(c2[4], c2[5]); o2.w = cvtpk(c2[6], c2[7]); *(u32x4*)(CT + (cb + cp) * SZ + g2 * 8) = o2; }
                if (part == 0 && tid == 0) MST[cb + cp] = m;
                const float mnew = blast + fmaxf(m, Mall), cw = __expf(blast + m - mnew), uwt = __expf(blast + Mall - mnew);
                const u32x4 a = uv[j], b2 = uw[j];
                c[0] = cw * c[0] + uwt * __uint_as_float(a.x << 16); c[1] = cw * c[1] + uwt * __uint_as_float(a.x & 0xffff0000u);
                c[2] = cw * c[2] + uwt * __uint_as_float(a.y << 16); c[3] = cw * c[3] + uwt * __uint_as_float(a.y & 0xffff0000u);
                c[4] = cw * c[4] + uwt * __uint_as_float(a.z << 16); c[5] = cw * c[5] + uwt * __uint_as_float(a.z & 0xffff0000u);
                c[6] = cw * c[6] + uwt * __uint_as_float(a.w << 16); c[7] = cw * c[7] + uwt * __uint_as_float(a.w & 0xffff0000u);
                c2[0] = cw * c2[0] + uwt * __uint_as_float(b2.x << 16); c2[1] = cw * c2[1] + uwt * __uint_as_float(b2.x & 0xffff0000u);
                c2[2] = cw * c2[2] + uwt * __uint_as_float(b2.y << 16); c2[3] = cw * c2[3] + uwt * __uint_as_float(b2.y & 0xffff0000u);
                c2[4] = cw * c2[4] + uwt * __uint_as_float(b2.z << 16); c2[5] = cw * c2[5] + uwt * __uint_as_float(b2.z & 0xffff0000u);
                c2[6] = cw * c2[6] + uwt * __uint_as_float(b2.w << 16); c2[7] = cw * c2[7] + uwt * __uint_as_float(b2.w & 0xffff0000u);
                m = mnew; }
        }
    }
}
constexpr int Y_VT = 0, Y_S = UROWS * MP * 2, Y_C = Y_S + 128 * MP * 2, Y_SC = Y_C + 2 * UROWS * MP * 2;
static_assert(Y_SC + 7168 <= LDS_BYTES - 16, "X3 LDS map");
DI void mlstm_x3(const Params& p, LAS unsigned char* lds, int item, int tid_in, int lane_in, int wave) {
    (void)tid_in; (void)lane_in;
    int tid = wave * 64 + fresh_lane(); asm volatile("" : "+v"(tid)); const int lane = tid & 63;
    const int cp = item % NCH, head = (item / NCH) & 3, b = item / (NCH * 4);
    const bf16* QKV = (const bf16*)(p.ws + WS_BIG); const float* GT = (const float*)(p.ws + WS_GATES);
    const float* MST = (const float*)(p.ws + WS_MSC) + 64 * NCH * 2;
    const bf16* CT = (const bf16*)(p.ws + WS_BIG) + (size_t)MTOT * NIN0;
    bf16* OC = (bf16*)(p.ws + WS_OCAT);
    { size_t z0 = 0; asm volatile("" : "+s"(z0)); QKV += z0; CT += z0; OC += z0; GT += z0; }
    LAS bf16* VTs = (LAS bf16*)(lds + Y_VT); LAS bf16* Ss = (LAS bf16*)(lds + Y_S);
    LAS float* sc = (LAS float*)(lds + Y_SC);
    LAS float* s_dir = sc + 512; LAS float* s_ssq = sc + 512 + 1024;
    LAS bf16* Cs = (LAS bf16*)(lds + Y_C);
    const int base = chunk_base(b, cp);
    const int r_ = lane & 31, h = lane >> 5, ti = wave >> 1, eh = wave & 1;
    const float KSCALE = 0.08838834764831845f;
    __syncthreads();
    const float mst0 = MST[(size_t)((b * 4 + head) * 2) * NCH + cp], mst1 = MST[(size_t)((b * 4 + head) * 2 + 1) * NCH + cp];
    u32x4 vr[4];
#pragma unroll
    for (int i = 0; i < 4; ++i) { const int id = tid + 512 * i, rr = id & 127, c = id >> 7; vr[i] = *(const u32x4*)(QKV + (size_t)(base + rr) * NIN0 + 1024 + head * 128 + c * 8); }
    const float gval = GT[(size_t)(base + (tid & 127)) * 16 + (tid >> 7) * 4 + head];
    u32x4 cb[9];
    { const bf16* C0 = CT + ((size_t)((b * 4 + head) * 2) * NCH + cp) * (UROWS * 128);
#pragma unroll
      for (int i = 0; i < 9; ++i) { const int id = tid + 512 * i; const int idc = id < 2 * UROWS * 16 ? id : 0; const int dd = idc >= UROWS * 16, q = idc - dd * UROWS * 16;
          cb[i] = *(const u32x4*)(C0 + (size_t)dd * NCH * (UROWS * 128) + q * 8); } }
    bf16x8 qf[8], kf[2][8];
    { const bf16* qp = QKV + (size_t)(base + 32 * ti + r_) * NIN0 + head * 128 + 8 * h;
#pragma unroll
        for (int ks = 0; ks < 8; ++ks) qf[ks] = *(const bf16x8*)(qp + 16 * ks); }
#pragma unroll
    for (int tt = 0; tt < 2; ++tt) { const bf16* kp = QKV + (size_t)(base + 32 * (2 * eh + tt) + r_) * NIN0 + 512 + head * 128 + 8 * h;
#pragma unroll
        for (int ks = 0; ks < 8; ++ks) kf[tt][ks] = *(const bf16x8*)(kp + 16 * ks); }
    asm volatile("" ::: "memory");
#pragma unroll
    for (int i = 0; i < 4; ++i) { const int id = tid + 512 * i, rr = id & 127, c = id >> 7; const u32x4 v = vr[i];
        LAS bf16* dv = VTs + (c * 8) * MP + rr;
        dv[0] = (bf16)(v.x & 0xffffu); dv[MP] = (bf16)(v.x >> 16); dv[2 * MP] = (bf16)(v.y & 0xffffu); dv[3 * MP] = (bf16)(v.y >> 16);
        dv[4 * MP] = (bf16)(v.z & 0xffffu); dv[5 * MP] = (bf16)(v.z >> 16); dv[6 * MP] = (bf16)(v.w & 0xffffu); dv[7 * MP] = (bf16)(v.w >> 16); }
    if (tid < 128) VTs[128 * MP + tid] = 0x3F80;
    sc[(tid >> 7) * 128 + (tid & 127)] = gval;
#pragma unroll
    for (int i = 0; i < 9; ++i) { const int id = tid + 512 * i; if (id < 2 * UROWS * 16) { const int dd = id >= UROWS * 16, q = id - dd * UROWS * 16, e = q >> 4, c8 = (q & 15) * 8;
        *(LAS u32x4*)(Cs + (dd * UROWS + e) * MP + c8) = cb[i]; } }
    unsigned spk[2][8];
#pragma unroll
    for (int tt = 0; tt < 2; ++tt) { f32x16 sraw = zero16();
#pragma unroll
        for (int ks = 0; ks < 8; ++ks) sraw = MFMA32(qf[ks], kf[tt][ks], sraw);
#pragma unroll
        for (int i = 0; i < 8; ++i) spk[tt][i] = cvtpk(sraw[2 * i], sraw[2 * i + 1]); }
    __syncthreads();
    if (wave < 2) { const int dir = wave; float a0, a1, pm0, pm1, bc0, bc1, blast, Mall; int u0, u1;
        chunk_scan(dir, sc + dir * 256, sc + dir * 256 + 128, lane, a0, a1, pm0, pm1, bc0, bc1, blast, Mall, u0, u1);
        const float m = dir ? mst1 : mst0;
        const float rt0 = -fmaxf(m, pm0), rt1 = -fmaxf(m, pm1);
        LAS float* d = s_dir + dir * 512;
        d[u0] = a0; d[u1] = a1; d[128 + u0] = rt0; d[128 + u1] = rt1; d[256 + u0] = __expf(m + rt0); d[256 + u1] = __expf(m + rt1);
        d[384 + u0] = __expf(rt0 - bc0); d[384 + u1] = __expf(rt1 - bc1); }
    f32x16 hs[2]; hs[0] = zero16(); hs[1] = zero16();
#pragma unroll 1
    for (int dir = 0; dir < 2; ++dir) {
        __syncthreads();
        const LAS float* d = s_dir + dir * 512;
        int r = r_; asm volatile("" : "+v"(r));
#pragma unroll
        for (int tt = 0; tt < 2; ++tt) { const int tj = 2 * eh + tt; const bool need = dir ? (tj >= ti) : (tj <= ti);
            if (need) {
                const int scol = 32 * tj + r; const float as = d[scol];
#pragma unroll
                for (int i = 0; i < 16; ++i) { const int trow = 32 * ti + crow(i, h); const bool ok = dir ? (scol >= trow) : (scol <= trow);
                    const float e = ok ? __expf(as + d[128 + trow]) * KSCALE : 0.f;
                    const float sv = (i & 1) ? __uint_as_float(spk[tt][i >> 1] & 0xffff0000u) : __uint_as_float(spk[tt][i >> 1] << 16); Ss[trow * MP + scol] = f2bf(sv * e); } } }
        __syncthreads();
        asm volatile("" ::: "memory");
        const LAS bf16* Cb = Cs + dir * UROWS * MP;
        const int klo = dir ? 32 * ti : 0, khi = dir ? 128 : 32 * (ti + 1);
        const LAS bf16* sp = Ss + (32 * ti + r) * MP + 8 * h;
        {
            f32x16 a1 = zero16(), a2 = zero16();
            const LAS bf16* cpp = Cb + 128 * MP + 8 * h;
#pragma unroll
            for (int ks = 0; ks < 8; ++ks) a1 = MFMA32(qf[ks], *(const LAS bf16x8*)(cpp + 16 * ks), a1);
            const LAS bf16* vp = VTs + 128 * MP + 8 * h;
#pragma unroll 1
            for (int k0 = klo; k0 < khi; k0 += 16) a2 = MFMA32(*(const LAS bf16x8*)(sp + k0), *(const LAS bf16x8*)(vp + k0), a2);
            if (r == 0) {
#pragma unroll
            for (int i = 0; i < 16; ++i) { const int trow = 32 * ti + crow(i, h); sc[trow] = 1.f / fmaxf(fabsf(d[256 + trow] * a1[i] + a2[i]), d[384 + trow]); } }
        }
        asm volatile("" ::: "memory");
#pragma unroll
        for (int tt = 0; tt < 2; ++tt) { const int te = 2 * eh + tt;
            f32x16 a1 = zero16(), a2 = zero16();
            const LAS bf16* cpp = Cb + (32 * te + r) * MP + 8 * h;
#pragma unroll
            for (int ks = 0; ks < 8; ++ks) a1 = MFMA32(qf[ks], *(const LAS bf16x8*)(cpp + 16 * ks), a1);
            const LAS bf16* vp = VTs + (32 * te + r) * MP + 8 * h;
#pragma unroll 1
            for (int k0 = klo; k0 < khi; k0 += 16) a2 = MFMA32(*(const LAS bf16x8*)(sp + k0), *(const LAS bf16x8*)(vp + k0), a2);
#pragma unroll
            for (int i = 0; i < 16; ++i) { const int trow = 32 * ti + crow(i, h); hs[tt][i] += (d[256 + trow] * a1[i] + a2[i]) * sc[trow]; }
            asm volatile("" ::: "memory"); }
    }
#pragma unroll
    for (int i = 0; i < 16; ++i) { float q = hs[0][i] * hs[0][i] + hs[1][i] * hs[1][i];
#pragma unroll
        for (int o = 1; o < 32; o <<= 1) q += __int_as_float(__builtin_amdgcn_ds_bpermute((lane ^ o) << 2, __float_as_int(q)));
        if (r_ == 0) s_ssq[(32 * ti + crow(i, h)) * 2 + eh] = q; }
    __syncthreads();
    LAS float* Hs = (LAS float*)(lds + Y_C);
#pragma unroll
    for (int i = 0; i < 16; ++i) { const int trow = 32 * ti + crow(i, h);
        const float rs = rsqrtf((s_ssq[trow * 2] + s_ssq[trow * 2 + 1]) * (1.f / 128.f) + EPS);
        Hs[trow * 132 + 32 * (2 * eh) + r_] = hs[0][i] * rs; Hs[trow * 132 + 32 * (2 * eh + 1) + r_] = hs[1][i] * rs; }
    __syncthreads();
    const float* gn = p.in[10] + head * 128;
    const int c8o = (tid & 15) * 8;
    const f32x4 g0 = *(const f32x4*)(gn + c8o), g1 = *(const f32x4*)(gn + c8o + 4);
    u32x4 oav[4];
#pragma unroll
    for (int it = 0; it < 4; ++it) { const int row = (tid + 512 * it) >> 4; oav[it] = *(const u32x4*)(QKV + (size_t)(base + row) * NIN0 + 1536 + head * 128 + c8o); }
    asm volatile("" ::: "memory");
#pragma unroll
    for (int it = 0; it < 4; ++it) { const int row = (tid + 512 * it) >> 4; const size_t grow = base + row; const u32x4 oa = oav[it];
        const f32x4 v0 = *(const LAS f32x4*)(Hs + row * 132 + c8o), v1 = *(const LAS f32x4*)(Hs + row * 132 + c8o + 4);
        float o[8]; o[0] = __uint_as_float(oa.x << 16); o[1] = __uint_as_float(oa.x & 0xffff0000u); o[2] = __uint_as_float(oa.y << 16); o[3] = __uint_as_float(oa.y & 0xffff0000u);
        o[4] = __uint_as_float(oa.z << 16); o[5] = __uint_as_float(oa.z & 0xffff0000u); o[6] = __uint_as_float(oa.w << 16); o[7] = __uint_as_float(oa.w & 0xffff0000u);
        u32x4 w;
        w.x = cvtpk(v0[0] * g0[0] / (1.f + __expf(-o[0])), v0[1] * g0[1] / (1.f + __expf(-o[1]))); w.y = cvtpk(v0[2] * g0[2] / (1.f + __expf(-o[2])), v0[3] * g0[3] / (1.f + __expf(-o[3])));
        w.z = cvtpk(v1[0] * g1[0] / (1.f + __expf(-o[4])), v1[1] * g1[1] / (1.f + __expf(-o[5]))); w.w = cvtpk(v1[2] * g1[2] / (1.f + __expf(-o[6])), v1[3] * g1[3] / (1.f + __expf(-o[7])));
        *(u32x4*)(OC + grow * DM + head * 128 + c8o) = w; }
}

template <int D, int MODE, int NSUB>
DI void attn_item(const bf16* QKV, int pitch, int qcol0, int kcol0, const bf16* VT, bf16* O, int ocol0, const float* sink,
                  LAS unsigned char* lds, int item, int tid_in, int lane_in, int wave) {
    (void)tid_in; (void)lane_in;
    int tid = wave * 64 + fresh_lane(); asm volatile("" : "+v"(tid)); const int lane = tid & 63;
    constexpr int KT = 64 * NSUB, KP = D + 8, VP = KT + 4, KBYTES = KT * KP * 2, VBYTES = D * VP * 2, BUF = KBYTES + VBYTES, NPT = NSUB * D / 64, NKS = D / 16, NDT = D / 32, CPR = D / 8, VCR = 8 * NSUB;
    static_assert(2 * BUF <= LDS_BYTES - 16, "attention LDS");
    const int r = lane & 31, h = lane >> 5;
    int b, kvh, head, qrow, qpos = 0, nt, wstart = 0;
    if (MODE == 0) { const int qb = item & 15; head = (item >> 4) & 7; b = item >> 7; kvh = head >> 2; qrow = NCTX + b * SEQ + qb * 256 + 32 * wave; nt = KVLEN / KT; }
    else if (MODE == 1) { const int nb = item & 31, hp = (item >> 5) & 1; kvh = (item >> 6) & 1; b = item >> 7; head = kvh * 4 + hp * 2 + (wave >> 2);
        qpos = nb * 128 + (wave & 3) * 32 + r; qrow = NCTX + b * SEQ + nb * 128 + (wave & 3) * 32;
        wstart = nb > 0 ? (nb - 1) * 128 : 0; const int wend = nb < 31 ? (nb + 2) * 128 : SEQ; nt = (CTXL + wend - wstart) / KT; }
    else { const int qh = item & 1, hp = (item >> 1) & 1; kvh = (item >> 2) & 1; b = item >> 3; head = kvh * 4 + hp * 2 + (wave >> 2); qrow = b * 256 + qh * 128 + (wave & 3) * 32; nt = CTXL / KT; }
    const bf16* VTb = VT + (size_t)(b * 2 + kvh) * D * KVLEN;
    const int kcol = kcol0 + kvh * D;
    bf16x8 qf[NKS];
    { const bf16* qp = QKV + (size_t)(qrow + r) * pitch + qcol0 + head * D + 8 * h;
#pragma unroll
        for (int ks = 0; ks < NKS; ++ks) qf[ks] = *(const bf16x8*)(qp + 16 * ks); }
    const float scl = (D == 64 ? 0.125f : 0.08838834764831845f) * LOG2E;
    constexpr float THR2 = 11.0f;
    float mrun, lrun;
    if (MODE == 0) { mrun = -INFINITY; lrun = 0.f; } else { mrun = sink[head] * LOG2E; lrun = h == 0 ? 1.f : 0.f; }
    f32x16 o[NDT];
#pragma unroll
    for (int dt = 0; dt < NDT; ++dt) o[dt] = zero16();
    u32x4 kr[NPT], vr[NPT];
#define ATT_TILE(t, krow0, vkey0) do { const int key0 = KT * (t); if (MODE == 0) { krow0 = key0 < CTXL ? b * CTXL + key0 : NCTX + b * SEQ + key0 - CTXL; vkey0 = key0; } \
        else if (key0 < CTXL) { krow0 = b * CTXL + key0; vkey0 = key0; } else { const int kp_ = wstart + key0 - CTXL; krow0 = NCTX + b * SEQ + kp_; vkey0 = CTXL + kp_; } } while (0)
#define ATT_LOAD(t) do { int krow0, vkey0; ATT_TILE(t, krow0, vkey0); _Pragma("unroll") for (int i = 0; i < NPT; ++i) { const int id = tid + 512 * i; \
        kr[i] = *(const u32x4*)(QKV + (size_t)(krow0 + id / CPR) * pitch + kcol + (id % CPR) * 8); \
        vr[i] = *(const u32x4*)(VTb + (size_t)(id / VCR) * KVLEN + vkey0 + (id % VCR) * 8); } } while (0)
#define ATT_STORE(bi) do { LAS bf16* Kd = (LAS bf16*)(lds + (bi) * BUF); LAS bf16* Vd = (LAS bf16*)(lds + (bi) * BUF + KBYTES); _Pragma("unroll") for (int i = 0; i < NPT; ++i) { const int id = tid + 512 * i; \
        *(LAS u32x4*)(Kd + (id / CPR) * KP + (id % CPR) * 8) = kr[i]; { LAS u32x2* vd_ = (LAS u32x2*)(Vd + (id / VCR) * VP + (id % VCR) * 8); vd_[0] = (u32x2){vr[i].x, vr[i].y}; vd_[1] = (u32x2){vr[i].z, vr[i].w}; } } } while (0)
    ATT_LOAD(0); ATT_STORE(0);
    __syncthreads();
    for (int t = 0; t < nt; ++t) {
        if (t + 1 < nt) ATT_LOAD(t + 1);
        const LAS bf16* Kt = (const LAS bf16*)(lds + (t & 1) * BUF); const LAS bf16* Vt = (const LAS bf16*)(lds + (t & 1) * BUF + KBYTES);
#pragma unroll
        for (int sub = 0; sub < NSUB; ++sub) {
        f32x16 s[2];
#pragma unroll
        for (int q = 0; q < 2; ++q) { s[q] = zero16(); const LAS bf16* kp = Kt + (64 * sub + 32 * q + r) * KP + 8 * h;
#pragma unroll
            for (int ks = 0; ks < NKS; ++ks) s[q] = MFMA32(*(const LAS bf16x8*)(kp + 16 * ks), qf[ks], s[q]); }
        if (MODE == 1 && KT * t >= CTXL) { const int kp0 = wstart + KT * t + 64 * sub - CTXL - qpos;
#pragma unroll
            for (int q = 0; q < 2; ++q)
#pragma unroll
                for (int i = 0; i < 16; ++i) { const int d0 = kp0 + 32 * q + crow(i, h); if (d0 > 128 || d0 < -128) s[q][i] = -INFINITY; } }
        float mx = s[0][0];
#pragma unroll
        for (int q = 0; q < 2; ++q)
#pragma unroll
            for (int i = 0; i < 16; ++i) mx = fmaxf(mx, s[q][i]);
        mx = fmaxf(mx, __shfl_xor(mx, 32)) * scl;
        if (!__all(mx - mrun <= THR2)) {
            const float mnew = fmaxf(mrun, mx), alpha = __builtin_amdgcn_exp2f(mrun - mnew);
            lrun *= alpha; mrun = mnew;
#pragma unroll
            for (int dt = 0; dt < NDT; ++dt)
#pragma unroll
                for (int i = 0; i < 16; ++i) o[dt][i] *= alpha;
        }
        float ls = 0.f; const float nm = -mrun;
#pragma unroll
        for (int q = 0; q < 2; ++q)
#pragma unroll
            for (int i = 0; i < 16; ++i) { s[q][i] = __builtin_amdgcn_exp2f(fmaf(s[q][i], scl, nm)); ls += s[q][i]; }
        lrun += ls;
#pragma unroll
        for (int q = 0; q < 2; ++q)
#pragma unroll
            for (int s2 = 0; s2 < 2; ++s2) {
                u32x4 pw; pw.x = cvtpk(s[q][8 * s2], s[q][8 * s2 + 1]); pw.y = cvtpk(s[q][8 * s2 + 2], s[q][8 * s2 + 3]); pw.z = cvtpk(s[q][8 * s2 + 4], s[q][8 * s2 + 5]); pw.w = cvtpk(s[q][8 * s2 + 6], s[q][8 * s2 + 7]);
                const bf16x8 pb = __builtin_bit_cast(bf16x8, pw);
#pragma unroll
                for (int dt = 0; dt < NDT; ++dt) { const LAS bf16* vp = Vt + (32 * dt + r) * VP + 64 * sub + 32 * q + 16 * s2 + 4 * h;
                    const s16x4 lo = *(const LAS s16x4*)vp, hi = *(const LAS s16x4*)(vp + 8);
                    const bf16x8 a = __builtin_shufflevector(lo, hi, 0, 1, 2, 3, 4, 5, 6, 7);
                    o[dt] = MFMA32(a, pb, o[dt]); }
            }
        }
        if (t + 1 < nt) ATT_STORE((t + 1) & 1);
        __syncthreads();
    }
#undef ATT_TILE
#undef ATT_LOAD
#undef ATT_STORE
    const float inv = 1.f / (lrun + __shfl_xor(lrun, 32));
    bf16* op = O + (size_t)(qrow + r) * DM + ocol0 + head * D + 4 * h;
#pragma unroll
    for (int dt = 0; dt < NDT; ++dt)
#pragma unroll
        for (int g = 0; g < 4; ++g) { u32x2 w; w.x = cvtpk(o[dt][4 * g] * inv, o[dt][4 * g + 1] * inv); w.y = cvtpk(o[dt][4 * g + 2] * inv, o[dt][4 * g + 3] * inv);
            *(u32x2*)(op + 32 * dt + 8 * g) = w; }
}


namespace adb {
using bf16 = unsigned short;
using bf16x8 = __attribute__((ext_vector_type(8))) short;
using s16x4  = __attribute__((ext_vector_type(4))) short;
using f32x16 = __attribute__((ext_vector_type(16))) float;
using u32x4  = __attribute__((ext_vector_type(4))) unsigned;
using ::crow; using ::cvtpk;
constexpr int   D = 128, NW = 8, QBLK = 32, KVBLK = 64;
constexpr float SCALE = 0.088388347648318440f;
constexpr float THR = 8.f;
constexpr int SDEPTH = 2;
constexpr int LDQ = 1536, LDK = 128, LDO = 1024;
constexpr size_t SHM_V = KVBLK * D * 2, SHM_K = KVBLK * D * 2, SHM_ATTN = 2 * SHM_V + 2 * SHM_K + NW * 64 * 4;
#define KSWZ(row, colB) ((row) * 256 + ((colB) ^ (((row) & 7) << 4)))
#define SBAR() __builtin_amdgcn_sched_barrier(0)
template <typename TIn> struct Stage;
template <> struct Stage<bf16>  { using T = bf16x8;
  __device__ static __forceinline__ T ld8(const bf16* p) { return *reinterpret_cast<const bf16x8*>(p); }
  __device__ static __forceinline__ bf16x8 tobf(T x) { return x; } };

__device__ __forceinline__ void partialSM(f32x16& p0, f32x16& p1, float& m_reg, float& mn, float& alpha) {
  constexpr float C = SCALE * 1.4426950408889634f;
  float pmax = p0[0]; for (int r = 1; r < 16; ++r) pmax = fmaxf(pmax, p0[r]); for (int r = 0; r < 16; ++r) pmax = fmaxf(pmax, p1[r]);
  { auto rr = __builtin_amdgcn_permlane32_swap(__float_as_uint(pmax), __float_as_uint(pmax), false, false);
    pmax = fmaxf(__uint_as_float(rr[0]), __uint_as_float(rr[1])); }
  if (__builtin_expect(__all(pmax - m_reg <= THR / SCALE), 1)) { mn = m_reg; alpha = 1.f; }
  else { mn = fmaxf(m_reg, pmax); alpha = __builtin_amdgcn_exp2f((m_reg - mn) * C); m_reg = mn; }
  float mnC = -mn * C;
  for (int r = 0; r < 16; ++r) p0[r] = fmaf(p0[r], C, mnC); for (int r = 0; r < 16; ++r) p1[r] = fmaf(p1[r], C, mnC);
  for (int r = 0; r < 16; ++r) p0[r] = __builtin_amdgcn_exp2f(p0[r]);
}
__device__ __forceinline__ void finishSM(f32x16& p0, f32x16& p1, float alpha, float& l_reg, bf16x8& pa0, bf16x8& pa1, bf16x8& pa2, bf16x8& pa3) {
  for (int r = 0; r < 16; ++r) p1[r] = __builtin_amdgcn_exp2f(p1[r]);
  float ps = 0; for (int r = 0; r < 16; ++r) ps += p0[r]; for (int r = 0; r < 16; ++r) ps += p1[r];
  { auto rr = __builtin_amdgcn_permlane32_swap(__float_as_uint(ps), __float_as_uint(ps), false, false);
    ps = __uint_as_float(rr[0]) + __uint_as_float(rr[1]); }
  l_reg = l_reg * alpha + ps;
#define PK4(P, BASE, OUT) do { unsigned a0 = cvtpk(P[BASE + 0], P[BASE + 1]), a1 = cvtpk(P[BASE + 2], P[BASE + 3]);   \
    unsigned b0 = cvtpk(P[BASE + 4], P[BASE + 5]), b1 = cvtpk(P[BASE + 6], P[BASE + 7]);                              \
    auto r0 = __builtin_amdgcn_permlane32_swap(a0, b0, false, false); auto r1 = __builtin_amdgcn_permlane32_swap(a1, b1, false, false); \
    u32x4 w = {r0[0], r1[0], r0[1], r1[1]}; OUT = *reinterpret_cast<bf16x8*>(&w); } while (0)
  PK4(p0, 0, pa0); PK4(p0, 8, pa1); PK4(p1, 0, pa2); PK4(p1, 8, pa3);
#undef PK4
}
__device__ __forceinline__ void qkt(f32x16& p0, f32x16& p1, const bf16* Ks, const bf16x8* qr, int r32, int hi) {
  p0 = f32x16{}; p1 = f32x16{};
  for (int d0 = 0; d0 < 8; ++d0) { int cb = (d0 * 16 + hi * 8) * 2;
    bf16x8 b0 = *reinterpret_cast<const bf16x8*>((const char*)Ks + KSWZ(r32, cb));
    bf16x8 b1 = *reinterpret_cast<const bf16x8*>((const char*)Ks + KSWZ(32 + r32, cb));
    p0 = __builtin_amdgcn_mfma_f32_32x32x16_bf16(b0, qr[d0], p0, 0, 0, 0);
    p1 = __builtin_amdgcn_mfma_f32_32x32x16_bf16(b1, qr[d0], p1, 0, 0, 0); }
}
__device__ __forceinline__ int v_st(int k, int c) { const int kk = (k & ~0xC) | ((k & 4) << 1) | ((k & 8) >> 1); return ((kk >> 3) * 4 + (c >> 5)) * 512 + ((kk & 7) * 32 + (c & 31)) * 2; }
__device__ __forceinline__ int v_rd_base(int lane) { return ((lane & 3) << 3) | (((lane >> 2) & 3) << 6) | (((lane >> 4) & 1) << 5) | (((lane >> 5) & 1) << 8); }
constexpr int v_rd_off(int d0, int ks, int half) { return d0 * 512 + ks * 4096 + half * 2048; }
template <int OFF> __device__ __forceinline__ s16x4 tr_read(int vb) {
  s16x4 r; asm volatile("ds_read_b64_tr_b16 %0, %1 offset:%2" : "=&v"(r) : "v"(vb), "i"(OFF) : "memory"); return r;
}
template <int D0> __device__ __forceinline__ void pv_one(f32x16& od, int vb, bf16x8 pa0, bf16x8 pa1, bf16x8 pa2, bf16x8 pa3) {
  const s16x4 l0 = tr_read<v_rd_off(D0, 0, 0)>(vb), h0 = tr_read<v_rd_off(D0, 0, 1)>(vb), l1 = tr_read<v_rd_off(D0, 1, 0)>(vb), h1 = tr_read<v_rd_off(D0, 1, 1)>(vb);
  const s16x4 l2 = tr_read<v_rd_off(D0, 2, 0)>(vb), h2 = tr_read<v_rd_off(D0, 2, 1)>(vb), l3 = tr_read<v_rd_off(D0, 3, 0)>(vb), h3 = tr_read<v_rd_off(D0, 3, 1)>(vb);
  asm volatile("s_waitcnt lgkmcnt(0)" ::: "memory"); SBAR();
#define PK(L, H) (bf16x8){L[0], L[1], L[2], L[3], H[0], H[1], H[2], H[3]}
  od = __builtin_amdgcn_mfma_f32_32x32x16_bf16(pa0, PK(l0, h0), od, 0, 0, 0);
  od = __builtin_amdgcn_mfma_f32_32x32x16_bf16(pa1, PK(l1, h1), od, 0, 0, 0);
  od = __builtin_amdgcn_mfma_f32_32x32x16_bf16(pa2, PK(l2, h2), od, 0, 0, 0);
  od = __builtin_amdgcn_mfma_f32_32x32x16_bf16(pa3, PK(l3, h3), od, 0, 0, 0);
#undef PK
}
__device__ __forceinline__ void pv_d0(f32x16* o, int vb, bf16x8 pa0, bf16x8 pa1, bf16x8 pa2, bf16x8 pa3) {
  pv_one<0>(o[0], vb, pa0, pa1, pa2, pa3); pv_one<1>(o[1], vb, pa0, pa1, pa2, pa3); pv_one<2>(o[2], vb, pa0, pa1, pa2, pa3); pv_one<3>(o[3], vb, pa0, pa1, pa2, pa3);
}

template <typename TQ>
__device__ __forceinline__ void attn_dense_body(const TQ* __restrict__ Qb, const bf16* __restrict__ Kh, const bf16* __restrict__ Vh,
                                                bf16* __restrict__ Ob, int seq, char* lds, const int tid) {
  using St = Stage<bf16>; using SQ = Stage<TQ>;
  const int wid = __builtin_amdgcn_readfirstlane(tid >> 6), lane = tid & 63, r32 = lane & 31, hi = lane >> 5;
  bf16* V_lds = (bf16*)lds; bf16* K_lds = (bf16*)(lds + 2 * SHM_V);
  float* ws = (float*)(lds + 2 * SHM_V + 2 * SHM_K) + wid * 64; float* li_l = ws; float* al_l = ws + 32;
  float m_reg = -1e30f, l_reg = 0; f32x16 o[4] = {}; bf16x8 qr[8];
  const TQ* Qw = Qb + (long)(wid * QBLK + r32) * LDQ + hi * 8;
#pragma unroll
  for (int d0 = 0; d0 < 8; ++d0) qr[d0] = SQ::tobf(SQ::ld8(Qw + d0 * 16));
  const int sr = tid >> 4, sc = (tid & 15) * 8, vst0 = v_st(sr, sc), vst1 = v_st(32 + sr, sc);
  const int vb0 = (int)(uintptr_t)V_lds + v_rd_base(lane);
  struct { typename St::T vs0, vs1, ks0, ks1; } sr_[SDEPTH];
#define SLOAD(i, k0) do { sr_[i].vs0 = St::ld8(&Vh[(long)((k0) + sr) * LDK + sc]); sr_[i].vs1 = St::ld8(&Vh[(long)((k0) + 32 + sr) * LDK + sc]); \
    sr_[i].ks0 = St::ld8(&Kh[(long)((k0) + sr) * LDK + sc]); sr_[i].ks1 = St::ld8(&Kh[(long)((k0) + 32 + sr) * LDK + sc]); } while (0)
#define SWRITE(b, i) do { *(bf16x8*)((char*)V_lds + (b) * SHM_V + vst0) = St::tobf(sr_[i].vs0);          \
    *(bf16x8*)((char*)V_lds + (b) * SHM_V + vst1) = St::tobf(sr_[i].vs1); int kc = sc * 2;               \
    *(bf16x8*)((char*)K_lds + (b) * SHM_K + KSWZ(sr, kc)) = St::tobf(sr_[i].ks0);                       \
    *(bf16x8*)((char*)K_lds + (b) * SHM_K + KSWZ(32 + sr, kc)) = St::tobf(sr_[i].ks1); } while (0)
#define SWAIT() do { if constexpr (SDEPTH == 2) asm volatile("s_waitcnt vmcnt(4)" ::: "memory"); else asm volatile("s_waitcnt vmcnt(0)" ::: "memory"); } while (0)
#define RESC(a) do { if (__any((a) < 1.f)) { if (hi == 0) al_l[r32] = (a); asm volatile("s_waitcnt lgkmcnt(0)" ::: "memory"); \
    for (int d = 0; d < 4; ++d) for (int r = 0; r < 16; ++r) o[d][r] *= al_l[crow(r, hi)]; } } while (0)
  f32x16 pA0, pA1, pB0, pB1; float mnA, mnB, alA, alB; bf16x8 pa0, pa1, pa2, pa3; const int NT = seq / KVBLK;
  constexpr int SE = 0, SO = SDEPTH - 1;
  SLOAD(SE, 0); asm volatile("s_waitcnt vmcnt(0)" ::: "memory"); SWRITE(0, SE); __syncthreads();
  qkt(pA0, pA1, K_lds, qr, r32, hi); partialSM(pA0, pA1, m_reg, mnA, alA);
  SLOAD(SO, KVBLK); if constexpr (SDEPTH == 2) { if (2 < NT) SLOAD(SE, 2 * KVBLK); }
  SWAIT(); SWRITE(1, SO); __syncthreads();
  for (int j = 1; j + 1 < NT; j += 2) {
    SBAR(); qkt(pB0, pB1, (bf16*)((char*)K_lds + SHM_K), qr, r32, hi);
    finishSM(pA0, pA1, alA, l_reg, pa0, pa1, pa2, pa3); SBAR();
    SLOAD(SO, (j + SDEPTH) * KVBLK); SBAR();
    pv_d0(o, vb0, pa0, pa1, pa2, pa3); partialSM(pB0, pB1, m_reg, mnB, alB);
    __syncthreads(); SWAIT(); SWRITE(0, SE);
    RESC(alB); __syncthreads();
    SBAR(); qkt(pA0, pA1, K_lds, qr, r32, hi);
    finishSM(pB0, pB1, alB, l_reg, pa0, pa1, pa2, pa3); SBAR();
    if (SDEPTH == 1 || j + 3 < NT) SLOAD(SE, (j + 1 + SDEPTH) * KVBLK); SBAR();
    pv_d0(o, vb0 + (int)SHM_V, pa0, pa1, pa2, pa3); partialSM(pA0, pA1, m_reg, mnA, alA);
    __syncthreads(); SWAIT(); SWRITE(1, SO);
    RESC(alA); __syncthreads();
  }
  SBAR(); qkt(pB0, pB1, (bf16*)((char*)K_lds + SHM_K), qr, r32, hi);
  finishSM(pA0, pA1, alA, l_reg, pa0, pa1, pa2, pa3); SBAR();
  pv_d0(o, vb0, pa0, pa1, pa2, pa3); partialSM(pB0, pB1, m_reg, mnB, alB);
  __syncthreads(); RESC(alB);
  finishSM(pB0, pB1, alB, l_reg, pa0, pa1, pa2, pa3); SBAR();
  pv_d0(o, vb0 + (int)SHM_V, pa0, pa1, pa2, pa3);
  if (hi == 0) li_l[r32] = l_reg; asm volatile("s_waitcnt lgkmcnt(0)" ::: "memory");
  float rli[16];
#pragma unroll
  for (int r = 0; r < 16; ++r) rli[r] = __builtin_amdgcn_rcpf(li_l[crow(r, hi)]);
  bf16* Ow = Ob + (long)(wid * QBLK) * LDO;
#pragma unroll
  for (int r = 0; r < 16; ++r) { int orow = crow(r, hi);
    for (int d0 = 0; d0 < 4; ++d0) Ow[(long)orow * LDO + d0 * 32 + r32] = (bf16)(::cvtpk(o[d0][r] * rli[r], 0.f) & 0xffffu); }
#undef SLOAD
#undef SWRITE
#undef SWAIT
#undef RESC
}
#undef SBAR
#undef KSWZ
}

DI void phase_mlstm_out(const Params& p, int lane, int wave) {
    const bf16* QKV = (const bf16*)(p.ws + WS_BIG); bf16* OC = (bf16*)(p.ws + WS_OCAT); const float* XC = (const float*)(p.ws + WS_XC);
    const float* gn = p.in[10];
    const int gw = blockIdx.x * 8 + wave, NGW = gridDim.x * 8;
    for (int row = gw; row < MTOT; row += NGW) {
        const float* hp = row < NCTX ? XC + (size_t)row * DM : p.out + (size_t)(row - NCTX) * DM;
        const bf16* oa = QKV + (size_t)row * NIN0 + 1536;
        bf16* dst = OC + (size_t)row * DM;
#pragma unroll
        for (int hd = 0; hd < 4; ++hd) { const int c0 = hd * 128 + lane, c1 = c0 + 64;
            const float v0 = hp[c0] + hp[512 + c0], v1 = hp[c1] + hp[512 + c1];
            const float rs = rsqrtf(wave_sum(v0 * v0 + v1 * v1) * (1.f / 128.f) + EPS);
            const float o0 = bf2f(oa[c0]), o1 = bf2f(oa[c1]);
            dst[c0] = f2bf(v0 * rs * gn[c0] / (1.f + __expf(-o0))); dst[c1] = f2bf(v1 * rs * gn[c1] / (1.f + __expf(-o1))); }
    }
}


#define XB_TMO      128
#define XB_XCNT(j)  (256  + 64 * (j))
#define XB_XSUB(j)  (1280 + 64 * (j))
#define XB_XGEN(j)  (2304 + 64 * (j))
#define XB_TOP      3328
#define XB_TOPGEN   3392
#define XCD_BAR_WORDS 3456
#define XB_SPIN_CAP (1u << 18)
DI unsigned xb_ld(unsigned* p)              { return __hip_atomic_load(p, __ATOMIC_RELAXED, __HIP_MEMORY_SCOPE_AGENT); }
DI unsigned xb_add(unsigned* p, unsigned v) { return __hip_atomic_fetch_add(p, v, __ATOMIC_RELAXED, __HIP_MEMORY_SCOPE_AGENT); }
DI unsigned xb_xcc_id() { return (unsigned)__builtin_amdgcn_s_getreg((3 << 11) | 20) & 0xFu; }
#define XB_SPIN(cond, bar) do { unsigned _sp = 0; while (cond) { __builtin_amdgcn_s_sleep(1); \
    if ((++_sp & 255u) == 0u) { if (xb_ld(&(bar)[XB_TMO])) break; if (_sp > XB_SPIN_CAP) { atomicAdd(&(bar)[XB_TMO], 1u); break; } } } } while (0)
struct XcdBarrier { unsigned* bar; unsigned x; volatile LAS unsigned* st; };
DI XcdBarrier xcd_barrier_post(unsigned* bar, volatile LAS unsigned* st, int tid) {
    XcdBarrier b; b.bar = bar; b.x = xb_xcc_id(); b.st = st;
    if (tid == 0) (void)xb_add(&bar[XB_XCNT(b.x)], 1u);
    return b;
}
DI void xcd_barrier_complete(unsigned* bar, unsigned x, unsigned& nloc, unsigned& nx) {
    const unsigned G = gridDim.x * gridDim.y * gridDim.z;
    unsigned sum, cnt, mine, sp = 0u;
    for (;;) {
        sum = 0u; cnt = 0u; mine = 0u;
#pragma unroll
        for (unsigned j = 0; j < 16; ++j) { const unsigned c = xb_ld(&bar[XB_XCNT(j)]); sum += c; cnt += (c > 0u) ? 1u : 0u; mine = (j == x) ? c : mine; }
        if (sum == G) break;
        __builtin_amdgcn_s_sleep(1);
        if ((++sp & 255u) == 0u) { if (xb_ld(&bar[XB_TMO])) break; if (sp > XB_SPIN_CAP) { atomicAdd(&bar[XB_TMO], 1u); break; } }
    }
    nloc = mine > 0u ? mine : 1u; nx = cnt > 0u ? cnt : 1u;
}
DI void xcd_barrier(const XcdBarrier& b, int tid) {
    asm volatile("s_waitcnt vmcnt(0)" ::: "memory");
    __syncthreads();
    if (tid == 0) {
        unsigned* bar = b.bar;
        __builtin_amdgcn_s_waitcnt(0);
        unsigned nloc = b.st[0], nx = b.st[1];
        if (nloc == 0u) { xcd_barrier_complete(bar, b.x, nloc, nx); b.st[0] = nloc; b.st[1] = nx; }
        const unsigned old = xb_add(&bar[XB_XSUB(b.x)], 1u);
        const unsigned gen = old / nloc;
        if (old + 1u == (gen + 1u) * nloc) {
            __builtin_amdgcn_fence(__ATOMIC_RELEASE, "agent");
            asm volatile("s_waitcnt vmcnt(0)" ::: "memory");
            const unsigned og = xb_add(&bar[XB_TOP], 1u);
            const unsigned tg = og / nx;
            if (og + 1u == (tg + 1u) * nx) xb_add(&bar[XB_TOPGEN], 1u);
            else XB_SPIN(xb_ld(&bar[XB_TOPGEN]) == tg, bar);
            __builtin_amdgcn_fence(__ATOMIC_ACQUIRE, "agent");
            xb_add(&bar[XB_XGEN(b.x)], 1u);
            asm volatile("s_waitcnt vmcnt(0)" ::: "memory");
        } else {
            XB_SPIN(xb_ld(&bar[XB_XGEN(b.x)]) == gen, bar);
            __builtin_amdgcn_fence(__ATOMIC_ACQUIRE, "agent");
            asm volatile("s_waitcnt vmcnt(0)" ::: "memory");
        }
    }
    __syncthreads();
}
DI void sub_barrier(unsigned* cnt, unsigned n, int tid) {
    asm volatile("s_waitcnt vmcnt(0)" ::: "memory");
    __syncthreads();
    if (tid == 0) {
        __builtin_amdgcn_fence(__ATOMIC_RELEASE, "agent");
        asm volatile("s_waitcnt vmcnt(0)" ::: "memory");
        (void)xb_add(cnt, 1u);
        unsigned sp = 0u; while (xb_ld(cnt) < n) { __builtin_amdgcn_s_sleep(1); if (++sp > (1u << 22)) break; }
        __builtin_amdgcn_fence(__ATOMIC_ACQUIRE, "agent");
        asm volatile("s_waitcnt vmcnt(0)" ::: "memory");
    }
    __syncthreads();
}
#ifndef REP_X1
#define REP_X1 1
#endif
#ifndef REP_X2
#define REP_X2 1
#endif
#ifndef REP_X3
#define REP_X3 1
#endif
#ifndef REP_SYNC
#define REP_SYNC 1
#endif
#ifndef REP_ATTNC
#define REP_ATTNC 1
#endif
#ifndef REP_MLSTM
#define REP_MLSTM 1
#endif
#ifndef REP_SWA
#define REP_SWA 1
#endif
#ifndef REP_UP1
#define REP_UP1 1
#endif
#ifndef REP_NORM
#define REP_NORM 1
#endif
#ifndef REP_PROL
#define REP_PROL 1
#endif
#define GSYNC() do { FRESH_IDS(); for (int s_ = 0; s_ < REP_SYNC; ++s_) xcd_barrier(xbar, tid); } while (0)
__global__ void __launch_bounds__(512, 2) fwd_kernel(Params p) {
    extern __shared__ __attribute__((aligned(16))) unsigned char lds_raw[];
    LAS unsigned char* lds = (LAS unsigned char*)lds_raw;
    cg::grid_group grid = cg::this_grid();
#define FRESH_IDS() int tid_ = wave_s * 64 + fresh_lane(); asm volatile("" : "+v"(tid_)); const int tid = tid_, lane = tid & 63, wave = wave_s; (void)tid; (void)lane; (void)wave
#define run_gemm(...) run_gemm_rng_(__VA_ARGS__, (int)gridDim.x, (int)blockIdx.x, 0, 0x7fffffff, tid)
#define run_gemm_gc(...) run_gemm_rng_(__VA_ARGS__, 0, 0x7fffffff, tid)
#define run_gemm_rng(...) run_gemm_rng_(__VA_ARGS__, tid)
    const int wave_s = __builtin_amdgcn_readfirstlane((int)threadIdx.x >> 6);
    unsigned char* ws = p.ws;
    bf16* WIN0 = (bf16*)(ws + WS_WIN0); bf16* WOUT0 = (bf16*)(ws + WS_WOUT0); bf16* WIN1 = (bf16*)(ws + WS_WIN1); bf16* WOUT1 = (bf16*)(ws + WS_WOUT1);
    bf16* W1 = (bf16*)(ws + WS_W1); bf16* W2 = (bf16*)(ws + WS_W2);
    const float* MOD0 = (const float*)(ws + WS_MOD); const float* MOD1 = MOD0 + 9 * NMODC;
    float* XC = (float*)(ws + WS_XC); bf16* VT = (bf16*)(ws + WS_VT); bf16* H = (bf16*)(ws + WS_H); bf16* OC = (bf16*)(ws + WS_OCAT); bf16* BIG = (bf16*)(ws + WS_BIG);
    const float* x = p.in[0]; const float* ctx = p.in[2];

    unsigned* barw = (unsigned*)(ws + WS_BAR);
    volatile LAS unsigned* bst = (volatile LAS unsigned*)(lds + LDS_BYTES - 16);
    { FRESH_IDS();
      if (tid < 2) bst[tid] = 0u;
      if (blockIdx.x == 0) for (int i = tid; i < 4096; i += 512) barw[i] = 0u; }
    for (int rep_ = 0; rep_ < REP_PROL; ++rep_) { FRESH_IDS();
        phase_prologue(p, lds, tid, lane, wave);
    }
    grid.sync();
    XcdBarrier xbar; { FRESH_IDS(); xbar = xcd_barrier_post(barw, bst, tid); }
    float* RSS = (float*)(ws + WS_RSS); const float* BIAS = (const float*)(ws + WS_BIAS);
    for (int rep_ = 0; rep_ < REP_NORM; ++rep_) { FRESH_IDS(); __syncthreads();
        phase_norm<false>(p, lds, ctx, x, p.in[6], MOD0, 0, H, 0, MTOT, tid, lane, wave);
        phase_bias(p, lane, wave);
    }
    GSYNC();
    { FRESH_IDS();
        run_gemm(lds, H, WIN0, MTOT, NIN0, DM, EpiStore<0>{BIG, NIN0});
        phase_gates(p, lds, H, tid, lane, wave, (int)blockIdx.x, (int)gridDim.x);
    }
    GSYNC();
    for (int rep_ = 0; rep_ < REP_MLSTM; ++rep_) {
    { FRESH_IDS();
        if (rep_ == 0) phase_post<64>(BIG, NIN0, 2048, 8, 2560, 2, 2688, p.in[11], p.in[12], VT, true, lds, tid, lane, wave);
        for (int rx_ = 0; rx_ < REP_X1; ++rx_) for (int item = blockIdx.x; item < 32 * NCH; item += gridDim.x) mlstm_x1(p, lds, item, tid, lane, wave);
    }
    GSYNC();
    { FRESH_IDS();
        const int G_ = (int)gridDim.x, nx3 = 32 * NCH, heavy = nx3 % G_, SWA_N = 1024 + 64;
        const int SWA_B = (heavy > 0 && G_ > heavy) ? 2 * (G_ - heavy) : 0, SWA_A = SWA_B < SWA_N ? SWA_N - SWA_B : SWA_N;
        if (((int)blockIdx.x & 1) == 0) for (int rx_ = 0; rx_ < REP_X2; ++rx_) mlstm_x2(p, tid);
        for (int rep_s = 0; rep_s < REP_SWA; ++rep_s)
        for (int item = (int)blockIdx.x; item < SWA_A; item += G_) {
            if (item < 1024) attn_item<64, 1, 2>(BIG, NIN0, 2048, 2560, VT, OC, 512, p.in[13], lds, item, tid, lane, wave);
            else attn_item<64, 2, 2>(BIG, NIN0, 2048, 2560, VT, OC, 512, p.in[13], lds, item - 1024, tid, lane, wave);
        }
        if (((int)blockIdx.x & 1) == 1) for (int rx_ = 0; rx_ < REP_X2; ++rx_) mlstm_x2(p, tid);
    }
    GSYNC();
    { FRESH_IDS();
        for (int rx_ = 0; rx_ < REP_X3; ++rx_) for (int item = blockIdx.x; item < 32 * NCH; item += gridDim.x) mlstm_x3(p, lds, item, tid, lane, wave);
        const int G_ = (int)gridDim.x, nx3 = 32 * NCH, heavy = nx3 % G_, SWA_N = 1024 + 64;
        const int SWA_B = (heavy > 0 && G_ > heavy) ? 2 * (G_ - heavy) : 0, SWA_A = SWA_B < SWA_N ? SWA_N - SWA_B : SWA_N;
        if (SWA_A < SWA_N && (int)blockIdx.x >= heavy)
            for (int item = SWA_A + (int)blockIdx.x - heavy; item < SWA_N; item += G_ - heavy) {
                if (item < 1024) attn_item<64, 1, 2>(BIG, NIN0, 2048, 2560, VT, OC, 512, p.in[13], lds, item, tid, lane, wave);
                else attn_item<64, 2, 2>(BIG, NIN0, 2048, 2560, VT, OC, 512, p.in[13], lds, item - 1024, tid, lane, wave);
            }
    }
    }
    GSYNC();
    { FRESH_IDS();
        run_gemm(lds, OC + (size_t)NCTX * DM, WOUT0, NLAT, DM, DM, EpiResidN{ctx, x, XC, p.out, MOD0, 2, NCTX, p.in[7], MOD0, 3, H, RSS});
    }
    GSYNC();
    { FRESH_IDS();
        const int NG1 = 32, bid = (int)blockIdx.x, G = (int)gridDim.x;
        const EpiStoreN<1> eup{BIG + (size_t)NCTX * DFF, DFF, RSS, BIAS, NCTX};
        if (bid < NG1) {
            run_gemm_gc(lds, OC, WOUT0, NCTX, DM, DM, EpiResidN{ctx, x, XC, p.out, MOD0, 2, 0, p.in[7], MOD0, 3, H, RSS}, NG1, bid);
            sub_barrier(barw + 3584, NG1, tid);
            run_gemm_gc(lds, H, W1, NCTX, DFF, DM, EpiStoreN<1>{BIG, DFF, RSS, BIAS, 0}, NG1, bid);
            run_gemm_rng(lds, H + (size_t)NCTX * DM, W1, NLAT, DFF, DM, eup, NG1, bid, 0, 96);
        } else {
            run_gemm_rng(lds, H + (size_t)NCTX * DM, W1, NLAT, DFF, DM, eup, G - NG1, bid - NG1, 96, 0x7fffffff);
        }
    }
    GSYNC();
    bf16* BIG1 = BIG + (size_t)16 * 1024 * 1024;
    const int GC = 32;
    { FRESH_IDS();
        run_gemm(lds, BIG + (size_t)NCTX * DFF, W2, NLAT, DM, DFF, EpiResidN{XC, p.out, XC, p.out, MOD0, 5, NCTX, p.in[6] + DM, MOD1, 0, H, RSS + MTOT});
    }
    GSYNC();
    { FRESH_IDS();
        if ((int)blockIdx.x < GC) run_gemm_gc(lds, BIG, W2, NCTX, DM, DFF, EpiResidN{XC, p.out, XC, p.out, MOD0, 5, 0, p.in[6] + DM, MOD1, 0, H, RSS + MTOT}, GC, (int)blockIdx.x);
        else run_gemm_gc(lds, H + (size_t)NCTX * DM, WIN1, NLAT, NIN1, DM, EpiStoreN<0>{BIG1 + (size_t)NCTX * NIN1, NIN1, RSS + MTOT, BIAS + 9 * 4096, NCTX}, (int)gridDim.x - GC, (int)blockIdx.x - GC);
    }
    GSYNC();
    { FRESH_IDS();
        if ((int)blockIdx.x < 48) { run_gemm_gc(lds, H, WIN1, NCTX, NIN1, DM, EpiStoreN<0>{BIG1, NIN1, RSS + MTOT, BIAS + 9 * 4096, 0}, 48, (int)blockIdx.x);
            sub_barrier(barw + 3600, 48, tid);
            phase_post1(BIG1, p.in[16], p.in[17], VT, (bf16*)(ws + WS_V1), lane, wave, 0, NCTX, (int)blockIdx.x, 48); }
        else phase_post1(BIG1, p.in[16], p.in[17], VT, (bf16*)(ws + WS_V1), lane, wave, NCTX, MTOT, (int)blockIdx.x - 48, (int)gridDim.x - 48);
    }
    GSYNC();
    for (int rep_ = 0; rep_ < REP_ATTNC; ++rep_) { FRESH_IDS();
        const int G_ = (int)gridDim.x, vcu = (G_ % 8 == 0) ? ((int)blockIdx.x & 7) * (G_ >> 3) + ((int)blockIdx.x >> 3) : (int)blockIdx.x;
        for (int item = vcu; item < 1024; item += G_) {
            const int qb = item & 15, head = (item >> 4) & 7, b = item >> 7, kvh = head >> 2;
            int tl = wave * 64 + fresh_lane(); asm volatile("" : "+v"(tl));
            const size_t qrow = (size_t)NCTX + (size_t)b * SEQ + qb * 256;
            __syncthreads();
            adb::attn_dense_body<adb::bf16>(BIG1 + qrow * NIN1 + head * 128, VT + (size_t)(b * 2 + kvh) * KVLEN * 128, (const bf16*)(ws + WS_V1) + (size_t)(b * 2 + kvh) * KVLEN * 128,
                                            OC + qrow * DM + head * 128, KVLEN, (char*)lds, tl);
        }
    }
    GSYNC();
    { FRESH_IDS();
        run_gemm(lds, OC + (size_t)NCTX * DM, WOUT1, NLAT, DM, DM, EpiResidN{XC, p.out, XC, p.out, MOD1, 2, NCTX, p.in[7] + DM, MOD1, 3, H, RSS + 2 * MTOT});
    }
    GSYNC();
    for (int rep_ = 0; rep_ < REP_UP1; ++rep_) { FRESH_IDS();
        run_gemm(lds, H + (size_t)NCTX * DM, W1 + (size_t)DFF * DM, NLAT, DFF, DM, EpiStoreN<1>{BIG, DFF, RSS + 2 * MTOT, BIAS + 2 * 9 * 4096, NCTX});
    }
    GSYNC();
    { FRESH_IDS();
        run_gemm(lds, BIG, W2 + (size_t)DFF * DM, NLAT, DM, DFF, EpiResid{XC, p.out, XC, p.out, MOD1, 5, NCTX});
    }
}

extern "C" void kernel_launch(void* const* d_in, const int* in_sizes, int n_in, void* d_out, int out_size, void* d_ws, size_t ws_size, hipStream_t stream) {
    static int grid = 0;
    if (grid == 0) {
        if (n_in != 21 || out_size != NLAT * DM || ws_size < WS_END) { fprintf(stderr, "kernel_launch: unexpected shapes (n_in %d out %d ws %zu)\n", n_in, out_size, ws_size); grid = -1; return; }
        int dev = 0, cus = 0, per_cu = 0;
        hipGetDevice(&dev); hipDeviceGetAttribute(&cus, hipDeviceAttributeMultiprocessorCount, dev);
        hipFuncSetAttribute((const void*)fwd_kernel, hipFuncAttributeMaxDynamicSharedMemorySize, LDS_BYTES);
        hipOccupancyMaxActiveBlocksPerMultiprocessor(&per_cu, (const void*)fwd_kernel, 512, LDS_BYTES);
        if (per_cu < 1) { fprintf(stderr, "kernel_launch: occupancy query says %d blocks per CU\n", per_cu); per_cu = 1; }
        grid = cus * per_cu;
    }
    if (grid < 0) return;
    Params p{};
    for (int i = 0; i < 21; ++i) p.in[i] = (const float*)d_in[i];
    p.out = (float*)d_out; p.ws = (unsigned char*)d_ws;
    void* args[] = {&p};
    hipError_t e = hipLaunchCooperativeKernel((const void*)fwd_kernel, dim3(grid), dim3(512), args, LDS_BYTES, stream);
    if (e != hipSuccess) fprintf(stderr, "cooperative launch failed: %s (grid %d)\n", hipGetErrorString(e), grid);
}
```

```cpp
#include <hip/hip_runtime.h>
#include <hip/hip_cooperative_groups.h>
#include <cstdio>
#include <cstdint>
namespace cg = cooperative_groups;
namespace pg8 {
#define PG8_LAS __attribute__((address_space(3)))
typedef unsigned short bf16_t;
typedef short bf16x8 __attribute__((ext_vector_type(8)));
typedef float f32x4 __attribute__((ext_vector_type(4)));
typedef unsigned u32x4 __attribute__((ext_vector_type(4)));
constexpr int BM = 256, BK = 64, HALF = 128, HTB = HALF * BK * 2  , STAGE_BYTES = 8 * HTB, NXCD = 8, WGM = 8;

__host__ __device__ __forceinline__ int lds_byte(int r, int c) { const int st = (r >> 4) * 2 + (c >> 5), rr = r & 15, cc = c & 31, ob = rr * 64 + cc * 2; return st * 1024 + (ob ^ (((ob >> 9) & 1) << 5)); }
__host__ __device__ __forceinline__ void stage_rc(int b, int& R, int& C) { const int st = b / 1024, sb = b % 1024, swz = sb ^ (((sb >> 9) & 1) << 5); R = (st >> 1) * 16 + swz / 64; C = (st & 1) * 32 + (swz % 64) / 2; }
__host__ __device__ __forceinline__ int perm32(int rho) { const int n = rho >> 4, i = rho & 15; return 8 * (i >> 2) + 4 * n + (i & 3); }

struct Unit { int pm, pn; };
struct Gemm { const bf16_t* A; const bf16_t* Bt; int M, N, K; };

struct StaticOrder {
    int nM, nN, nwg, G, c, lo, hi;
    __host__ __device__ void init(int M, int N, int G_, int c_) { nM = M / BM; nN = N / BM; nwg = nM * nN; G = G_; c = c_; lo = 0; hi = nwg; }
    __host__ __device__ void range(int lo_, int hi_) { lo = lo_; hi = hi_ < nwg ? hi_ : nwg; }
    __host__ __device__ bool next(int i, Unit& u) const {
        const long L = (long)lo + (long)i * G + c; if (L >= hi) return false;
        int wgid = (int)L; { const int q = nwg / NXCD, r = nwg % NXCD, xcd = wgid % NXCD, off = wgid / NXCD; wgid = (xcd < r ? xcd * (q + 1) : r * (q + 1) + (xcd - r) * q) + off; }
        const int nig = WGM * nN, gid = wgid / nig, fm = gid * WGM, gsz = (nM - fm) < WGM ? (nM - fm) : WGM;
        u.pm = fm + ((wgid % nig) % gsz); u.pn = (wgid % nig) / gsz; return true;
    }
    __device__ __forceinline__ void a_ready(const Unit&) const {}
    __device__ __forceinline__ void done(const Unit&) const {}
};
}
namespace pg8 {

template <class Epi, class Sched, bool ALIGN_EPI = false, bool SP2 = false>
__device__ __forceinline__ void gemm_phase(PG8_LAS unsigned char* lds, const Gemm g, const Sched& S, const Epi& E, const int tid_in) {
    int tid_ = tid_in; asm volatile("" : "+v"(tid_)); const int tid = tid_, wid = __builtin_amdgcn_readfirstlane(tid >> 6), lane = tid & 63, wr = wid >> 2, wc = wid & 3, fr = lane & 15, fq = lane >> 4;
    const int K = g.K, nt = K / BK;
    unsigned voffA[2], voffB[2];
#pragma unroll
    for (int i = 0; i < 2; ++i) { int R, C; stage_rc(tid * 16 + i * 8192, R, C); const int Rb = Epi::PERM ? ((R & ~31) + perm32(R & 31)) : R;
        voffA[i] = (unsigned)(R * K + C) * 2u; voffB[i] = (unsigned)(Rb * K + C) * 2u; }
    const size_t kstep = (size_t)(BK * 2);
    const size_t hstep = (size_t)HALF * K * 2;
    const size_t tstep = 2 * hstep;
    const unsigned ldsw = (unsigned)wid * 1024u;
    const int aoff = lds_byte(wr * 64 + fr, fq * 8), boff = lds_byte(wc * 32 + fr, fq * 8);
#define PG8_SA(b, h) (((b) * 2 + (h)) * HTB)
#define PG8_SB(b, h) ((4 + (b) * 2 + (h)) * HTB)
#define PG8_STAGE(bufoff, gbase, voff) do { _Pragma("unroll") for (int _i = 0; _i < 2; ++_i) \
        __builtin_amdgcn_global_load_lds((const unsigned*)((const char*)(gbase) + (voff)[_i]), (PG8_LAS unsigned*)(lds + (bufoff) + ldsw + _i * 8192), 16, 0, 0); } while (0)
#define PG8_LDA(dst, b, h) do { _Pragma("unroll") for (int m = 0; m < 4; ++m) _Pragma("unroll") for (int k = 0; k < 2; ++k) dst[m][k] = *(const PG8_LAS bf16x8*)(lds + PG8_SA(b, h) + aoff + m * 2048 + k * 1024); } while (0)
#define PG8_LDB(dst, b, h) do { _Pragma("unroll") for (int n = 0; n < 2; ++n) _Pragma("unroll") for (int k = 0; k < 2; ++k) dst[n][k] = *(const PG8_LAS bf16x8*)(lds + PG8_SB(b, h) + boff + n * 2048 + k * 1024); } while (0)
#define PG8_MMA(ai, bj, At, Bt) do { __builtin_amdgcn_s_setprio(1); _Pragma("unroll") for (int m = 0; m < 4; ++m) _Pragma("unroll") for (int n = 0; n < 2; ++n) _Pragma("unroll") for (int k = 0; k < 2; ++k) \
        acc[ai][bj][m][n] = __builtin_amdgcn_mfma_f32_16x16x32_bf16(Bt[n][k], At[m][k], acc[ai][bj][m][n], 0, 0, 0); __builtin_amdgcn_s_setprio(0); } while (0)
#define PG8_WAIT_V(n) asm volatile("s_waitcnt vmcnt(" #n ")" ::: "memory")
#define PG8_WAIT_L(n) asm volatile("s_waitcnt lgkmcnt(" #n ")" ::: "memory")
#define PG8_BAR __builtin_amdgcn_s_barrier()
#define PG8_SCHED __builtin_amdgcn_sched_barrier(0)
    Unit cur, nxt; int ui = 0;
    if (!S.next(0, cur)) return;
    f32x4 acc[2][2][4][2];
#pragma unroll
    for (int a = 0; a < 2; ++a)
#pragma unroll
        for (int b = 0; b < 2; ++b)
#pragma unroll
            for (int m = 0; m < 4; ++m)
#pragma unroll
                for (int n = 0; n < 2; ++n) acc[a][b][m][n] = (f32x4){0.f, 0.f, 0.f, 0.f};
    bf16x8 At[4][2], B0[2][2], B1[2][2];
    const char* cA = (const char*)g.A + (size_t)cur.pm * tstep; const char* cB = (const char*)g.Bt + (size_t)cur.pn * tstep;
    S.a_ready(cur);
    if constexpr (SP2) {
        PG8_STAGE(PG8_SB(0, 0), cB, voffB); PG8_STAGE(PG8_SB(0, 1), cB + hstep, voffB); PG8_STAGE(PG8_SA(0, 0), cA, voffA); PG8_STAGE(PG8_SA(0, 1), cA + hstep, voffA);
        if (wr == 1) PG8_BAR;
        PG8_WAIT_V(2); PG8_BAR;
        PG8_STAGE(PG8_SB(1, 0), cB + kstep, voffB); PG8_STAGE(PG8_SA(1, 0), cA + kstep, voffA); PG8_STAGE(PG8_SB(1, 1), cB + hstep + kstep, voffB);
        PG8_WAIT_V(6); PG8_BAR;
    } else {
        PG8_STAGE(PG8_SB(0, 0), cB, voffB); PG8_STAGE(PG8_SA(0, 0), cA, voffA); PG8_STAGE(PG8_SB(0, 1), cB + hstep, voffB); PG8_STAGE(PG8_SA(0, 1), cA + hstep, voffA);
        if (wr == 1) PG8_BAR;
        PG8_WAIT_V(4); PG8_BAR;
        PG8_STAGE(PG8_SB(1, 0), cB + kstep, voffB); PG8_STAGE(PG8_SA(1, 0), cA + kstep, voffA); PG8_STAGE(PG8_SB(1, 1), cB + hstep + kstep, voffB);
        PG8_WAIT_V(6); PG8_BAR;
    }
    for (;;) {
        const bool has_next = S.next(ui + 1, nxt);
        const char* nA = has_next ? (const char*)g.A + (size_t)nxt.pm * tstep : cA; const char* nB = has_next ? (const char*)g.Bt + (size_t)nxt.pn * tstep : cB;
        for (int t = 0; t < nt; t += 2) {
            const bool last = (t == nt - 2);
            const char* a1 = cA + (size_t)(t + 1) * kstep;
            const char* a2 = last ? nA : cA + (size_t)(t + 2) * kstep; const char* b2 = last ? nB : cB + (size_t)(t + 2) * kstep;
            const char* a3 = a2 + kstep; const char* b3 = b2 + kstep;
            if (last && has_next) S.a_ready(nxt);
            if constexpr (SP2) {
            PG8_LDB(B0, 0, 0); PG8_LDB(B1, 0, 1); PG8_SCHED; PG8_LDA(At, 0, 0); PG8_STAGE(PG8_SA(1, 1), a1 + hstep, voffA);
            PG8_WAIT_V(8); PG8_WAIT_L(0); PG8_BAR; PG8_MMA(0, 0, At, B0); PG8_MMA(0, 1, At, B1); PG8_BAR; PG8_SCHED;
            PG8_LDA(At, 0, 1); PG8_STAGE(PG8_SB(0, 0), b2, voffB); PG8_STAGE(PG8_SB(0, 1), b2 + hstep, voffB); PG8_STAGE(PG8_SA(0, 0), a2, voffA);
            PG8_WAIT_V(8); PG8_WAIT_L(0); PG8_BAR; PG8_MMA(1, 0, At, B0); PG8_MMA(1, 1, At, B1); PG8_BAR; PG8_SCHED;
            PG8_LDB(B0, 1, 0); PG8_LDB(B1, 1, 1); PG8_SCHED; PG8_LDA(At, 1, 0); PG8_STAGE(PG8_SA(0, 1), a2 + hstep, voffA);
            PG8_WAIT_V(8); PG8_WAIT_L(0); PG8_BAR; PG8_MMA(0, 0, At, B0); PG8_MMA(0, 1, At, B1); PG8_BAR; PG8_SCHED;
            PG8_LDA(At, 1, 1); PG8_STAGE(PG8_SB(1, 0), b3, voffB); PG8_STAGE(PG8_SB(1, 1), b3 + hstep, voffB); PG8_STAGE(PG8_SA(1, 0), a3, voffA);
            PG8_WAIT_V(8); PG8_WAIT_L(0); PG8_BAR; PG8_MMA(1, 0, At, B0); PG8_MMA(1, 1, At, B1); PG8_BAR; PG8_SCHED;
            } else {
            PG8_LDB(B0, 0, 0); PG8_SCHED; PG8_LDA(At, 0, 0); PG8_STAGE(PG8_SA(1, 1), a1 + hstep, voffA);
            PG8_WAIT_L(8); PG8_BAR; PG8_WAIT_L(0); PG8_MMA(0, 0, At, B0); PG8_BAR; PG8_SCHED;
            PG8_LDB(B1, 0, 1); PG8_STAGE(PG8_SB(0, 0), b2, voffB);
            PG8_BAR; PG8_WAIT_L(0); PG8_MMA(0, 1, At, B1); PG8_BAR;
            PG8_LDA(At, 0, 1); PG8_STAGE(PG8_SA(0, 0), a2, voffA);
            PG8_BAR; PG8_WAIT_L(0); PG8_MMA(1, 0, At, B0); PG8_BAR; PG8_SCHED;
            PG8_STAGE(PG8_SB(0, 1), b2 + hstep, voffB);
            PG8_WAIT_V(6); PG8_BAR; PG8_MMA(1, 1, At, B1); PG8_BAR;
            PG8_LDB(B0, 1, 0); PG8_SCHED; PG8_LDA(At, 1, 0); PG8_STAGE(PG8_SA(0, 1), a2 + hstep, voffA);
            PG8_WAIT_L(8); PG8_BAR; PG8_WAIT_L(0); PG8_MMA(0, 0, At, B0); PG8_BAR; PG8_SCHED;
            PG8_LDB(B1, 1, 1); PG8_STAGE(PG8_SB(1, 0), b3, voffB);
            PG8_BAR; PG8_WAIT_L(0); PG8_MMA(0, 1, At, B1); PG8_BAR;
            PG8_LDA(At, 1, 1); PG8_STAGE(PG8_SA(1, 0), a3, voffA);
            PG8_BAR; PG8_WAIT_L(0); PG8_MMA(1, 0, At, B0); PG8_BAR; PG8_SCHED;
            PG8_STAGE(PG8_SB(1, 1), b3 + hstep, voffB);
            PG8_WAIT_V(6); PG8_BAR; PG8_MMA(1, 1, At, B1); PG8_BAR;
            }
        }
        if constexpr (ALIGN_EPI) { if (wr == 0) PG8_BAR; }
        if constexpr (!Epi::AFTER_DRAIN) { E(acc, cur, wr, wc, fr, fq); S.done(cur); }
        if (!has_next) break;
#pragma unroll
        for (int a = 0; a < 2; ++a)
#pragma unroll
            for (int b = 0; b < 2; ++b)
#pragma unroll
                for (int m = 0; m < 4; ++m)
#pragma unroll
                    for (int n = 0; n < 2; ++n) acc[a][b][m][n] = (f32x4){0.f, 0.f, 0.f, 0.f};
        cur = nxt; cA = nA; cB = nB; ++ui;
        if constexpr (ALIGN_EPI) { if (wr == 1) PG8_BAR; }
    }
    PG8_WAIT_V(0);
    if constexpr (!ALIGN_EPI) { if (wr == 0) PG8_BAR; }
    PG8_BAR;
    if constexpr (Epi::AFTER_DRAIN) { E.fused(acc, cur, wr, wc, fr, fq, lds, wid, lane); S.done(cur); }
#undef PG8_SA
#undef PG8_SB
#undef PG8_STAGE
#undef PG8_LDA
#undef PG8_LDB
#undef PG8_MMA
#undef PG8_WAIT_V
#undef PG8_WAIT_L
#undef PG8_BAR
#undef PG8_SCHED
}
}

#define DI __device__ __forceinline__
#define LAS __attribute__((address_space(3)))
typedef unsigned short bf16;
typedef short bf16x8 __attribute__((ext_vector_type(8)));
typedef short s16x4 __attribute__((ext_vector_type(4)));
typedef float f32x2 __attribute__((ext_vector_type(2)));
typedef float f32x4 __attribute__((ext_vector_type(4)));
typedef float f32x16 __attribute__((ext_vector_type(16)));
typedef unsigned u32x2 __attribute__((ext_vector_type(2)));
typedef unsigned u32x4 __attribute__((ext_vector_type(4)));
typedef __bf16 bf16x2_t __attribute__((ext_vector_type(2)));
#define LDS_WAIT() asm volatile("s_waitcnt lgkmcnt(0)" ::: "memory")
#define MFMA32(a, b, c) __builtin_amdgcn_mfma_f32_32x32x16_bf16((a), (b), (c), 0, 0, 0)

constexpr int DM = 1024, NBATCH = 8, SEQ = 4096, CTXL = 256, NCTX = NBATCH * CTXL, NLAT = NBATCH * SEQ, MTOT = NCTX + NLAT;
constexpr int NIN0 = 2816, NIN1 = 1536, DFF = 4096, KVLEN = CTXL + SEQ, AB_IN_W = 2832, NMODC = 6144;
constexpr float EPS = 1e-6f, LOG2E = 1.4426950408889634f;
constexpr size_t MiB = 1u << 20;
constexpr size_t WS_WIN0 = 0, WS_WOUT0 = 6 * MiB, WS_WIN1 = 8 * MiB, WS_WOUT1 = 11 * MiB, WS_W1 = 13 * MiB, WS_W2 = 29 * MiB, WS_MOD = 45 * MiB,
                 WS_GATES = 46 * MiB, WS_XC = 49 * MiB, WS_VT = 57 * MiB, WS_H = 74 * MiB, WS_OCAT = 142 * MiB, WS_BIG = 210 * MiB, WS_BAR = 482 * MiB, WS_RSS = 483 * MiB, WS_BIAS = 484 * MiB, WS_V1 = 485 * MiB, WS_END = 502 * MiB;
constexpr size_t WS_WG = 45 * MiB + 512 * 1024;
constexpr int LDS_BYTES = 147456;

struct Params { const float* in[21]; float* out; unsigned char* ws; };

DI unsigned cvtpk(float lo, float hi) { f32x2 v = {lo, hi}; bf16x2_t b = __builtin_convertvector(v, bf16x2_t); return __builtin_bit_cast(unsigned, b); }
DI bf16 f2bf(float x) { return (bf16)(cvtpk(x, 0.f) & 0xffffu); }
DI float bf2f(bf16 b) { return __uint_as_float(((unsigned)b) << 16); }
DI float wave_sum(float v) {
#pragma unroll
    for (int o = 1; o < 64; o <<= 1) v += __shfl_xor(v, o);
    return v;
}
DI int fresh_lane() { int l; asm volatile("v_mbcnt_lo_u32_b32 %0, -1, 0\n\tv_mbcnt_hi_u32_b32 %0, -1, %0" : "=v"(l)); return l; }
DI int crow(int i, int h) { return (i & 3) + 8 * (i >> 2) + 4 * h; }
DI f32x16 zero16() { f32x16 z; for (int i = 0; i < 16; ++i) z[i] = 0.f; return z; }

DI void mma32(f32x16& acc, const LAS bf16* A, int lda, const LAS bf16* B, int ldb, int K, int lane) {
    const int r = lane & 31, h = lane >> 5;
    const LAS bf16* ap = A + r * lda + 8 * h; const LAS bf16* bp = B + r * ldb + 8 * h;
#pragma unroll 1
    for (int k0 = 0; k0 < K; k0 += 16) {
        const bf16x8 a = *(const LAS bf16x8*)(ap + k0); const bf16x8 b = *(const LAS bf16x8*)(bp + k0);
        acc = MFMA32(a, b, acc);
    }
}

template <int ACT> struct EpiStore {
    static constexpr bool PERM = true, AFTER_DRAIN = false;
    bf16* O; int ldc;
    DI void operator()(const f32x4 (&acc)[2][2][4][2], const pg8::Unit& u, int wr, int wc, int fr, int fq) const {
        const int row0 = u.pm * 256 + wr * 64 + fr, col0 = u.pn * 256 + wc * 32 + 8 * fq;
#pragma unroll
        for (int ai = 0; ai < 2; ++ai)
#pragma unroll
            for (int m = 0; m < 4; ++m) { bf16* rowp = O + (size_t)(row0 + ai * 128 + m * 16) * ldc + col0;
#pragma unroll
                for (int bj = 0; bj < 2; ++bj) { f32x4 v0 = acc[ai][bj][m][0], v1 = acc[ai][bj][m][1];
                    if (ACT == 1) {
#pragma unroll
                        for (int e = 0; e < 4; ++e) { float a = fmaxf(v0[e], 0.f), b = fmaxf(v1[e], 0.f); v0[e] = a * a; v1[e] = b * b; } }
                    u32x4 w; w.x = cvtpk(v0[0], v0[1]); w.y = cvtpk(v0[2], v0[3]); w.z = cvtpk(v1[0], v1[1]); w.w = cvtpk(v1[2], v1[3]);
                    *(u32x4*)(rowp + bj * 128) = w; } }
    }
};
struct EpiResid {
    static constexpr bool PERM = true, AFTER_DRAIN = false;
    const float* srcC; const float* srcL; float* dstC; float* dstL; const float* mod; int gi; int row_base;
    DI void operator()(const f32x4 (&acc)[2][2][4][2], const pg8::Unit& u, int wr, int wc, int fr, int fq) const {
        const int grow0 = row_base + u.pm * 256;
        const float* s; float* d; int mrow;
        if (grow0 < NCTX) { s = srcC + (size_t)grow0 * DM; d = dstC + (size_t)grow0 * DM; mrow = 8; }
        else { const int lr = grow0 - NCTX; s = srcL + (size_t)lr * DM; d = dstL + (size_t)lr * DM; mrow = lr >> 12; }
        const float* gp = mod + mrow * NMODC + gi * DM;
#pragma unroll
        for (int bj = 0; bj < 2; ++bj) { const int col = u.pn * 256 + bj * 128 + wc * 32 + 8 * fq;
            const f32x4 g0 = *(const f32x4*)(gp + col), g1 = *(const f32x4*)(gp + col + 4);
#pragma unroll
            for (int ai = 0; ai < 2; ++ai) {
            f32x4 rr0[4], rr1[4];
#pragma unroll
                for (int m = 0; m < 4; ++m) { const int ro = (ai * 128 + wr * 64 + m * 16 + fr) * DM + col; rr0[m] = *(const f32x4*)(s + ro); rr1[m] = *(const f32x4*)(s + ro + 4); }
            asm volatile("" ::: "memory");
#pragma unroll
                for (int m = 0; m < 4; ++m) { const int ro = (ai * 128 + wr * 64 + m * 16 + fr) * DM + col;
                    *(f32x4*)(d + ro) = rr0[m] + g0 * acc[ai][bj][m][0]; *(f32x4*)(d + ro + 4) = rr1[m] + g1 * acc[ai][bj][m][1]; } } }
    }
};
struct EpiResidN {
    static constexpr bool PERM = true, AFTER_DRAIN = false;
    const float* srcC; const float* srcL; float* dstC; float* dstL; const float* mod; int gi; int row_base;
    const float* gnext; const float* modn; int sin; bf16* Hn; float* rss;
    DI void operator()(const f32x4 (&acc)[2][2][4][2], const pg8::Unit& u, int wr, int wc, int fr, int fq) const {
        const int grow0 = row_base + u.pm * 256;
        const float* s; float* d; int mrow;
        if (grow0 < NCTX) { s = srcC + (size_t)grow0 * DM; d = dstC + (size_t)grow0 * DM; mrow = 8; }
        else { const int lr = grow0 - NCTX; s = srcL + (size_t)lr * DM; d = dstL + (size_t)lr * DM; mrow = lr >> 12; }
        const float* gp = mod + mrow * NMODC + gi * DM; const float* scp = modn + mrow * NMODC + (sin + 1) * DM;
        bf16* hb = Hn + (size_t)grow0 * DM;
        float ssq[2][4];
#pragma unroll
        for (int ai = 0; ai < 2; ++ai)
#pragma unroll
            for (int m = 0; m < 4; ++m) ssq[ai][m] = 0.f;
#pragma unroll
        for (int bj = 0; bj < 2; ++bj) { const int col = u.pn * 256 + bj * 128 + wc * 32 + 8 * fq;
            const f32x4 g0 = *(const f32x4*)(gp + col), g1 = *(const f32x4*)(gp + col + 4);
            const f32x4 w0 = *(const f32x4*)(gnext + col) * (*(const f32x4*)(scp + col) + 1.f), w1 = *(const f32x4*)(gnext + col + 4) * (*(const f32x4*)(scp + col + 4) + 1.f);
#pragma unroll
            for (int ai = 0; ai < 2; ++ai) {
            f32x4 rr0[4], rr1[4];
#pragma unroll
                for (int m = 0; m < 4; ++m) { const int ro = (ai * 128 + wr * 64 + m * 16 + fr) * DM + col; rr0[m] = *(const f32x4*)(s + ro); rr1[m] = *(const f32x4*)(s + ro + 4); }
            asm volatile("" ::: "memory");
#pragma unroll
                for (int m = 0; m < 4; ++m) { const int ro = (ai * 128 + wr * 64 + m * 16 + fr) * DM + col;
                    const f32x4 r0 = rr0[m], r1 = rr1[m];
                    const f32x4 x0 = r0 + g0 * acc[ai][bj][m][0], x1 = r1 + g1 * acc[ai][bj][m][1];
                    *(f32x4*)(d + ro) = x0; *(f32x4*)(d + ro + 4) = x1;
                    ssq[ai][m] += (x0[0] * x0[0] + x0[1] * x0[1]) + (x0[2] * x0[2] + x0[3] * x0[3]) + (x1[0] * x1[0] + x1[1] * x1[1]) + (x1[2] * x1[2] + x1[3] * x1[3]);
                    const f32x4 h0 = x0 * w0, h1 = x1 * w1;
                    u32x4 w; w.x = cvtpk(h0[0], h0[1]); w.y = cvtpk(h0[2], h0[3]); w.z = cvtpk(h1[0], h1[1]); w.w = cvtpk(h1[2], h1[3]);
                    *(u32x4*)(hb + ro) = w; } } }
#pragma unroll
        for (int ai = 0; ai < 2; ++ai)
#pragma unroll
            for (int m = 0; m < 4; ++m) { float q = ssq[ai][m]; q += __shfl_xor(q, 16); q += __shfl_xor(q, 32);
                if (fq == 0) atomicAdd(rss + grow0 + ai * 128 + wr * 64 + m * 16 + fr, q); }
    }
};
template <int ACT> struct EpiStoreN {
    static constexpr bool PERM = true, AFTER_DRAIN = false;
    bf16* O; int ldc; const float* rss; const float* bias; int row_base;
    DI void operator()(const f32x4 (&acc)[2][2][4][2], const pg8::Unit& u, int wr, int wc, int fr, int fq) const {
        const int lrow0 = u.pm * 256 + wr * 64 + fr, grow0 = row_base + u.pm * 256, col0 = u.pn * 256 + wc * 32 + 8 * fq;
        bf16* Ou = O + (size_t)(u.pm * 256) * ldc + u.pn * 256;
        const int mrow = grow0 < NCTX ? 8 : (grow0 - NCTX) >> 12;
        float rstd[2][4];
#pragma unroll
        for (int ai = 0; ai < 2; ++ai)
#pragma unroll
            for (int m = 0; m < 4; ++m) rstd[ai][m] = rsqrtf(rss[row_base + lrow0 + ai * 128 + m * 16] * (1.f / DM) + EPS);
        const float* bp = bias + mrow * 4096 + col0;
        f32x4 bb[2][2];
#pragma unroll
        for (int bj = 0; bj < 2; ++bj) { bb[bj][0] = *(const f32x4*)(bp + bj * 128); bb[bj][1] = *(const f32x4*)(bp + bj * 128 + 4); }
        asm volatile("" ::: "memory");
#pragma unroll
        for (int bj = 0; bj < 2; ++bj) { const f32x4 b0 = bb[bj][0], b1 = bb[bj][1];
#pragma unroll
            for (int ai = 0; ai < 2; ++ai)
#pragma unroll
                for (int m = 0; m < 4; ++m) {
                    f32x4 v0 = acc[ai][bj][m][0] * rstd[ai][m] + b0, v1 = acc[ai][bj][m][1] * rstd[ai][m] + b1;
                    if (ACT == 1) {
#pragma unroll
                        for (int e = 0; e < 4; ++e) { float a = fmaxf(v0[e], 0.f), b = fmaxf(v1[e], 0.f); v0[e] = a * a; v1[e] = b * b; } }
                    u32x4 w; w.x = cvtpk(v0[0], v0[1]); w.y = cvtpk(v0[2], v0[3]); w.z = cvtpk(v1[0], v1[1]); w.w = cvtpk(v1[2], v1[3]);
                    *(u32x4*)(Ou + (wr * 64 + fr + ai * 128 + m * 16) * ldc + wc * 32 + 8 * fq + bj * 128) = w; } }
    }
};
template <class Epi> DI void run_gemm_rng_(LAS unsigned char* lds, const bf16* A, const bf16* Bt, int M, int N, int K, const Epi& E, int G, int c, int lo, int hi, int tid) {
    pg8::Gemm g{A, Bt, M, N, K}; pg8::StaticOrder S; S.init(M, N, G, c); S.range(lo, hi);
    pg8::gemm_phase<Epi, pg8::StaticOrder, true, true>(lds, g, S, E, tid);
}

DI void transpose_item(const float* __restrict__ W, int ldw, int K, bf16* WT, int nblk, LAS float* scr, int item, int lane) {
    const int kb = item / nblk, nb = item - kb * nblk, k0 = 64 * kb, n0 = 32 * nb;
    float wv[32];
#pragma unroll
    for (int i = 0; i < 32; ++i) wv[i] = W[(size_t)(k0 + 2 * i + (lane >> 5)) * ldw + n0 + (lane & 31)];
#pragma unroll
    for (int i = 0; i < 32; ++i) scr[(2 * i + (lane >> 5)) * 33 + (lane & 31)] = wv[i];
    LDS_WAIT();
    const int c = lane & 7;
#pragma unroll
    for (int j = 0; j < 4; ++j) { const int n = (lane >> 3) + 8 * j; const LAS float* s = scr + (8 * c) * 33 + n;
        u32x4 o; o.x = cvtpk(s[0], s[33]); o.y = cvtpk(s[66], s[99]); o.z = cvtpk(s[132], s[165]); o.w = cvtpk(s[198], s[231]);
        *(u32x4*)(WT + (size_t)(n0 + n) * K + k0 + 8 * c) = o; }
    LDS_WAIT();
}
constexpr int TR_I0 = 16 * 64, TR_I1 = 16 * 24, TR_I2 = 16 * 32, TR_I3 = 16 * 48, TR_I4 = 16 * 32, TR_I5 = 16 * 128, TR_I6 = 64 * 32;
constexpr int TR_EARLY = TR_I0 + TR_I1 + TR_I2 + TR_I3 + TR_I5 + TR_I6, TR_ALL = TR_EARLY + TR_I4 + TR_I5 + TR_I6;
DI void transpose_any(const Params& p, LAS float* scr, int it, int lane) {
    unsigned char* ws = p.ws; int r = it;
    if (r < TR_I0) { transpose_item(p.in[8], AB_IN_W, 1024, (bf16*)(ws + WS_WIN0), 64, scr, r, lane); return; } r -= TR_I0;
    if (r < TR_I1) { transpose_item(p.in[8] + 2064, AB_IN_W, 1024, (bf16*)(ws + WS_WIN0) + (size_t)2048 * 1024, 24, scr, r, lane); return; } r -= TR_I1;
    if (r < TR_I2) { transpose_item(p.in[14], 1024, 1024, (bf16*)(ws + WS_WOUT0), 32, scr, r, lane); return; } r -= TR_I2;
    if (r < TR_I3) { transpose_item(p.in[15], NIN1, 1024, (bf16*)(ws + WS_WIN1), 48, scr, r, lane); return; } r -= TR_I3;
    if (r < TR_I5) { transpose_item(p.in[19], DFF, 1024, (bf16*)(ws + WS_W1), 128, scr, r, lane); return; } r -= TR_I5;
    if (r < TR_I6) { transpose_item(p.in[20], 1024, DFF, (bf16*)(ws + WS_W2), 32, scr, r, lane); return; } r -= TR_I6;
    if (r < TR_I4) { transpose_item(p.in[18], 1024, 1024, (bf16*)(ws + WS_WOUT1), 32, scr, r, lane); return; } r -= TR_I4;
    if (r < TR_I5) { transpose_item(p.in[19] + (size_t)1024 * DFF, DFF, 1024, (bf16*)(ws + WS_W1) + (size_t)DFF * 1024, 128, scr, r, lane); return; } r -= TR_I5;
    transpose_item(p.in[20] + (size_t)DFF * 1024, 1024, DFF, (bf16*)(ws + WS_W2) + (size_t)DFF * 1024, 32, scr, r, lane);
}
DI void phase_prologue(const Params& p, LAS unsigned char* lds, int tid, int lane, int wave) {
    unsigned char* ws = p.ws;
    float* MOD = (float*)(ws + WS_MOD);
    for (int item = blockIdx.x; item < 192; item += gridDim.x) {
        const int l = item / 96, cgp = item - l * 96;
        LAS float* sl = (LAS float*)lds; LAS float* part = sl + 9 * 1024;
        for (int i = tid; i < 9 * 1024; i += 512) { const int r = i >> 10, k = i & 1023; const float cv = r < 8 ? p.in[1][r * 1024 + k] : p.in[3][k]; sl[i] = cv / (1.f + __expf(-cv)); }
        __syncthreads();
        const float* aw = p.in[4] + (size_t)l * 1024 * NMODC + cgp * 64 + lane;
        float acc[9];
#pragma unroll
        for (int r = 0; r < 9; ++r) acc[r] = 0.f;
        const int kbase = wave * 128;
#pragma unroll 32
        for (int k = 0; k < 128; ++k) { const float w = aw[(size_t)(kbase + k) * NMODC];
#pragma unroll
            for (int r = 0; r < 9; ++r) acc[r] += sl[r * 1024 + kbase + k] * w; }
#pragma unroll
        for (int r = 0; r < 9; ++r) part[(wave * 9 + r) * 64 + lane] = acc[r];
        __syncthreads();
        for (int i = tid; i < 576; i += 512) { const int r = i >> 6, cl = i & 63; float s = p.in[5][l * NMODC + cgp * 64 + cl];
#pragma unroll
            for (int kg = 0; kg < 8; ++kg) s += part[(kg * 9 + r) * 64 + cl];
            MOD[(l * 9 + r) * NMODC + cgp * 64 + cl] = s; }
        __syncthreads();
    }
    { float* rss = (float*)(ws + WS_RSS); for (int i = blockIdx.x * 512 + tid; i < 3 * MTOT; i += gridDim.x * 512) rss[i] = 0.f; }
    { bf16* WG = (bf16*)(ws + WS_WG);
      for (int idx = blockIdx.x * 512 + tid; idx < 16 * 1024; idx += gridDim.x * 512) { const int g = idx & 15, k = idx >> 4;
          const float w = p.in[8][(size_t)k * AB_IN_W + 2048 + g]; const bf16 hi = f2bf(w); const bf16 lo = f2bf(w - bf2f(hi));
          WG[g * 1024 + k] = hi; WG[16 * 1024 + g * 1024 + k] = lo; } }
    LAS float* scr = (LAS float*)(lds + wave * 16384);
    const int gw = blockIdx.x * 8 + wave, NGW = gridDim.x * 8;
    for (int it = gw; it < TR_EARLY; it += NGW) transpose_any(p, scr, it, lane);
}

DI float log_sigmoid(float x) { return -(fmaxf(-x, 0.f) + log1pf(__expf(-fabsf(x)))); }
template <bool GATES>
DI void phase_norm(const Params& p, LAS unsigned char* lds, const float* srcC, const float* srcL, const float* gn, const float* modL, int si, bf16* H,
                   int row_lo, int row_hi, int tid, int lane, int wave) {
    const int gw = blockIdx.x * 8 + wave, NGW = gridDim.x * 8;
    for (int row = row_lo + gw; row < row_hi; row += 2 * NGW) {
        const int rowB = row + NGW; const bool hasB = rowB < row_hi;
        const float* xa; const float* xb; int ma, mb;
        if (row < NCTX) { xa = srcC + (size_t)row * DM; ma = 8; } else { xa = srcL + (size_t)(row - NCTX) * DM; ma = (row - NCTX) >> 12; }
        const int rb = hasB ? rowB : row;
        if (rb < NCTX) { xb = srcC + (size_t)rb * DM; mb = 8; } else { xb = srcL + (size_t)(rb - NCTX) * DM; mb = (rb - NCTX) >> 12; }
        f32x4 va[4], vb[4]; float sa = 0.f, sb = 0.f;
#pragma unroll
        for (int j = 0; j < 4; ++j) { va[j] = ((const f32x4*)xa)[lane + 64 * j]; vb[j] = ((const f32x4*)xb)[lane + 64 * j]; }
        const float* sha = modL + ma * NMODC + si * DM; const float* shb = modL + mb * NMODC + si * DM;
        f32x4 gg[4], sca[4], tca[4], scb[4], tcb[4];
#pragma unroll
        for (int j = 0; j < 4; ++j) { gg[j] = ((const f32x4*)gn)[lane + 64 * j]; sca[j] = ((const f32x4*)(sha + DM))[lane + 64 * j]; tca[j] = ((const f32x4*)sha)[lane + 64 * j];
            scb[j] = ((const f32x4*)(shb + DM))[lane + 64 * j]; tcb[j] = ((const f32x4*)shb)[lane + 64 * j]; }
        asm volatile("" ::: "memory");
#pragma unroll
        for (int j = 0; j < 4; ++j) { sa += (va[j].x * va[j].x + va[j].y * va[j].y) + (va[j].z * va[j].z + va[j].w * va[j].w);
                                      sb += (vb[j].x * vb[j].x + vb[j].y * vb[j].y) + (vb[j].z * vb[j].z + vb[j].w * vb[j].w); }
#pragma unroll
        for (int o = 1; o < 64; o <<= 1) { sa += __shfl_xor(sa, o); sb += __shfl_xor(sb, o); }
        const float ra = rsqrtf(sa * (1.f / DM) + EPS), rbs = rsqrtf(sb * (1.f / DM) + EPS);
        bf16* ha = H + (size_t)row * DM; bf16* hb = H + (size_t)rb * DM;
#pragma unroll
        for (int j = 0; j < 4; ++j) {
            { const f32x4 v = va[j] * ra * gg[j] * (sca[j] + 1.f) + tca[j]; u32x2 o; o.x = cvtpk(v.x, v.y); o.y = cvtpk(v.z, v.w); ((u32x2*)ha)[lane + 64 * j] = o; }
            if (hasB) { const f32x4 v = vb[j] * rbs * gg[j] * (scb[j] + 1.f) + tcb[j]; u32x2 o; o.x = cvtpk(v.x, v.y); o.y = cvtpk(v.z, v.w); ((u32x2*)hb)[lane + 64 * j] = o; }
        }
    }
}

DI void phase_gates(const Params& p, LAS unsigned char* lds, const bf16* H, int tid, int lane, int wave, int bidx, int nblk) {
    constexpr int GP = 1032;
    LAS bf16* Ws = (LAS bf16*)lds;
    const bf16* WG = (const bf16*)(p.ws + WS_WG);
    __syncthreads();
    for (int i = tid; i < 32 * 128; i += 512) { const int rw = i >> 7, c = i & 127; *(LAS u32x4*)(Ws + rw * GP + c * 8) = *(const u32x4*)(WG + rw * 1024 + c * 8); }
    __syncthreads();
    float* GT = (float*)(p.ws + WS_GATES);
    const int r = lane & 31, hh = lane >> 5;
    const int gw = bidx * 8 + wave, NGW = nblk * 8;
    const float gb = p.in[9][r & 15];
    for (int tile = gw; tile < MTOT / 32; tile += NGW) {
        const int row0 = 32 * tile;
        const bf16* ap = H + (size_t)(row0 + r) * DM + 8 * hh;
        const LAS bf16* bh = Ws + (r & 15) * GP + 8 * hh; const LAS bf16* bl = bh + 16 * GP;
        f32x16 acc = zero16();
#pragma unroll 1
        for (int kg = 0; kg < 4; ++kg) { bf16x8 af[16];
#pragma unroll
            for (int q = 0; q < 16; ++q) af[q] = *(const bf16x8*)(ap + 16 * (16 * kg + q));
            asm volatile("" ::: "memory");
#pragma unroll
            for (int q = 0; q < 16; ++q) { const int ks = 16 * kg + q;
                acc = MFMA32(af[q], *(const LAS bf16x8*)(bh + 16 * ks), acc); acc = MFMA32(af[q], *(const LAS bf16x8*)(bl + 16 * ks), acc); } }
        if (r < 16) {
#pragma unroll
            for (int i = 0; i < 16; ++i) { float gv = acc[i] + gb; if ((r >> 2) & 1) gv = log_sigmoid(gv); GT[(size_t)(row0 + crow(i, hh)) * 16 + r] = gv; } }
    }
    __syncthreads();
}


DI void phase_bias(const Params& p, int lane, int wave, int it_lo, int it_hi, int bidx, int nblk) {
    const float* MOD = (const float*)(p.ws + WS_MOD); float* BIAS = (float*)(p.ws + WS_BIAS);
    const int gw = bidx * 8 + wave, NGW = nblk * 8;
    for (int it = it_lo + gw; it < it_hi; it += NGW) {
        int which, n; const bf16* WT; const float* sh;
        if (it < 4096) { which = 0; n = it; WT = (const bf16*)(p.ws + WS_W1); sh = MOD + 3 * DM; }
        else if (it < 4096 + 1536) { which = 1; n = it - 4096; WT = (const bf16*)(p.ws + WS_WIN1); sh = MOD + 9 * NMODC; }
        else { which = 2; n = it - 4096 - 1536; WT = (const bf16*)(p.ws + WS_W1) + (size_t)DFF * DM; sh = MOD + 9 * NMODC + 3 * DM; }
        const u32x4 w0 = *(const u32x4*)(WT + (size_t)n * DM + lane * 16), w1 = *(const u32x4*)(WT + (size_t)n * DM + lane * 16 + 8);
        float wf[16];
        wf[0] = __uint_as_float(w0.x << 16); wf[1] = __uint_as_float(w0.x & 0xffff0000u); wf[2] = __uint_as_float(w0.y << 16); wf[3] = __uint_as_float(w0.y & 0xffff0000u);
        wf[4] = __uint_as_float(w0.z << 16); wf[5] = __uint_as_float(w0.z & 0xffff0000u); wf[6] = __uint_as_float(w0.w << 16); wf[7] = __uint_as_float(w0.w & 0xffff0000u);
        wf[8] = __uint_as_float(w1.x << 16); wf[9] = __uint_as_float(w1.x & 0xffff0000u); wf[10] = __uint_as_float(w1.y << 16); wf[11] = __uint_as_float(w1.y & 0xffff0000u);
        wf[12] = __uint_as_float(w1.z << 16); wf[13] = __uint_as_float(w1.z & 0xffff0000u); wf[14] = __uint_as_float(w1.w << 16); wf[15] = __uint_as_float(w1.w & 0xffff0000u);
        float mine = 0.f;
        f32x4 s4[9][4];
#pragma unroll
        for (int r = 0; r < 9; ++r)
#pragma unroll
            for (int q = 0; q < 4; ++q) s4[r][q] = *(const f32x4*)(sh + r * NMODC + lane * 16 + 4 * q);
        float av[9];
#pragma unroll
        for (int r = 0; r < 9; ++r) { float a = 0.f;
#pragma unroll
            for (int q = 0; q < 4; ++q) a += s4[r][q][0] * wf[4 * q] + s4[r][q][1] * wf[4 * q + 1] + s4[r][q][2] * wf[4 * q + 2] + s4[r][q][3] * wf[4 * q + 3];
            av[r] = a; }
#pragma unroll
        for (int o = 1; o < 64; o <<= 1) {
#pragma unroll
            for (int r = 0; r < 9; ++r) av[r] += __shfl_xor(av[r], o); }
#pragma unroll
        for (int r = 0; r < 9; ++r) if (lane == r) mine = av[r];
        if (lane < 9) BIAS[(which * 9 + lane) * 4096 + n] = mine;
    }
}


DI void phase_post1(bf16* QKV, const float* qg, const float* kg, bf16* K1, bf16* V1, int lane, int wave, int row_lo, int row_hi, int bidx, int nblk) {
    constexpr int HD = 128, PPA = 32, NH = 10, pitch = NIN1, R = 2;
    const int gw = bidx * 8 + wave, NGW = nblk * 8;
    const float gq0 = qg[lane], gq1 = qg[lane + 64], gk0 = kg[lane], gk1 = kg[lane + 64];
    const int fi = lane & (PPA - 1); const float invf = exp2f(-(float)fi * (13.287712379549449f / (float)PPA));
    for (int row0 = row_lo + gw; row0 < row_hi; row0 += R * NGW) {
        int rows[R]; bool ok[R], lat[R]; int bb[R], key[R]; float cs[R], sn[R]; bf16* base[R];
        float x1[R][NH], x2[R][NH], ss[R][NH]; bf16 vv[R][4];
#pragma unroll
        for (int q = 0; q < R; ++q) { rows[q] = row0 + q * NGW; ok[q] = rows[q] < row_hi; if (!ok[q]) rows[q] = row0;
            lat[q] = rows[q] >= NCTX; const int tt = (rows[q] - NCTX) & (SEQ - 1);
            if (lat[q]) { bb[q] = (rows[q] - NCTX) >> 12; key[q] = CTXL + tt; } else { bb[q] = rows[q] >> 8; key[q] = rows[q] & 255; }
            cs[q] = 1.f; sn[q] = 0.f;
            if (lat[q]) { const float ang = (float)(lane < PPA ? (tt >> 6) : (tt & 63)) * invf; cs[q] = __cosf(ang); sn[q] = __sinf(ang); }
            base[q] = QKV + (size_t)rows[q] * pitch;
#pragma unroll
            for (int hq = 0; hq < NH; ++hq) { x1[q][hq] = bf2f(base[q][hq * HD + lane]); x2[q][hq] = bf2f(base[q][hq * HD + lane + 64]); }
#pragma unroll
            for (int j = 0; j < 4; ++j) vv[q][j] = base[q][1280 + 64 * j + lane]; }
        asm volatile("" ::: "memory");
#pragma unroll
        for (int q = 0; q < R; ++q)
#pragma unroll
            for (int hq = 0; hq < NH; ++hq) ss[q][hq] = x1[q][hq] * x1[q][hq] + x2[q][hq] * x2[q][hq];
#pragma unroll
        for (int o = 1; o < 64; o <<= 1) {
#pragma unroll
            for (int q = 0; q < R; ++q)
#pragma unroll
                for (int hq = 0; hq < NH; ++hq) ss[q][hq] += __shfl_xor(ss[q][hq], o); }
#pragma unroll
        for (int q = 0; q < R; ++q) if (ok[q]) {
#pragma unroll
            for (int hq = 0; hq < NH; ++hq) if (hq >= 8 || lat[q]) {
                const float rs = rsqrtf(ss[q][hq] * (1.f / (float)HD) + EPS);
                const float y1 = x1[q][hq] * rs * (hq < 8 ? gq0 : gk0), y2 = x2[q][hq] * rs * (hq < 8 ? gq1 : gk1);
                bf16* dst = hq < 8 ? base[q] + hq * HD : K1 + ((size_t)(bb[q] * 2 + (hq - 8)) * KVLEN + key[q]) * HD;
                dst[lane] = f2bf(y1 * cs[q] - y2 * sn[q]); dst[lane + 64] = f2bf(y2 * cs[q] + y1 * sn[q]); }
            bf16* vd0 = V1 + ((size_t)(bb[q] * 2) * KVLEN + key[q]) * HD; bf16* vd1 = V1 + ((size_t)(bb[q] * 2 + 1) * KVLEN + key[q]) * HD;
            vd0[lane] = vv[q][0]; vd0[lane + 64] = vv[q][1]; vd1[lane] = vv[q][2]; vd1[lane + 64] = vv[q][3]; }
    }
}

template <int HD>
DI void phase_post(bf16* QKV, int pitch, int qcol, int nq, int kcol, int nk, int vcol, const float* qg, const float* kg, bf16* VT, bool q_for_ctx,
                   LAS unsigned char* lds, int tid, int lane, int wave, int row_lo = 0, int row_hi = MTOT, int tile_lo = 0, int tile_hi = MTOT / 64) {
    constexpr int PPA = HD / 4, NH = 10, R = 2;
    const int gw = blockIdx.x * 8 + wave, NGW = gridDim.x * 8;
    float gq0, gq1 = 0.f, gk0, gk1 = 0.f;
    gq0 = qg[lane]; gk0 = kg[lane]; if (HD == 128) { gq1 = qg[lane + 64]; gk1 = kg[lane + 64]; }
    const int jj = (HD == 64) ? (lane & 31) : lane;
    const float invf = exp2f(-(float)(jj & (PPA - 1)) * (13.287712379549449f / (float)PPA));
    for (int row0 = row_lo + gw; row0 < row_hi; row0 += R * NGW) {
        int rows[R]; bool ok[R], lat[R]; int h0[R]; float cs[R], sn[R]; bf16* base[R];
        float x1[R][NH], x2[R][NH], ss[R][NH];
#pragma unroll
        for (int q = 0; q < R; ++q) { rows[q] = row0 + q * NGW; ok[q] = rows[q] < row_hi; if (!ok[q]) rows[q] = row0;
            lat[q] = rows[q] >= NCTX; const int tt = (rows[q] - NCTX) & (SEQ - 1);
            cs[q] = 1.f; sn[q] = 0.f;
            if (lat[q]) { const float ang = (float)(jj < PPA ? (tt >> 6) : (tt & 63)) * invf; cs[q] = __cosf(ang); sn[q] = __sinf(ang); }
            h0[q] = (lat[q] || q_for_ctx) ? 0 : nq;
            base[q] = QKV + (size_t)rows[q] * pitch + qcol;
#pragma unroll
            for (int hq = 0; hq < NH; ++hq) { x1[q][hq] = bf2f(base[q][hq * HD + lane]); x2[q][hq] = 0.f; if (HD == 128) x2[q][hq] = bf2f(base[q][hq * HD + lane + 64]); } }
        asm volatile("" ::: "memory");
#pragma unroll
        for (int q = 0; q < R; ++q)
#pragma unroll
            for (int hq = 0; hq < NH; ++hq) ss[q][hq] = x1[q][hq] * x1[q][hq] + x2[q][hq] * x2[q][hq];
#pragma unroll
        for (int o = 1; o < 64; o <<= 1) {
#pragma unroll
            for (int q = 0; q < R; ++q)
#pragma unroll
                for (int hq = 0; hq < NH; ++hq) ss[q][hq] += __shfl_xor(ss[q][hq], o); }
#pragma unroll
        for (int q = 0; q < R; ++q) {
#pragma unroll
            for (int hq = 0; hq < NH; ++hq) if (hq >= h0[q]) {
                const float rs = rsqrtf(ss[q][hq] * (1.f / (float)HD) + EPS);
                if (HD == 64) { const float y = x1[q][hq] * rs * (hq < 8 ? gq0 : gk0); const float pr = __shfl_xor(y, 32);
                    if (ok[q]) base[q][hq * HD + lane] = f2bf(lane < 32 ? y * cs[q] - pr * sn[q] : y * cs[q] + pr * sn[q]); }
                else { const float y1 = x1[q][hq] * rs * (hq < 8 ? gq0 : gk0), y2 = x2[q][hq] * rs * (hq < 8 ? gq1 : gk1);
                    if (ok[q]) { base[q][hq * HD + lane] = f2bf(y1 * cs[q] - y2 * sn[q]); base[q][hq * HD + lane + 64] = f2bf(y2 * cs[q] + y1 * sn[q]); } }
            } }
    }
    constexpr int NV = 2 * HD, TP = NV + 2;
    LAS bf16* tile = (LAS bf16*)lds;
    for (int tk = tile_lo + blockIdx.x; tk < tile_hi; tk += gridDim.x) {
        const int row0 = 64 * tk; int b, key0;
        if (row0 < NCTX) { b = row0 >> 8; key0 = row0 & 255; } else { const int lr = row0 - NCTX; b = lr >> 12; key0 = 256 + (lr & 4095); }
        { constexpr int NIT = 64 * NV / 512; bf16 tv[NIT];
#pragma unroll
          for (int i = 0; i < NIT; ++i) { const int idx = tid + 512 * i, tok = idx / NV, c = idx - tok * NV; tv[i] = QKV[(size_t)(row0 + tok) * pitch + vcol + c]; }
#pragma unroll
          for (int i = 0; i < NIT; ++i) { const int idx = tid + 512 * i, tok = idx / NV, c = idx - tok * NV; tile[tok * TP + c] = tv[i]; } }
        __syncthreads();
        for (int idx = tid; idx < 64 * NV; idx += 512) { const int rr = idx >> 6, key = idx & 63; VT[(size_t)(b * NV + rr) * KVLEN + key0 + key] = tile[key * TP + rr]; }
        __syncthreads();
    }
}

constexpr int MP = 136;
constexpr int ML_VT = 0, ML_VWT = 40 * MP * 2, ML_CT = 2 * 40 * MP * 2, ML_Q = 3 * 40 * MP * 2, ML_K = ML_Q + 128 * MP * 2, ML_KT = ML_K + 128 * MP * 2, ML_SC = ML_KT + 128 * MP * 2;
static_assert(ML_SC + 5120 <= LDS_BYTES, "mLSTM LDS map");
DI void mlstm_item(const Params& p, LAS unsigned char* lds, int item, int tid, int lane, int wave) {
    const int dvq = item & 3, dir = (item >> 2) & 1, head = (item >> 3) & 3, b = item >> 5;
    const bf16* QKV = (const bf16*)(p.ws + WS_BIG); const float* GT = (const float*)(p.ws + WS_GATES);
    float* XC = (float*)(p.ws + WS_XC);
    LAS bf16* VTs = (LAS bf16*)(lds + ML_VT); LAS bf16* VWTs = (LAS bf16*)(lds + ML_VWT); LAS bf16* CTs = (LAS bf16*)(lds + ML_CT);
    LAS bf16* Qs = (LAS bf16*)(lds + ML_Q); LAS bf16* Ks = (LAS bf16*)(lds + ML_K); LAS bf16* KTs = (LAS bf16*)(lds + ML_KT); LAS bf16* Ss = Ks;
    LAS float* sc = (LAS float*)(lds + ML_SC);
    LAS float* s_ic = sc; LAS float* s_fc = sc + 128; LAS float* s_a = sc + 256; LAS float* s_rt = sc + 384; LAS float* s_iw = sc + 512;
    LAS float* s_w = sc + 640; LAS float* s_emt = sc + 768; LAS float* s_den = sc + 896; LAS float* s_misc = sc + 1024;
    const int r = lane & 31, h = lane >> 5, ti = wave >> 1, tj = wave & 1;
    const float KSCALE = 0.08838834764831845f;
    for (int i = tid; i < 40 * MP; i += 512) CTs[i] = 0;
    if (tid < 128) VTs[32 * MP + tid] = 0x3F80;
    f32x16 accC = zero16(); float m = 0.f;
    __syncthreads();
    for (int ci = 0; ci < 34; ++ci) {
        int base;
        if (ci < 2) { const int cc = dir ? 1 - ci : ci; base = b * 256 + cc * 128; }
        else { const int cc = dir ? 31 - (ci - 2) : (ci - 2); base = NCTX + b * 4096 + cc * 128; }
#pragma unroll
        for (int i = 0; i < 4; ++i) { const int id = tid + 512 * i, rr = id >> 4, c = id & 15; const size_t grow = base + (dir ? 127 - rr : rr);
            const bf16* src = QKV + grow * NIN0 + head * 128 + c * 8;
            *(LAS u32x4*)(Qs + rr * MP + c * 8) = *(const u32x4*)src; *(LAS u32x4*)(Ks + rr * MP + c * 8) = *(const u32x4*)(src + 512); }
        { const int rr = tid >> 2, c = tid & 3; const size_t grow = base + (dir ? 127 - rr : rr);
            const u32x4 v = *(const u32x4*)(QKV + grow * NIN0 + 1024 + head * 128 + dvq * 32 + c * 8);
            LAS bf16* d = VTs + (c * 8) * MP + rr;
            d[0] = (bf16)(v.x & 0xffffu); d[MP] = (bf16)(v.x >> 16); d[2 * MP] = (bf16)(v.y & 0xffffu); d[3 * MP] = (bf16)(v.y >> 16);
            d[4 * MP] = (bf16)(v.z & 0xffffu); d[5 * MP] = (bf16)(v.z >> 16); d[6 * MP] = (bf16)(v.w & 0xffffu); d[7 * MP] = (bf16)(v.w >> 16); }
        if (tid < 256) { const int rr = tid & 127; const size_t grow = base + (dir ? 127 - rr : rr); const int gi = (dir ? 2 : 0) + (tid >> 7);
            const float gv = GT[grow * 16 + gi * 4 + head]; if (tid < 128) s_ic[rr] = gv; else s_fc[rr] = gv; }
        __syncthreads();
        { const int d = tid & 127, sg = tid >> 7;
#pragma unroll
            for (int s8 = 0; s8 < 4; ++s8) { const LAS bf16* kp = Ks + (32 * sg + 8 * s8) * MP + d;
                u32x4 o; o.x = (unsigned)kp[0] | ((unsigned)kp[MP] << 16); o.y = (unsigned)kp[2 * MP] | ((unsigned)kp[3 * MP] << 16);
                o.z = (unsigned)kp[4 * MP] | ((unsigned)kp[5 * MP] << 16); o.w = (unsigned)kp[6 * MP] | ((unsigned)kp[7 * MP] << 16);
                *(LAS u32x4*)(KTs + d * MP + 32 * sg + 8 * s8) = o; } }
        if (wave == 0) {
            const float f0 = s_fc[2 * lane], f1 = s_fc[2 * lane + 1], i0 = s_ic[2 * lane], i1 = s_ic[2 * lane + 1];
            float S = f0 + f1;
#pragma unroll
            for (int o = 1; o < 64; o <<= 1) { const float t = __shfl_up(S, o); if (lane >= o) S += t; }
            const float bc1 = S, bc0 = S - f1, a0 = i0 - bc0, a1 = i1 - bc1;
            float P = fmaxf(a0, a1);
#pragma unroll
            for (int o = 1; o < 64; o <<= 1) { const float t = __shfl_up(P, o); if (lane >= o) P = fmaxf(P, t); }
            float Pex = __shfl_up(P, 1); if (lane == 0) Pex = -INFINITY;
            const float pm0 = fmaxf(Pex, a0), pm1 = P;
            const float blast = __shfl(bc1, 63), Mall = __shfl(P, 63);
            const float mnew = blast + fmaxf(m, Mall);
            const float rt0 = -fmaxf(m, pm0), rt1 = -fmaxf(m, pm1);
            s_a[2 * lane] = a0; s_a[2 * lane + 1] = a1; s_rt[2 * lane] = rt0; s_rt[2 * lane + 1] = rt1;
            s_iw[2 * lane] = __expf(m + rt0); s_iw[2 * lane + 1] = __expf(m + rt1);
            s_w[2 * lane] = __expf(a0 + blast - mnew) * KSCALE; s_w[2 * lane + 1] = __expf(a1 + blast - mnew) * KSCALE;
            s_emt[2 * lane] = __expf(rt0 - bc0); s_emt[2 * lane + 1] = __expf(rt1 - bc1);
            if (lane == 0) { s_misc[0] = __expf(blast + m - mnew); s_misc[1] = mnew; }
        }
        __syncthreads();
        const float carry = s_misc[0], mnew = s_misc[1];
        for (int idx = tid; idx < 33 * 128; idx += 512) { const int e = idx >> 7, s = idx & 127; VWTs[e * MP + s] = f2bf(bf2f(VTs[e * MP + s]) * s_w[s]); }
        float sv[2][16];
#pragma unroll
        for (int tt = 0; tt < 2; ++tt) { const int tjs = (wave & 1) * 2 + tt;
            if (tjs <= ti) { f32x16 acc = zero16(); mma32(acc, Qs + 32 * ti * MP, MP, Ks + 32 * tjs * MP, MP, 128, lane);
                const int scol = 32 * tjs + r; const float as = s_a[scol];
#pragma unroll
                for (int i = 0; i < 16; ++i) { const int trow = 32 * ti + crow(i, h); const float e = (scol <= trow) ? __expf(as + s_rt[trow]) : 0.f; sv[tt][i] = acc[i] * KSCALE * e; } } }
        __syncthreads();
#pragma unroll
        for (int tt = 0; tt < 2; ++tt) { const int tjs = (wave & 1) * 2 + tt;
            if (tjs <= ti) { const int scol = 32 * tjs + r;
#pragma unroll
                for (int i = 0; i < 16; ++i) Ss[(32 * ti + crow(i, h)) * MP + scol] = f2bf(sv[tt][i]); } }
        __syncthreads();
        f32x16 a1 = zero16(), a2 = zero16(), up = zero16();
        mma32(a1, Qs + 32 * ti * MP, MP, CTs + 32 * tj * MP, MP, 128, lane);
        mma32(a2, Ss + 32 * ti * MP, MP, VTs + 32 * tj * MP, MP, 32 * (ti + 1), lane);
        float num[16];
#pragma unroll
        for (int i = 0; i < 16; ++i) num[i] = s_iw[32 * ti + crow(i, h)] * a1[i] + a2[i];
        if (tj == 1 && r == 0) {
#pragma unroll
            for (int i = 0; i < 16; ++i) s_den[32 * ti + crow(i, h)] = num[i]; }
        mma32(up, KTs + 32 * ti * MP, MP, VWTs + 32 * tj * MP, MP, 128, lane);
#pragma unroll
        for (int i = 0; i < 16; ++i) accC[i] = carry * accC[i] + up[i];
        __syncthreads();
        if (tj == 0) {
#pragma unroll
            for (int i = 0; i < 16; ++i) { const int trow = 32 * ti + crow(i, h); const float hv = num[i] / fmaxf(fabsf(s_den[trow]), s_emt[trow]);
                const int grow = base + (dir ? 127 - trow : trow);
                float* dst = grow < NCTX ? XC + (size_t)grow * DM : p.out + (size_t)(grow - NCTX) * DM;
                dst[dir * 512 + head * 128 + dvq * 32 + r] = hv; } }
        if (tj == 0 || r == 0) {
#pragma unroll
            for (int g = 0; g < 4; ++g) { u32x2 o; o.x = cvtpk(accC[4 * g], accC[4 * g + 1]); o.y = cvtpk(accC[4 * g + 2], accC[4 * g + 3]);
                *(LAS u32x2*)(CTs + (32 * tj + r) * MP + 32 * ti + 8 * g + 4 * h) = o; } }
        m = mnew;
    }
    __syncthreads();
}


constexpr int NCH = 34, UROWS = 129;
constexpr size_t WS_MSC = WS_GATES + 2560 * 1024;
DI int chunk_base(int b, int cp) { return cp < 2 ? b * CTXL + cp * 128 : NCTX + b * SEQ + (cp - 2) * 128; }
DI float shfl_up_l(float v, int o, int lane) { return __int_as_float(__builtin_amdgcn_ds_bpermute((lane >= o ? lane - o : lane) << 2, __float_as_int(v))); }
DI void chunk_scan(int dir, const LAS float* ic, const LAS float* fc, int lane, float& a0, float& a1, float& pm0, float& pm1, float& bc0, float& bc1, float& blast, float& Mall, int& u0, int& u1) {
    u0 = dir ? 127 - 2 * lane : 2 * lane; u1 = dir ? u0 - 1 : u0 + 1;
    const float f0 = fc[u0], f1 = fc[u1], i0 = ic[u0], i1 = ic[u1];
    float S = f0 + f1;
#pragma unroll
    for (int o = 1; o < 64; o <<= 1) { const float t = shfl_up_l(S, o, lane); if (lane >= o) S += t; }
    bc1 = S; bc0 = S - f1; a0 = i0 - bc0; a1 = i1 - bc1;
    float P = fmaxf(a0, a1);
#pragma unroll
    for (int o = 1; o < 64; o <<= 1) { const float t = shfl_up_l(P, o, lane); if (lane >= o) P = fmaxf(P, t); }
    float Pex = shfl_up_l(P, 1, lane); if (lane == 0) Pex = -INFINITY;
    pm0 = fmaxf(Pex, a0); pm1 = P;
    blast = __int_as_float(__builtin_amdgcn_readlane(__float_as_int(bc1), 63)); Mall = __int_as_float(__builtin_amdgcn_readlane(__float_as_int(P), 63));
}
constexpr int X_VT = 0, X_VWT = UROWS * MP * 2, X_KT = 2 * UROWS * MP * 2, X_SC = X_KT + 128 * MP * 2;
DI void mlstm_x1(const Params& p, LAS unsigned char* lds, int item, int tid_in, int lane_in, int wave) {
    int tid = tid_in; asm volatile("" : "+v"(tid)); const int lane = tid & 63; (void)lane_in;
    const int cp = item % NCH, head = (item / NCH) & 3, b = item / (NCH * 4);
    const bf16* QKV = (const bf16*)(p.ws + WS_BIG); const float* GT = (const float*)(p.ws + WS_GATES);
    bf16* UT = (bf16*)p.out; float* SC = (float*)(p.ws + WS_MSC);
    LAS bf16* VTs = (LAS bf16*)(lds + X_VT); LAS bf16* VWTs = (LAS bf16*)(lds + X_VWT); LAS bf16* KTs = (LAS bf16*)(lds + X_KT);
    LAS float* sc = (LAS float*)(lds + X_SC);
    LAS float* s_w = sc + 512;
    const int base = chunk_base(b, cp);
    const int r = lane & 31, h = lane >> 5;
    const float KSCALE = 0.08838834764831845f;
    __syncthreads();
#pragma unroll
    for (int i = 0; i < 4; ++i) { const int id = tid + 512 * i, rr = id & 127, c = id >> 7;
        const bf16* src = QKV + (size_t)(base + rr) * NIN0 + head * 128 + c * 8;
        const u32x4 k = *(const u32x4*)(src + 512), v = *(const u32x4*)(src + 1024);
        LAS bf16* dk = KTs + (c * 8) * MP + rr; LAS bf16* dv = VTs + (c * 8) * MP + rr;
        dk[0] = (bf16)(k.x & 0xffffu); dk[MP] = (bf16)(k.x >> 16); dk[2 * MP] = (bf16)(k.y & 0xffffu); dk[3 * MP] = (bf16)(k.y >> 16);
        dk[4 * MP] = (bf16)(k.z & 0xffffu); dk[5 * MP] = (bf16)(k.z >> 16); dk[6 * MP] = (bf16)(k.w & 0xffffu); dk[7 * MP] = (bf16)(k.w >> 16);
        dv[0] = (bf16)(v.x & 0xffffu); dv[MP] = (bf16)(v.x >> 16); dv[2 * MP] = (bf16)(v.y & 0xffffu); dv[3 * MP] = (bf16)(v.y >> 16);
        dv[4 * MP] = (bf16)(v.z & 0xffffu); dv[5 * MP] = (bf16)(v.z >> 16); dv[6 * MP] = (bf16)(v.w & 0xffffu); dv[7 * MP] = (bf16)(v.w >> 16); }
    { const int u = tid & 127, gi = tid >> 7; sc[gi * 128 + u] = GT[(size_t)(base + u) * 16 + gi * 4 + head]; }
    __syncthreads();
    if (wave < 2) { const int dir = wave; float a0, a1, pm0, pm1, bc0, bc1, blast, Mall; int u0, u1;
        chunk_scan(dir, sc + dir * 256, sc + dir * 256 + 128, lane, a0, a1, pm0, pm1, bc0, bc1, blast, Mall, u0, u1);
        s_w[dir * 128 + u0] = __expf(a0 - Mall) * KSCALE; s_w[dir * 128 + u1] = __expf(a1 - Mall) * KSCALE;
        if (lane == 0) { float* o = SC + ((size_t)((b * 4 + head) * 2 + dir) * NCH + cp) * 2; o[0] = blast; o[1] = Mall; } }
    __syncthreads();
    for (int dir = 0; dir < 2; ++dir) {
        for (int idx = tid; idx < UROWS * 16; idx += 512) { const int e = idx >> 4, c8 = (idx & 15) * 8;
            const u32x4 v = e < 128 ? *(const LAS u32x4*)(VTs + e * MP + c8) : (u32x4){0x3F803F80u, 0x3F803F80u, 0x3F803F80u, 0x3F803F80u};
            const f32x4 w0 = *(const LAS f32x4*)(s_w + dir * 128 + c8), w1 = *(const LAS f32x4*)(s_w + dir * 128 + c8 + 4);
            u32x4 o; o.x = cvtpk(__uint_as_float(v.x << 16) * w0[0], __uint_as_float(v.x & 0xffff0000u) * w0[1]); o.y = cvtpk(__uint_as_float(v.y << 16) * w0[2], __uint_as_float(v.y & 0xffff0000u) * w0[3]);
            o.z = cvtpk(__uint_as_float(v.z << 16) * w1[0], __uint_as_float(v.z & 0xffff0000u) * w1[1]); o.w = cvtpk(__uint_as_float(v.w << 16) * w1[2], __uint_as_float(v.w & 0xffff0000u) * w1[3]);
            *(LAS u32x4*)(VWTs + e * MP + c8) = o; }
        __syncthreads();
        bf16* Uo = UT + ((size_t)((b * 4 + head) * 2 + dir) * NCH + cp) * (UROWS * 128);
        for (int tile = wave; tile < 20; tile += 8) { const int td = tile & 3, te = tile >> 2;
            f32x16 acc = zero16();
            const LAS bf16* bp = VWTs + (te < 4 ? (32 * te + r) : 128) * MP + 8 * h; const LAS bf16* ap = KTs + (32 * td + r) * MP + 8 * h;
#pragma unroll
            for (int k0 = 0; k0 < 128; k0 += 16) acc = MFMA32(*(const LAS bf16x8*)(ap + k0), *(const LAS bf16x8*)(bp + k0), acc);
            if (te < 4 || r == 0) { bf16* dst = Uo + (size_t)(te < 4 ? 32 * te + r : 128) * 128 + 32 * td + 4 * h;
#pragma unroll
                for (int g = 0; g < 4; ++g) { u32x2 o; o.x = cvtpk(acc[4 * g], acc[4 * g + 1]); o.y = cvtpk(acc[4 * g + 2], acc[4 * g + 3]); *(u32x2*)(dst + 8 * g) = o; } } }
        __syncthreads();
    }
}
DI void mlstm_x2(const Params& p, int tid) {
    const bf16* __restrict__ UT = (const bf16*)p.out; const float* __restrict__ SC = (const float*)(p.ws + WS_MSC); float* __restrict__ MST = (float*)(p.ws + WS_MSC) + 64 * NCH * 2;
    bf16* __restrict__ CT = (bf16*)(p.ws + WS_BIG) + (size_t)MTOT * NIN0;
    constexpr int SZ = UROWS * 128;
    for (int item = blockIdx.x; item < 256; item += gridDim.x) {
        const int chain = item >> 2, part = item & 3, dir = chain & 1;
        const int g1 = part * 512 + tid; const bool has2 = (part == 0) && (tid < 16); const int g2 = 2048 + (tid & 15);
        float c[8], c2[8];
#pragma unroll
        for (int j = 0; j < 8; ++j) { c[j] = 0.f; c2[j] = 0.f; }
        float m = 0.f;
        const size_t cb = (size_t)chain * NCH;
#pragma unroll 1
        for (int half = 0; half < 2; ++half) {
            u32x4 uv[17], uw[17]; f32x2 scv[17];
#pragma unroll
            for (int j = 0; j < 17; ++j) { const int ci = half * 17 + j, cp = dir ? (ci < 2 ? 1 - ci : 35 - ci) : ci;
                uv[j] = *(const u32x4*)(UT + (cb + cp) * SZ + g1 * 8);
                uw[j] = has2 ? *(const u32x4*)(UT + (cb + cp) * SZ + g2 * 8) : (u32x4){0u, 0u, 0u, 0u};
                scv[j] = *(const f32x2*)(SC + (cb + cp) * 2); }
            asm volatile("" ::: "memory");
#pragma unroll
            for (int j = 0; j < 17; ++j) { const int ci = half * 17 + j, cp = dir ? (ci < 2 ? 1 - ci : 35 - ci) : ci;
                const float blast = scv[j].x, Mall = scv[j].y;
                u32x4 o; o.x = cvtpk(c[0], c[1]); o.y = cvtpk(c[2], c[3]); o.z = cvtpk(c[4], c[5]); o.w = cvtpk(c[6], c[7]);
                *(u32x4*)(CT + (cb + cp) * SZ + g1 * 8) = o;
                if (has2) { u32x4 o2; o2.x = cvtpk(c2[0], c2[1]); o2.y = cvtpk(c2[2], c2[3]); o2.z = cvtpk(c2[4], c2[5]); o2.w = cvtpk(c2[6], c2[7]); *(u32x4*)(CT + (cb + cp) * SZ + g2 * 8) = o2; }
                if (part == 0 && tid == 0) MST[cb + cp] = m;
                const float mnew = blast + fmaxf(m, Mall), cw = __expf(blast + m - mnew), uwt = __expf(blast + Mall - mnew);
                const u32x4 a = uv[j], b2 = uw[j];
                c[0] = cw * c[0] + uwt * __uint_as_float(a.x << 16); c[1] = cw * c[1] + uwt * __uint_as_float(a.x & 0xffff0000u);
                c[2] = cw * c[2] + uwt * __uint_as_float(a.y << 16); c[3] = cw * c[3] + uwt * __uint_as_float(a.y & 0xffff0000u);
                c[4] = cw * c[4] + uwt * __uint_as_float(a.z << 16); c[5] = cw * c[5] + uwt * __uint_as_float(a.z & 0xffff0000u);
                c[6] = cw * c[6] + uwt * __uint_as_float(a.w << 16); c[7] = cw * c[7] + uwt * __uint_as_float(a.w & 0xffff0000u);
                c2[0] = cw * c2[0] + uwt * __uint_as_float(b2.x << 16); c2[1] = cw * c2[1] + uwt * __uint_as_float(b2.x & 0xffff0000u);
                c2[2] = cw * c2[2] + uwt * __uint_as_float(b2.y << 16); c2[3] = cw * c2[3] + uwt * __uint_as_float(b2.y & 0xffff0000u);
                c2[4] = cw * c2[4] + uwt * __uint_as_float(b2.z << 16); c2[5] = cw * c2[5] + uwt * __uint_as_float(b2.z & 0xffff0000u);
                c2[6] = cw * c2[6] + uwt * __uint_as_float(b2.w << 16); c2[7] = cw * c2[7] + uwt * __uint_as_float(b2.w & 0xffff0000u);
                m = mnew; }
        }
    }
}
constexpr int Y_VT = 0, Y_S = UROWS * MP * 2, Y_C = Y_S + 128 * MP * 2, Y_SC = Y_C + 2 * UROWS * MP * 2;
static_assert(Y_SC + 7168 <= LDS_BYTES - 16, "X3 LDS map");
DI void mlstm_x3(const Params& p, LAS unsigned char* lds, int item, int tid_in, int lane_in, int wave) {
    (void)tid_in; (void)lane_in;
    int tid = wave * 64 + fresh_lane(); asm volatile("" : "+v"(tid)); const int lane = tid & 63;
    const int cp = item % NCH, head = (item / NCH) & 3, b = item / (NCH * 4);
    const bf16* QKV = (const bf16*)(p.ws + WS_BIG); const float* GT = (const float*)(p.ws + WS_GATES);
    const float* MST = (const float*)(p.ws + WS_MSC) + 64 * NCH * 2;
    const bf16* CT = (const bf16*)(p.ws + WS_BIG) + (size_t)MTOT * NIN0;
    bf16* OC = (bf16*)(p.ws + WS_OCAT);
    { size_t z0 = 0; asm volatile("" : "+s"(z0)); QKV += z0; CT += z0; OC += z0; GT += z0; }
    LAS bf16* VTs = (LAS bf16*)(lds + Y_VT); LAS bf16* Ss = (LAS bf16*)(lds + Y_S);
    LAS float* sc = (LAS float*)(lds + Y_SC);
    LAS float* s_dir = sc + 512; LAS float* s_ssq = sc + 512 + 1024;
    LAS bf16* Cs = (LAS bf16*)(lds + Y_C);
    const int base = chunk_base(b, cp);
    const int r_ = lane & 31, h = lane >> 5, ti = wave >> 1, eh = wave & 1;
    const float KSCALE = 0.08838834764831845f;
    __syncthreads();
    const float mst0 = MST[(size_t)((b * 4 + head) * 2) * NCH + cp], mst1 = MST[(size_t)((b * 4 + head) * 2 + 1) * NCH + cp];
    u32x4 vr[4];
#pragma unroll
    for (int i = 0; i < 4; ++i) { const int id = tid + 512 * i, rr = id & 127, c = id >> 7; vr[i] = *(const u32x4*)(QKV + (size_t)(base + rr) * NIN0 + 1024 + head * 128 + c * 8); }
    const float gval = GT[(size_t)(base + (tid & 127)) * 16 + (tid >> 7) * 4 + head];
    u32x4 cb[9];
    { const bf16* C0 = CT + ((size_t)((b * 4 + head) * 2) * NCH + cp) * (UROWS * 128);
#pragma unroll
      for (int i = 0; i < 9; ++i) { const int id = tid + 512 * i; const int idc = id < 2 * UROWS * 16 ? id : 0; const int dd = idc >= UROWS * 16, q = idc - dd * UROWS * 16;
          cb[i] = *(const u32x4*)(C0 + (size_t)dd * NCH * (UROWS * 128) + q * 8); } }
    bf16x8 qf[8], kf[2][8];
    { const bf16* qp = QKV + (size_t)(base + 32 * ti + r_) * NIN0 + head * 128 + 8 * h;
#pragma unroll
        for (int ks = 0; ks < 8; ++ks) qf[ks] = *(const bf16x8*)(qp + 16 * ks); }
#pragma unroll
    for (int tt = 0; tt < 2; ++tt) { const bf16* kp = QKV + (size_t)(base + 32 * (2 * eh + tt) + r_) * NIN0 + 512 + head * 128 + 8 * h;
#pragma unroll
        for (int ks = 0; ks < 8; ++ks) kf[tt][ks] = *(const bf16x8*)(kp + 16 * ks); }
    asm volatile("" ::: "memory");
#pragma unroll
    for (int i = 0; i < 4; ++i) { const int id = tid + 512 * i, rr = id & 127, c = id >> 7; const u32x4 v = vr[i];
        LAS bf16* dv = VTs + (c * 8) * MP + rr;
        dv[0] = (bf16)(v.x & 0xffffu); dv[MP] = (bf16)(v.x >> 16); dv[2 * MP] = (bf16)(v.y & 0xffffu); dv[3 * MP] = (bf16)(v.y >> 16);
        dv[4 * MP] = (bf16)(v.z & 0xffffu); dv[5 * MP] = (bf16)(v.z >> 16); dv[6 * MP] = (bf16)(v.w & 0xffffu); dv[7 * MP] = (bf16)(v.w >> 16); }
    if (tid < 128) VTs[128 * MP + tid] = 0x3F80;
    sc[(tid >> 7) * 128 + (tid & 127)] = gval;
#pragma unroll
    for (int i = 0; i < 9; ++i) { const int id = tid + 512 * i; if (id < 2 * UROWS * 16) { const int dd = id >= UROWS * 16, q = id - dd * UROWS * 16, e = q >> 4, c8 = (q & 15) * 8;
        *(LAS u32x4*)(Cs + (dd * UROWS + e) * MP + c8) = cb[i]; } }
    unsigned spk[2][8];
#pragma unroll
    for (int tt = 0; tt < 2; ++tt) { f32x16 sraw = zero16();
#pragma unroll
        for (int ks = 0; ks < 8; ++ks) sraw = MFMA32(qf[ks], kf[tt][ks], sraw);
#pragma unroll
        for (int i = 0; i < 8; ++i) spk[tt][i] = cvtpk(sraw[2 * i], sraw[2 * i + 1]); }
    __syncthreads();
    if (wave < 2) { const int dir = wave; float a0, a1, pm0, pm1, bc0, bc1, blast, Mall; int u0, u1;
        chunk_scan(dir, sc + dir * 256, sc + dir * 256 + 128, lane, a0, a1, pm0, pm1, bc0, bc1, blast, Mall, u0, u1);
        const float m = dir ? mst1 : mst0;
        const float rt0 = -fmaxf(m, pm0), rt1 = -fmaxf(m, pm1);
        LAS float* d = s_dir + dir * 512;
        d[u0] = a0; d[u1] = a1; d[128 + u0] = rt0; d[128 + u1] = rt1; d[256 + u0] = __expf(m + rt0); d[256 + u1] = __expf(m + rt1);
        d[384 + u0] = __expf(rt0 - bc0); d[384 + u1] = __expf(rt1 - bc1); }
    f32x16 hs[2]; hs[0] = zero16(); hs[1] = zero16();
#pragma unroll 1
    for (int dir = 0; dir < 2; ++dir) {
        __syncthreads();
        const LAS float* d = s_dir + dir * 512;
        int r = r_; asm volatile("" : "+v"(r));
#pragma unroll
        for (int tt = 0; tt < 2; ++tt) { const int tj = 2 * eh + tt; const bool need = dir ? (tj >= ti) : (tj <= ti);
            if (need) {
                const int scol = 32 * tj + r; const float as = d[scol];
#pragma unroll
                for (int i = 0; i < 16; ++i) { const int trow = 32 * ti + crow(i, h); const bool ok = dir ? (scol >= trow) : (scol <= trow);
                    const float e = ok ? __expf(as + d[128 + trow]) * KSCALE : 0.f;
                    const float sv = (i & 1) ? __uint_as_float(spk[tt][i >> 1] & 0xffff0000u) : __uint_as_float(spk[tt][i >> 1] << 16); Ss[trow * MP + scol] = f2bf(sv * e); } } }
        __syncthreads();
        asm volatile("" ::: "memory");
        const LAS bf16* Cb = Cs + dir * UROWS * MP;
        const int klo = dir ? 32 * ti : 0, khi = dir ? 128 : 32 * (ti + 1);
        const LAS bf16* sp = Ss + (32 * ti + r) * MP + 8 * h;
        {
            f32x16 a1 = zero16(), a2 = zero16();
            const LAS bf16* cpp = Cb + 128 * MP + 8 * h;
#pragma unroll
            for (int ks = 0; ks < 8; ++ks) a1 = MFMA32(qf[ks], *(const LAS bf16x8*)(cpp + 16 * ks), a1);
            const LAS bf16* vp = VTs + 128 * MP + 8 * h;
#pragma unroll 1
            for (int k0 = klo; k0 < khi; k0 += 16) a2 = MFMA32(*(const LAS bf16x8*)(sp + k0), *(const LAS bf16x8*)(vp + k0), a2);
            if (r == 0) {
#pragma unroll
            for (int i = 0; i < 16; ++i) { const int trow = 32 * ti + crow(i, h); sc[trow] = 1.f / fmaxf(fabsf(d[256 + trow] * a1[i] + a2[i]), d[384 + trow]); } }
        }
        asm volatile("" ::: "memory");
#pragma unroll
        for (int tt = 0; tt < 2; ++tt) { const int te = 2 * eh + tt;
            f32x16 a1 = zero16(), a2 = zero16();
            const LAS bf16* cpp = Cb + (32 * te + r) * MP + 8 * h;
#pragma unroll
            for (int ks = 0; ks < 8; ++ks) a1 = MFMA32(qf[ks], *(const LAS bf16x8*)(cpp + 16 * ks), a1);
            const LAS bf16* vp = VTs + (32 * te + r) * MP + 8 * h;
#pragma unroll 1
            for (int k0 = klo; k0 < khi; k0 += 16) a2 = MFMA32(*(const LAS bf16x8*)(sp + k0), *(const LAS bf16x8*)(vp + k0), a2);
#pragma unroll
            for (int i = 0; i < 16; ++i) { const int trow = 32 * ti + crow(i, h); hs[tt][i] += (d[256 + trow] * a1[i] + a2[i]) * sc[trow]; }
            asm volatile("" ::: "memory"); }
    }
#pragma unroll
    for (int i = 0; i < 16; ++i) { float q = hs[0][i] * hs[0][i] + hs[1][i] * hs[1][i];
#pragma unroll
        for (int o = 1; o < 32; o <<= 1) q += __int_as_float(__builtin_amdgcn_ds_bpermute((lane ^ o) << 2, __float_as_int(q)));
        if (r_ == 0) s_ssq[(32 * ti + crow(i, h)) * 2 + eh] = q; }
    __syncthreads();
    LAS float* Hs = (LAS float*)(lds + Y_C);
#pragma unroll
    for (int i = 0; i < 16; ++i) { const int trow = 32 * ti + crow(i, h);
        const float rs = rsqrtf((s_ssq[trow * 2] + s_ssq[trow * 2 + 1]) * (1.f / 128.f) + EPS);
        Hs[trow * 132 + 32 * (2 * eh) + r_] = hs[0][i] * rs; Hs[trow * 132 + 32 * (2 * eh + 1) + r_] = hs[1][i] * rs; }
    __syncthreads();
    const float* gn = p.in[10] + head * 128;
    const int c8o = (tid & 15) * 8;
    const f32x4 g0 = *(const f32x4*)(gn + c8o), g1 = *(const f32x4*)(gn + c8o + 4);
    u32x4 oav[4];
#pragma unroll
    for (int it = 0; it < 4; ++it) { const int row = (tid + 512 * it) >> 4; oav[it] = *(const u32x4*)(QKV + (size_t)(base + row) * NIN0 + 1536 + head * 128 + c8o); }
    asm volatile("" ::: "memory");
#pragma unroll
    for (int it = 0; it < 4; ++it) { const int row = (tid + 512 * it) >> 4; const size_t grow = base + row; const u32x4 oa = oav[it];
        const f32x4 v0 = *(const LAS f32x4*)(Hs + row * 132 + c8o), v1 = *(const LAS f32x4*)(Hs + row * 132 + c8o + 4);
        float o[8]; o[0] = __uint_as_float(oa.x << 16); o[1] = __uint_as_float(oa.x & 0xffff0000u); o[2] = __uint_as_float(oa.y << 16); o[3] = __uint_as_float(oa.y & 0xffff0000u);
        o[4] = __uint_as_float(oa.z << 16); o[5] = __uint_as_float(oa.z & 0xffff0000u); o[6] = __uint_as_float(oa.w << 16); o[7] = __uint_as_float(oa.w & 0xffff0000u);
        u32x4 w;
        w.x = cvtpk(v0[0] * g0[0] / (1.f + __expf(-o[0])), v0[1] * g0[1] / (1.f + __expf(-o[1]))); w.y = cvtpk(v0[2] * g0[2] / (1.f + __expf(-o[2])), v0[3] * g0[3] / (1.f + __expf(-o[3])));
        w.z = cvtpk(v1[0] * g1[0] / (1.f + __expf(-o[4])), v1[1] * g1[1] / (1.f + __expf(-o[5]))); w.w = cvtpk(v1[2] * g1[2] / (1.f + __expf(-o[6])), v1[3] * g1[3] / (1.f + __expf(-o[7])));
        *(u32x4*)(OC + grow * DM + head * 128 + c8o) = w; }
}

template <int D, int MODE, int NSUB>
DI void attn_item(const bf16* QKV, int pitch, int qcol0, int kcol0, const bf16* VT, bf16* O, int ocol0, const float* sink,
                  LAS unsigned char* lds, int item, int tid_in, int lane_in, int wave) {
    (void)tid_in; (void)lane_in;
    int tid = wave * 64 + fresh_lane(); asm volatile("" : "+v"(tid)); const int lane = tid & 63;
    constexpr int KT = 64 * NSUB, KP = D + 8, VP = KT + 4, KBYTES = KT * KP * 2, VBYTES = D * VP * 2, BUF = KBYTES + VBYTES, NPT = NSUB * D / 64, NKS = D / 16, NDT = D / 32, CPR = D / 8, VCR = 8 * NSUB;
    static_assert(2 * BUF <= LDS_BYTES - 16, "attention LDS");
    const int r = lane & 31, h = lane >> 5;
    int b, kvh, head, qrow, qpos = 0, nt, wstart = 0;
    if (MODE == 0) { const int qb = item & 15; head = (item >> 4) & 7; b = item >> 7; kvh = head >> 2; qrow = NCTX + b * SEQ + qb * 256 + 32 * wave; nt = KVLEN / KT; }
    else if (MODE == 1) { const int nb = item & 31, hp = (item >> 5) & 1; kvh = (item >> 6) & 1; b = item >> 7; head = kvh * 4 + hp * 2 + (wave >> 2);
        qpos = nb * 128 + (wave & 3) * 32 + r; qrow = NCTX + b * SEQ + nb * 128 + (wave & 3) * 32;
        wstart = nb > 0 ? (nb - 1) * 128 : 0; const int wend = nb < 31 ? (nb + 2) * 128 : SEQ; nt = (CTXL + wend - wstart) / KT; }
    else { const int qh = item & 1, hp = (item >> 1) & 1; kvh = (item >> 2) & 1; b = item >> 3; head = kvh * 4 + hp * 2 + (wave >> 2); qrow = b * 256 + qh * 128 + (wave & 3) * 32; nt = CTXL / KT; }
    const bf16* VTb = VT + (size_t)(b * 2 + kvh) * D * KVLEN;
    const int kcol = kcol0 + kvh * D;
    bf16x8 qf[NKS];
    { const bf16* qp = QKV + (size_t)(qrow + r) * pitch + qcol0 + head * D + 8 * h;
#pragma unroll
        for (int ks = 0; ks < NKS; ++ks) qf[ks] = *(const bf16x8*)(qp + 16 * ks); }
    const float scl = (D == 64 ? 0.125f : 0.08838834764831845f) * LOG2E;
    constexpr float THR2 = 11.0f;
    float mrun, lrun;
    if (MODE == 0) { mrun = -INFINITY; lrun = 0.f; } else { mrun = sink[head] * LOG2E; lrun = h == 0 ? 1.f : 0.f; }
    f32x16 o[NDT];
#pragma unroll
    for (int dt = 0; dt < NDT; ++dt) o[dt] = zero16();
    u32x4 kr[NPT], vr[NPT];
#define ATT_TILE(t, krow0, vkey0) do { const int key0 = KT * (t); if (MODE == 0) { krow0 = key0 < CTXL ? b * CTXL + key0 : NCTX + b * SEQ + key0 - CTXL; vkey0 = key0; } \
        else if (key0 < CTXL) { krow0 = b * CTXL + key0; vkey0 = key0; } else { const int kp_ = wstart + key0 - CTXL; krow0 = NCTX + b * SEQ + kp_; vkey0 = CTXL + kp_; } } while (0)
#define ATT_LOAD(t) do { int krow0, vkey0; ATT_TILE(t, krow0, vkey0); _Pragma("unroll") for (int i = 0; i < NPT; ++i) { const int id = tid + 512 * i; \
        kr[i] = *(const u32x4*)(QKV + (size_t)(krow0 + id / CPR) * pitch + kcol + (id % CPR) * 8); \
        vr[i] = *(const u32x4*)(VTb + (size_t)(id / VCR) * KVLEN + vkey0 + (id % VCR) * 8); } } while (0)
#define ATT_STORE(bi) do { LAS bf16* Kd = (LAS bf16*)(lds + (bi) * BUF); LAS bf16* Vd = (LAS bf16*)(lds + (bi) * BUF + KBYTES); _Pragma("unroll") for (int i = 0; i < NPT; ++i) { const int id = tid + 512 * i; \
        *(LAS u32x4*)(Kd + (id / CPR) * KP + (id % CPR) * 8) = kr[i]; { LAS u32x2* vd_ = (LAS u32x2*)(Vd + (id / VCR) * VP + (id % VCR) * 8); vd_[0] = (u32x2){vr[i].x, vr[i].y}; vd_[1] = (u32x2){vr[i].z, vr[i].w}; } } } while (0)
    ATT_LOAD(0); ATT_STORE(0);
    __syncthreads();
    for (int t = 0; t < nt; ++t) {
        if (t + 1 < nt) ATT_LOAD(t + 1);
        const LAS bf16* Kt = (const LAS bf16*)(lds + (t & 1) * BUF); const LAS bf16* Vt = (const LAS bf16*)(lds + (t & 1) * BUF + KBYTES);
#pragma unroll
        for (int sub = 0; sub < NSUB; ++sub) {
        f32x16 s[2];
#pragma unroll
        for (int q = 0; q < 2; ++q) { s[q] = zero16(); const LAS bf16* kp = Kt + (64 * sub + 32 * q + r) * KP + 8 * h;
#pragma unroll
            for (int ks = 0; ks < NKS; ++ks) s[q] = MFMA32(*(const LAS bf16x8*)(kp + 16 * ks), qf[ks], s[q]); }
        if (MODE == 1 && KT * t >= CTXL) { const int kp0 = wstart + KT * t + 64 * sub - CTXL - qpos;
#pragma unroll
            for (int q = 0; q < 2; ++q)
#pragma unroll
                for (int i = 0; i < 16; ++i) { const int d0 = kp0 + 32 * q + crow(i, h); if (d0 > 128 || d0 < -128) s[q][i] = -INFINITY; } }
        float mx = s[0][0];
#pragma unroll
        for (int q = 0; q < 2; ++q)
#pragma unroll
            for (int i = 0; i < 16; ++i) mx = fmaxf(mx, s[q][i]);
        mx = fmaxf(mx, __shfl_xor(mx, 32)) * scl;
        if (!__all(mx - mrun <= THR2)) {
            const float mnew = fmaxf(mrun, mx), alpha = __builtin_amdgcn_exp2f(mrun - mnew);
            lrun *= alpha; mrun = mnew;
#pragma unroll
            for (int dt = 0; dt < NDT; ++dt)
#pragma unroll
                for (int i = 0; i < 16; ++i) o[dt][i] *= alpha;
        }
        float ls = 0.f; const float nm = -mrun;
#pragma unroll
        for (int q = 0; q < 2; ++q)
#pragma unroll
            for (int i = 0; i < 16; ++i) { s[q][i] = __builtin_amdgcn_exp2f(fmaf(s[q][i], scl, nm)); ls += s[q][i]; }
        lrun += ls;
#pragma unroll
        for (int q = 0; q < 2; ++q)
#pragma unroll
            for (int s2 = 0; s2 < 2; ++s2) {
                u32x4 pw; pw.x = cvtpk(s[q][8 * s2], s[q][8 * s2 + 1]); pw.y = cvtpk(s[q][8 * s2 + 2], s[q][8 * s2 + 3]); pw.z = cvtpk(s[q][8 * s2 + 4], s[q][8 * s2 + 5]); pw.w = cvtpk(s[q][8 * s2 + 6], s[q][8 * s2 + 7]);
                const bf16x8 pb = __builtin_bit_cast(bf16x8, pw);
#pragma unroll
                for (int dt = 0; dt < NDT; ++dt) { const LAS bf16* vp = Vt + (32 * dt + r) * VP + 64 * sub + 32 * q + 16 * s2 + 4 * h;
                    const s16x4 lo = *(const LAS s16x4*)vp, hi = *(const LAS s16x4*)(vp + 8);
                    const bf16x8 a = __builtin_shufflevector(lo, hi, 0, 1, 2, 3, 4, 5, 6, 7);
                    o[dt] = MFMA32(a, pb, o[dt]); }
            }
        }
        if (t + 1 < nt) ATT_STORE((t + 1) & 1);
        __syncthreads();
    }
#undef ATT_TILE
#undef ATT_LOAD
#undef ATT_STORE
    const float inv = 1.f / (lrun + __shfl_xor(lrun, 32));
    bf16* op = O + (size_t)(qrow + r) * DM + ocol0 + head * D + 4 * h;
#pragma unroll
    for (int dt = 0; dt < NDT; ++dt)
#pragma unroll
        for (int g = 0; g < 4; ++g) { u32x2 w; w.x = cvtpk(o[dt][4 * g] * inv, o[dt][4 * g + 1] * inv); w.y = cvtpk(o[dt][4 * g + 2] * inv, o[dt][4 * g + 3] * inv);
            *(u32x2*)(op + 32 * dt + 8 * g) = w; }
}


namespace adb {
using bf16 = unsigned short;
using bf16x8 = __attribute__((ext_vector_type(8))) short;
using s16x4  = __attribute__((ext_vector_type(4))) short;
using f32x16 = __attribute__((ext_vector_type(16))) float;
using u32x4  = __attribute__((ext_vector_type(4))) unsigned;
using ::crow; using ::cvtpk;
constexpr int   D = 128, NW = 8, QBLK = 32, KVBLK = 64;
constexpr float SCALE = 0.088388347648318440f;
constexpr float THR = 8.f;
constexpr int SDEPTH = 2;
constexpr int LDQ = 1536, LDK = 128, LDO = 1024;
constexpr size_t SHM_V = KVBLK * D * 2, SHM_K = KVBLK * D * 2, SHM_ATTN = 2 * SHM_V + 2 * SHM_K + NW * 64 * 4;
#define KSWZ(row, colB) ((row) * 256 + ((colB) ^ (((row) & 7) << 4)))
#define SBAR() __builtin_amdgcn_sched_barrier(0)
template <typename TIn> struct Stage;
template <> struct Stage<bf16>  { using T = bf16x8;
  __device__ static __forceinline__ T ld8(const bf16* p) { return *reinterpret_cast<const bf16x8*>(p); }
  __device__ static __forceinline__ bf16x8 tobf(T x) { return x; } };

__device__ __forceinline__ void partialSM(f32x16& p0, f32x16& p1, float& m_reg, float& mn, float& alpha) {
  constexpr float C = SCALE * 1.4426950408889634f;
  float pmax = p0[0]; for (int r = 1; r < 16; ++r) pmax = fmaxf(pmax, p0[r]); for (int r = 0; r < 16; ++r) pmax = fmaxf(pmax, p1[r]);
  { auto rr = __builtin_amdgcn_permlane32_swap(__float_as_uint(pmax), __float_as_uint(pmax), false, false);
    pmax = fmaxf(__uint_as_float(rr[0]), __uint_as_float(rr[1])); }
  if (__builtin_expect(__all(pmax - m_reg <= THR / SCALE), 1)) { mn = m_reg; alpha = 1.f; }
  else { mn = fmaxf(m_reg, pmax); alpha = __builtin_amdgcn_exp2f((m_reg - mn) * C); m_reg = mn; }
  float mnC = -mn * C;
  for (int r = 0; r < 16; ++r) p0[r] = fmaf(p0[r], C, mnC); for (int r = 0; r < 16; ++r) p1[r] = fmaf(p1[r], C, mnC);
  for (int r = 0; r < 16; ++r) p0[r] = __builtin_amdgcn_exp2f(p0[r]);
}
__device__ __forceinline__ void finishSM(f32x16& p0, f32x16& p1, float alpha, float& l_reg, bf16x8& pa0, bf16x8& pa1, bf16x8& pa2, bf16x8& pa3) {
  for (int r = 0; r < 16; ++r) p1[r] = __builtin_amdgcn_exp2f(p1[r]);
  float ps = 0; for (int r = 0; r < 16; ++r) ps += p0[r]; for (int r = 0; r < 16; ++r) ps += p1[r];
  { auto rr = __builtin_amdgcn_permlane32_swap(__float_as_uint(ps), __float_as_uint(ps), false, false);
    ps = __uint_as_float(rr[0]) + __uint_as_float(rr[1]); }
  l_reg = l_reg * alpha + ps;
#define PK4(P, BASE, OUT) do { unsigned a0 = cvtpk(P[BASE + 0], P[BASE + 1]), a1 = cvtpk(P[BASE + 2], P[BASE + 3]);   \
    unsigned b0 = cvtpk(P[BASE + 4], P[BASE + 5]), b1 = cvtpk(P[BASE + 6], P[BASE + 7]);                              \
    auto r0 = __builtin_amdgcn_permlane32_swap(a0, b0, false, false); auto r1 = __builtin_amdgcn_permlane32_swap(a1, b1, false, false); \
    u32x4 w = {r0[0], r1[0], r0[1], r1[1]}; OUT = *reinterpret_cast<bf16x8*>(&w); } while (0)
  PK4(p0, 0, pa0); PK4(p0, 8, pa1); PK4(p1, 0, pa2); PK4(p1, 8, pa3);
#undef PK4
}
__device__ __forceinline__ void qkt(f32x16& p0, f32x16& p1, const bf16* Ks, const bf16x8* qr, int r32, int hi) {
  p0 = f32x16{}; p1 = f32x16{};
  for (int d0 = 0; d0 < 8; ++d0) { int cb = (d0 * 16 + hi * 8) * 2;
    bf16x8 b0 = *reinterpret_cast<const bf16x8*>((const char*)Ks + KSWZ(r32, cb));
    bf16x8 b1 = *reinterpret_cast<const bf16x8*>((const char*)Ks + KSWZ(32 + r32, cb));
    p0 = __builtin_amdgcn_mfma_f32_32x32x16_bf16(b0, qr[d0], p0, 0, 0, 0);
    p1 = __builtin_amdgcn_mfma_f32_32x32x16_bf16(b1, qr[d0], p1, 0, 0, 0); }
}
__device__ __forceinline__ int v_st(int k, int c) { const int kk = (k & ~0xC) | ((k & 4) << 1) | ((k & 8) >> 1); return ((kk >> 3) * 4 + (c >> 5)) * 512 + ((kk & 7) * 32 + (c & 31)) * 2; }
__device__ __forceinline__ int v_rd_base(int lane) { return ((lane & 3) << 3) | (((lane >> 2) & 3) << 6) | (((lane >> 4) & 1) << 5) | (((lane >> 5) & 1) << 8); }
constexpr int v_rd_off(int d0, int ks, int half) { return d0 * 512 + ks * 4096 + half * 2048; }
template <int OFF> __device__ __forceinline__ s16x4 tr_read(int vb) {
  s16x4 r; asm volatile("ds_read_b64_tr_b16 %0, %1 offset:%2" : "=&v"(r) : "v"(vb), "i"(OFF) : "memory"); return r;
}
template <int D0> __device__ __forceinline__ void pv_one(f32x16& od, int vb, bf16x8 pa0, bf16x8 pa1, bf16x8 pa2, bf16x8 pa3) {
  const s16x4 l0 = tr_read<v_rd_off(D0, 0, 0)>(vb), h0 = tr_read<v_rd_off(D0, 0, 1)>(vb), l1 = tr_read<v_rd_off(D0, 1, 0)>(vb), h1 = tr_read<v_rd_off(D0, 1, 1)>(vb);
  const s16x4 l2 = tr_read<v_rd_off(D0, 2, 0)>(vb), h2 = tr_read<v_rd_off(D0, 2, 1)>(vb), l3 = tr_read<v_rd_off(D0, 3, 0)>(vb), h3 = tr_read<v_rd_off(D0, 3, 1)>(vb);
  asm volatile("s_waitcnt lgkmcnt(0)" ::: "memory"); SBAR();
#define PK(L, H) (bf16x8){L[0], L[1], L[2], L[3], H[0], H[1], H[2], H[3]}
  od = __builtin_amdgcn_mfma_f32_32x32x16_bf16(pa0, PK(l0, h0), od, 0, 0, 0);
  od = __builtin_amdgcn_mfma_f32_32x32x16_bf16(pa1, PK(l1, h1), od, 0, 0, 0);
  od = __builtin_amdgcn_mfma_f32_32x32x16_bf16(pa2, PK(l2, h2), od, 0, 0, 0);
  od = __builtin_amdgcn_mfma_f32_32x32x16_bf16(pa3, PK(l3, h3), od, 0, 0, 0);
#undef PK
}
__device__ __forceinline__ void pv_d0(f32x16* o, int vb, bf16x8 pa0, bf16x8 pa1, bf16x8 pa2, bf16x8 pa3) {
  pv_one<0>(o[0], vb, pa0, pa1, pa2, pa3); pv_one<1>(o[1], vb, pa0, pa1, pa2, pa3); pv_one<2>(o[2], vb, pa0, pa1, pa2, pa3); pv_one<3>(o[3], vb, pa0, pa1, pa2, pa3);
}

template <typename TQ>
__device__ __forceinline__ void attn_dense_body(const TQ* __restrict__ Qb, const bf16* __restrict__ Kh, const bf16* __restrict__ Vh,
                                                bf16* __restrict__ Ob, int seq, char* lds, const int tid) {
  using St = Stage<bf16>; using SQ = Stage<TQ>;
  const int wid = __builtin_amdgcn_readfirstlane(tid >> 6), lane = tid & 63, r32 = lane & 31, hi = lane >> 5;
  bf16* V_lds = (bf16*)lds; bf16* K_lds = (bf16*)(lds + 2 * SHM_V);
  float* ws = (float*)(lds + 2 * SHM_V + 2 * SHM_K) + wid * 64; float* li_l = ws; float* al_l = ws + 32;
  float m_reg = -1e30f, l_reg = 0; f32x16 o[4] = {}; bf16x8 qr[8];
  const TQ* Qw = Qb + (long)(wid * QBLK + r32) * LDQ + hi * 8;
#pragma unroll
  for (int d0 = 0; d0 < 8; ++d0) qr[d0] = SQ::tobf(SQ::ld8(Qw + d0 * 16));
  const int sr = tid >> 4, sc = (tid & 15) * 8, vst0 = v_st(sr, sc), vst1 = v_st(32 + sr, sc);
  const int vb0 = (int)(uintptr_t)V_lds + v_rd_base(lane);
  struct { typename St::T vs0, vs1, ks0, ks1; } sr_[SDEPTH];
#define SLOAD(i, k0) do { sr_[i].vs0 = St::ld8(&Vh[(long)((k0) + sr) * LDK + sc]); sr_[i].vs1 = St::ld8(&Vh[(long)((k0) + 32 + sr) * LDK + sc]); \
    sr_[i].ks0 = St::ld8(&Kh[(long)((k0) + sr) * LDK + sc]); sr_[i].ks1 = St::ld8(&Kh[(long)((k0) + 32 + sr) * LDK + sc]); } while (0)
#define SWRITE(b, i) do { *(bf16x8*)((char*)V_lds + (b) * SHM_V + vst0) = St::tobf(sr_[i].vs0);          \
    *(bf16x8*)((char*)V_lds + (b) * SHM_V + vst1) = St::tobf(sr_[i].vs1); int kc = sc * 2;               \
    *(bf16x8*)((char*)K_lds + (b) * SHM_K + KSWZ(sr, kc)) = St::tobf(sr_[i].ks0);                       \
    *(bf16x8*)((char*)K_lds + (b) * SHM_K + KSWZ(32 + sr, kc)) = St::tobf(sr_[i].ks1); } while (0)
#define SWAIT() do { if constexpr (SDEPTH == 2) asm volatile("s_waitcnt vmcnt(4)" ::: "memory"); else asm volatile("s_waitcnt vmcnt(0)" ::: "memory"); } while (0)
#define RESC(a) do { if (__any((a) < 1.f)) { if (hi == 0) al_l[r32] = (a); asm volatile("s_waitcnt lgkmcnt(0)" ::: "memory"); \
    for (int d = 0; d < 4; ++d) for (int r = 0; r < 16; ++r) o[d][r] *= al_l[crow(r, hi)]; } } while (0)
  f32x16 pA0, pA1, pB0, pB1; float mnA, mnB, alA, alB; bf16x8 pa0, pa1, pa2, pa3; const int NT = seq / KVBLK;
  constexpr int SE = 0, SO = SDEPTH - 1;
  SLOAD(SE, 0); asm volatile("s_waitcnt vmcnt(0)" ::: "memory"); SWRITE(0, SE); __syncthreads();
  qkt(pA0, pA1, K_lds, qr, r32, hi); partialSM(pA0, pA1, m_reg, mnA, alA);
  SLOAD(SO, KVBLK); if constexpr (SDEPTH == 2) { if (2 < NT) SLOAD(SE, 2 * KVBLK); }
  SWAIT(); SWRITE(1, SO); __syncthreads();
  for (int j = 1; j + 1 < NT; j += 2) {
    SBAR(); qkt(pB0, pB1, (bf16*)((char*)K_lds + SHM_K), qr, r32, hi);
    finishSM(pA0, pA1, alA, l_reg, pa0, pa1, pa2, pa3); SBAR();
    SLOAD(SO, (j + SDEPTH) * KVBLK); SBAR();
    pv_d0(o, vb0, pa0, pa1, pa2, pa3); partialSM(pB0, pB1, m_reg, mnB, alB);
    __syncthreads(); SWAIT(); SWRITE(0, SE);
    RESC(alB); __syncthreads();
    SBAR(); qkt(pA0, pA1, K_lds, qr, r32, hi);
    finishSM(pB0, pB1, alB, l_reg, pa0, pa1, pa2, pa3); SBAR();
    if (SDEPTH == 1 || j + 3 < NT) SLOAD(SE, (j + 1 + SDEPTH) * KVBLK); SBAR();
    pv_d0(o, vb0 + (int)SHM_V, pa0, pa1, pa2, pa3); partialSM(pA0, pA1, m_reg, mnA, alA);
    __syncthreads(); SWAIT(); SWRITE(1, SO);
    RESC(alA); __syncthreads();
  }
  SBAR(); qkt(pB0, pB1, (bf16*)((char*)K_lds + SHM_K), qr, r32, hi);
  finishSM(pA0, pA1, alA, l_reg, pa0, pa1, pa2, pa3); SBAR();
  pv_d0(o, vb0, pa0, pa1, pa2, pa3); partialSM(pB0, pB1, m_reg, mnB, alB);
  __syncthreads(); RESC(alB);
  finishSM(pB0, pB1, alB, l_reg, pa0, pa1, pa2, pa3); SBAR();
  pv_d0(o, vb0 + (int)SHM_V, pa0, pa1, pa2, pa3);
  if (hi == 0) li_l[r32] = l_reg; asm volatile("s_waitcnt lgkmcnt(0)" ::: "memory");
  float rli[16];
#pragma unroll
  for (int r = 0; r < 16; ++r) rli[r] = __builtin_amdgcn_rcpf(li_l[crow(r, hi)]);
  bf16* Ow = Ob + (long)(wid * QBLK) * LDO;
#pragma unroll
  for (int r = 0; r < 16; ++r) { int orow = crow(r, hi);
    for (int d0 = 0; d0 < 4; ++d0) Ow[(long)orow * LDO + d0 * 32 + r32] = (bf16)(::cvtpk(o[d0][r] * rli[r], 0.f) & 0xffffu); }
#undef SLOAD
#undef SWRITE
#undef SWAIT
#undef RESC
}
#undef SBAR
#undef KSWZ
}

DI void phase_mlstm_out(const Params& p, int lane, int wave) {
    const bf16* QKV = (const bf16*)(p.ws + WS_BIG); bf16* OC = (bf16*)(p.ws + WS_OCAT); const float* XC = (const float*)(p.ws + WS_XC);
    const float* gn = p.in[10];
    const int gw = blockIdx.x * 8 + wave, NGW = gridDim.x * 8;
    for (int row = gw; row < MTOT; row += NGW) {
        const float* hp = row < NCTX ? XC + (size_t)row * DM : p.out + (size_t)(row - NCTX) * DM;
        const bf16* oa = QKV + (size_t)row * NIN0 + 1536;
        bf16* dst = OC + (size_t)row * DM;
#pragma unroll
        for (int hd = 0; hd < 4; ++hd) { const int c0 = hd * 128 + lane, c1 = c0 + 64;
            const float v0 = hp[c0] + hp[512 + c0], v1 = hp[c1] + hp[512 + c1];
            const float rs = rsqrtf(wave_sum(v0 * v0 + v1 * v1) * (1.f / 128.f) + EPS);
            const float o0 = bf2f(oa[c0]), o1 = bf2f(oa[c1]);
            dst[c0] = f2bf(v0 * rs * gn[c0] / (1.f + __expf(-o0))); dst[c1] = f2bf(v1 * rs * gn[c1] / (1.f + __expf(-o1))); }
    }
}


#define XB_TMO      128
#define XB_XCNT(j)  (256  + 64 * (j))
#define XB_XSUB(j)  (1280 + 64 * (j))
#define XB_XGEN(j)  (2304 + 64 * (j))
#define XB_TOP      3328
#define XB_TOPGEN   3392
#define XCD_BAR_WORDS 3456
#define XB_SPIN_CAP (1u << 18)
DI unsigned xb_ld(unsigned* p)              { return __hip_atomic_load(p, __ATOMIC_RELAXED, __HIP_MEMORY_SCOPE_AGENT); }
DI unsigned xb_add(unsigned* p, unsigned v) { return __hip_atomic_fetch_add(p, v, __ATOMIC_RELAXED, __HIP_MEMORY_SCOPE_AGENT); }
DI unsigned xb_xcc_id() { return (unsigned)__builtin_amdgcn_s_getreg((3 << 11) | 20) & 0xFu; }
#define XB_SPIN(cond, bar) do { unsigned _sp = 0; while (cond) { __builtin_amdgcn_s_sleep(1); \
    if ((++_sp & 255u) == 0u) { if (xb_ld(&(bar)[XB_TMO])) break; if (_sp > XB_SPIN_CAP) { atomicAdd(&(bar)[XB_TMO], 1u); break; } } } } while (0)
struct XcdBarrier { unsigned* bar; unsigned x; volatile LAS unsigned* st; };
DI XcdBarrier xcd_barrier_post(unsigned* bar, volatile LAS unsigned* st, int tid) {
    XcdBarrier b; b.bar = bar; b.x = xb_xcc_id(); b.st = st;
    if (tid == 0) (void)xb_add(&bar[XB_XCNT(b.x)], 1u);
    return b;
}
DI void xcd_barrier_complete(unsigned* bar, unsigned x, unsigned& nloc, unsigned& nx) {
    const unsigned G = gridDim.x * gridDim.y * gridDim.z;
    unsigned sum, cnt, mine, sp = 0u;
    for (;;) {
        sum = 0u; cnt = 0u; mine = 0u;
#pragma unroll
        for (unsigned j = 0; j < 16; ++j) { const unsigned c = xb_ld(&bar[XB_XCNT(j)]); sum += c; cnt += (c > 0u) ? 1u : 0u; mine = (j == x) ? c : mine; }
        if (sum == G) break;
        __builtin_amdgcn_s_sleep(1);
        if ((++sp & 255u) == 0u) { if (xb_ld(&bar[XB_TMO])) break; if (sp > XB_SPIN_CAP) { atomicAdd(&bar[XB_TMO], 1u); break; } }
    }
    nloc = mine > 0u ? mine : 1u; nx = cnt > 0u ? cnt : 1u;
}
DI void xcd_barrier(const XcdBarrier& b, int tid) {
    asm volatile("s_waitcnt vmcnt(0)" ::: "memory");
    __syncthreads();
    if (tid == 0) {
        unsigned* bar = b.bar;
        __builtin_amdgcn_s_waitcnt(0);
        unsigned nloc = b.st[0], nx = b.st[1];
        if (nloc == 0u) { xcd_barrier_complete(bar, b.x, nloc, nx); b.st[0] = nloc; b.st[1] = nx; }
        const unsigned old = xb_add(&bar[XB_XSUB(b.x)], 1u);
        const unsigned gen = old / nloc;
        if (old + 1u == (gen + 1u) * nloc) {
            __builtin_amdgcn_fence(__ATOMIC_RELEASE, "agent");
            asm volatile("s_waitcnt vmcnt(0)" ::: "memory");
            const unsigned og = xb_add(&bar[XB_TOP], 1u);
            const unsigned tg = og / nx;
            if (og + 1u == (tg + 1u) * nx) xb_add(&bar[XB_TOPGEN], 1u);
            else XB_SPIN(xb_ld(&bar[XB_TOPGEN]) == tg, bar);
            __builtin_amdgcn_fence(__ATOMIC_ACQUIRE, "agent");
            xb_add(&bar[XB_XGEN(b.x)], 1u);
            asm volatile("s_waitcnt vmcnt(0)" ::: "memory");
        } else {
            XB_SPIN(xb_ld(&bar[XB_XGEN(b.x)]) == gen, bar);
            __builtin_amdgcn_fence(__ATOMIC_ACQUIRE, "agent");
            asm volatile("s_waitcnt vmcnt(0)" ::: "memory");
        }
    }
    __syncthreads();
}
DI void sub_barrier(unsigned* cnt, unsigned n, int tid) {
    asm volatile("s_waitcnt vmcnt(0)" ::: "memory");
    __syncthreads();
    if (tid == 0) {
        __builtin_amdgcn_fence(__ATOMIC_RELEASE, "agent");
        asm volatile("s_waitcnt vmcnt(0)" ::: "memory");
        (void)xb_add(cnt, 1u);
        unsigned sp = 0u; while (xb_ld(cnt) < n) { __builtin_amdgcn_s_sleep(1); if (++sp > (1u << 22)) break; }
        __builtin_amdgcn_fence(__ATOMIC_ACQUIRE, "agent");
        asm volatile("s_waitcnt vmcnt(0)" ::: "memory");
    }
    __syncthreads();
}
#ifndef REP_X1
#define REP_X1 1
#endif
#ifndef REP_X2
#define REP_X2 1
#endif
#ifndef REP_X3
#define REP_X3 1
#endif
#ifndef REP_SYNC
#define REP_SYNC 1
#endif
#ifndef REP_ATTNC
#define REP_ATTNC 1
#endif
#ifndef REP_MLSTM
#define REP_MLSTM 1
#endif
#ifndef REP_SWA
#define REP_SWA 1
#endif
#ifndef REP_UP1
#define REP_UP1 1
#endif
#ifndef REP_NORM
#define REP_NORM 1
#endif
#ifndef REP_PROL
#define REP_PROL 1
#endif
#define GSYNC() do { FRESH_IDS(); for (int s_ = 0; s_ < REP_SYNC; ++s_) xcd_barrier(xbar, tid); } while (0)
__global__ void __launch_bounds__(512, 2) fwd_kernel(Params p) {
    extern __shared__ __attribute__((aligned(16))) unsigned char lds_raw[];
    LAS unsigned char* lds = (LAS unsigned char*)lds_raw;
    cg::grid_group grid = cg::this_grid();
#define FRESH_IDS() int tid_ = wave_s * 64 + fresh_lane(); asm volatile("" : "+v"(tid_)); const int tid = tid_, lane = tid & 63, wave = wave_s; (void)tid; (void)lane; (void)wave
#define run_gemm(...) run_gemm_rng_(__VA_ARGS__, (int)gridDim.x, (int)blockIdx.x, 0, 0x7fffffff, tid)
#define run_gemm_gc(...) run_gemm_rng_(__VA_ARGS__, 0, 0x7fffffff, tid)
#define run_gemm_rng(...) run_gemm_rng_(__VA_ARGS__, tid)
    const int wave_s = __builtin_amdgcn_readfirstlane((int)threadIdx.x >> 6);
    unsigned char* ws = p.ws;
    bf16* WIN0 = (bf16*)(ws + WS_WIN0); bf16* WOUT0 = (bf16*)(ws + WS_WOUT0); bf16* WIN1 = (bf16*)(ws + WS_WIN1); bf16* WOUT1 = (bf16*)(ws + WS_WOUT1);
    bf16* W1 = (bf16*)(ws + WS_W1); bf16* W2 = (bf16*)(ws + WS_W2);
    const float* MOD0 = (const float*)(ws + WS_MOD); const float* MOD1 = MOD0 + 9 * NMODC;
    float* XC = (float*)(ws + WS_XC); bf16* VT = (bf16*)(ws + WS_VT); bf16* H = (bf16*)(ws + WS_H); bf16* OC = (bf16*)(ws + WS_OCAT); bf16* BIG = (bf16*)(ws + WS_BIG);
    const float* x = p.in[0]; const float* ctx = p.in[2];

    unsigned* barw = (unsigned*)(ws + WS_BAR);
    volatile LAS unsigned* bst = (volatile LAS unsigned*)(lds + LDS_BYTES - 16);
    { FRESH_IDS();
      if (tid < 2) bst[tid] = 0u;
      if (blockIdx.x == 0) for (int i = tid; i < 4096; i += 512) barw[i] = 0u; }
    for (int rep_ = 0; rep_ < REP_PROL; ++rep_) { FRESH_IDS();
        phase_prologue(p, lds, tid, lane, wave);
    }
    grid.sync();
    XcdBarrier xbar; { FRESH_IDS(); xbar = xcd_barrier_post(barw, bst, tid); }
    float* RSS = (float*)(ws + WS_RSS); const float* BIAS = (const float*)(ws + WS_BIAS);
    for (int rep_ = 0; rep_ < REP_NORM; ++rep_) { FRESH_IDS(); __syncthreads();
        phase_norm<false>(p, lds, ctx, x, p.in[6], MOD0, 0, H, 0, MTOT, tid, lane, wave);
        phase_bias(p, lane, wave, 0, 4096 + 1536, (int)blockIdx.x, (int)gridDim.x);
    }
    GSYNC();
    { FRESH_IDS();
        run_gemm(lds, H, WIN0, MTOT, NIN0, DM, EpiStore<0>{BIG, NIN0});
        phase_gates(p, lds, H, tid, lane, wave, (int)blockIdx.x, (int)gridDim.x);
    }
    GSYNC();
    for (int rep_ = 0; rep_ < REP_MLSTM; ++rep_) {
    { FRESH_IDS();
        if (rep_ == 0) phase_post<64>(BIG, NIN0, 2048, 8, 2560, 2, 2688, p.in[11], p.in[12], VT, true, lds, tid, lane, wave);
        for (int rx_ = 0; rx_ < REP_X1; ++rx_) for (int item = blockIdx.x; item < 32 * NCH; item += gridDim.x) mlstm_x1(p, lds, item, tid, lane, wave);
    }
    GSYNC();
    { FRESH_IDS();
        const int G_ = (int)gridDim.x, nx3 = 32 * NCH, heavy = nx3 % G_, SWA_N = 1024 + 64;
        const int SWA_B = (heavy > 0 && G_ > heavy) ? 2 * (G_ - heavy) : 0, SWA_A = SWA_B < SWA_N ? SWA_N - SWA_B : SWA_N;
        if (((int)blockIdx.x & 1) == 0) for (int rx_ = 0; rx_ < REP_X2; ++rx_) mlstm_x2(p, tid);
        for (int rep_s = 0; rep_s < REP_SWA; ++rep_s)
        for (int item = (int)blockIdx.x; item < SWA_A; item += G_) {
            if (item < 1024) attn_item<64, 1, 2>(BIG, NIN0, 2048, 2560, VT, OC, 512, p.in[13], lds, item, tid, lane, wave);
            else attn_item<64, 2, 2>(BIG, NIN0, 2048, 2560, VT, OC, 512, p.in[13], lds, item - 1024, tid, lane, wave);
        }
        if (((int)blockIdx.x & 1) == 1) for (int rx_ = 0; rx_ < REP_X2; ++rx_) mlstm_x2(p, tid);
    }
    GSYNC();
    { FRESH_IDS();
        for (int rx_ = 0; rx_ < REP_X3; ++rx_) for (int item = blockIdx.x; item < 32 * NCH; item += gridDim.x) mlstm_x3(p, lds, item, tid, lane, wave);
        const int G_ = (int)gridDim.x, nx3 = 32 * NCH, heavy = nx3 % G_, SWA_N = 1024 + 64;
        const int SWA_B = (heavy > 0 && G_ > heavy) ? 2 * (G_ - heavy) : 0, SWA_A = SWA_B < SWA_N ? SWA_N - SWA_B : SWA_N;
        if (SWA_A < SWA_N && (int)blockIdx.x >= heavy)
            for (int item = SWA_A + (int)blockIdx.x - heavy; item < SWA_N; item += G_ - heavy) {
                if (item < 1024) attn_item<64, 1, 2>(BIG, NIN0, 2048, 2560, VT, OC, 512, p.in[13], lds, item, tid, lane, wave);
                else attn_item<64, 2, 2>(BIG, NIN0, 2048, 2560, VT, OC, 512, p.in[13], lds, item - 1024, tid, lane, wave);
            }
    }
    }
    GSYNC();
    { FRESH_IDS();
        run_gemm(lds, OC + (size_t)NCTX * DM, WOUT0, NLAT, DM, DM, EpiResidN{ctx, x, XC, p.out, MOD0, 2, NCTX, p.in[7], MOD0, 3, H, RSS});
    }
    GSYNC();
    { FRESH_IDS();
        const int NG1 = 32, bid = (int)blockIdx.x, G = (int)gridDim.x;
        const EpiStoreN<1> eup{BIG + (size_t)NCTX * DFF, DFF, RSS, BIAS, NCTX};
        if (bid < NG1) {
            run_gemm_gc(lds, OC, WOUT0, NCTX, DM, DM, EpiResidN{ctx, x, XC, p.out, MOD0, 2, 0, p.in[7], MOD0, 3, H, RSS}, NG1, bid);
            sub_barrier(barw + 3584, NG1, tid);
            run_gemm_gc(lds, H, W1, NCTX, DFF, DM, EpiStoreN<1>{BIG, DFF, RSS, BIAS, 0}, NG1, bid);
            run_gemm_rng(lds, H + (size_t)NCTX * DM, W1, NLAT, DFF, DM, eup, NG1, bid, 0, 96);
        } else {
            run_gemm_rng(lds, H + (size_t)NCTX * DM, W1, NLAT, DFF, DM, eup, G - NG1, bid - NG1, 96, 0x7fffffff);
        }
    }
    GSYNC();
    bf16* BIG1 = BIG + (size_t)16 * 1024 * 1024;
    const int GC = 32;
    { FRESH_IDS();
        run_gemm(lds, BIG + (size_t)NCTX * DFF, W2, NLAT, DM, DFF, EpiResidN{XC, p.out, XC, p.out, MOD0, 5, NCTX, p.in[6] + DM, MOD1, 0, H, RSS + MTOT});
    }
    GSYNC();
    { FRESH_IDS();
        if ((int)blockIdx.x < GC) run_gemm_gc(lds, BIG, W2, NCTX, DM, DFF, EpiResidN{XC, p.out, XC, p.out, MOD0, 5, 0, p.in[6] + DM, MOD1, 0, H, RSS + MTOT}, GC, (int)blockIdx.x);
        else { run_gemm_gc(lds, H + (size_t)NCTX * DM, WIN1, NLAT, NIN1, DM, EpiStoreN<0>{BIG1 + (size_t)NCTX * NIN1, NIN1, RSS + MTOT, BIAS + 9 * 4096, NCTX}, (int)gridDim.x - GC, (int)blockIdx.x - GC);
            LAS float* scr = (LAS float*)(lds + wave * 16384);
            for (int it = TR_EARLY + ((int)blockIdx.x - GC) * 8 + wave; it < TR_ALL; it += ((int)gridDim.x - GC) * 8) transpose_any(p, scr, it, lane); }
    }
    GSYNC();
    { FRESH_IDS();
        if ((int)blockIdx.x < 48) { run_gemm_gc(lds, H, WIN1, NCTX, NIN1, DM, EpiStoreN<0>{BIG1, NIN1, RSS + MTOT, BIAS + 9 * 4096, 0}, 48, (int)blockIdx.x);
            sub_barrier(barw + 3600, 48, tid);
            phase_post1(BIG1, p.in[16], p.in[17], VT, (bf16*)(ws + WS_V1), lane, wave, 0, NCTX, (int)blockIdx.x, 48); }
        else { phase_post1(BIG1, p.in[16], p.in[17], VT, (bf16*)(ws + WS_V1), lane, wave, NCTX, MTOT, (int)blockIdx.x - 48, (int)gridDim.x - 48);
            phase_bias(p, lane, wave, 4096 + 1536, 4096 + 1536 + 4096, (int)blockIdx.x - 48, (int)gridDim.x - 48); }
    }
    GSYNC();
    for (int rep_ = 0; rep_ < REP_ATTNC; ++rep_) { FRESH_IDS();
        const int G_ = (int)gridDim.x, vcu = (G_ % 8 == 0) ? ((int)blockIdx.x & 7) * (G_ >> 3) + ((int)blockIdx.x >> 3) : (int)blockIdx.x;
        for (int item = vcu; item < 1024; item += G_) {
            const int qb = item & 15, head = (item >> 4) & 7, b = item >> 7, kvh = head >> 2;
            int tl = wave * 64 + fresh_lane(); asm volatile("" : "+v"(tl));
            const size_t qrow = (size_t)NCTX + (size_t)b * SEQ + qb * 256;
            __syncthreads();
            adb::attn_dense_body<adb::bf16>(BIG1 + qrow * NIN1 + head * 128, VT + (size_t)(b * 2 + kvh) * KVLEN * 128, (const bf16*)(ws + WS_V1) + (size_t)(b * 2 + kvh) * KVLEN * 128,
                                            OC + qrow * DM + head * 128, KVLEN, (char*)lds, tl);
        }
    }
    GSYNC();
    { FRESH_IDS();
        run_gemm(lds, OC + (size_t)NCTX * DM, WOUT1, NLAT, DM, DM, EpiResidN{XC, p.out, XC, p.out, MOD1, 2, NCTX, p.in[7] + DM, MOD1, 3, H, RSS + 2 * MTOT});
    }
    GSYNC();
    for (int rep_ = 0; rep_ < REP_UP1; ++rep_) { FRESH_IDS();
        run_gemm(lds, H + (size_t)NCTX * DM, W1 + (size_t)DFF * DM, NLAT, DFF, DM, EpiStoreN<1>{BIG, DFF, RSS + 2 * MTOT, BIAS + 2 * 9 * 4096, NCTX});
    }
    GSYNC();
    { FRESH_IDS();
        run_gemm(lds, BIG, W2 + (size_t)DFF * DM, NLAT, DM, DFF, EpiResid{XC, p.out, XC, p.out, MOD1, 5, NCTX});
    }
}

extern "C" void kernel_launch(void* const* d_in, const int* in_sizes, int n_in, void* d_out, int out_size, void* d_ws, size_t ws_size, hipStream_t stream) {
    static int grid = 0;
    if (grid == 0) {
        if (n_in != 21 || out_size != NLAT * DM || ws_size < WS_END) { fprintf(stderr, "kernel_launch: unexpected shapes (n_in %d out %d ws %zu)\n", n_in, out_size, ws_size); grid = -1; return; }
        int dev = 0, cus = 0, per_cu = 0;
        hipGetDevice(&dev); hipDeviceGetAttribute(&cus, hipDeviceAttributeMultiprocessorCount, dev);
        hipFuncSetAttribute((const void*)fwd_kernel, hipFuncAttributeMaxDynamicSharedMemorySize, LDS_BYTES);
        hipOccupancyMaxActiveBlocksPerMultiprocessor(&per_cu, (const void*)fwd_kernel, 512, LDS_BYTES);
        if (per_cu < 1) { fprintf(stderr, "kernel_launch: occupancy query says %d blocks per CU\n", per_cu); per_cu = 1; }
        grid = cus * per_cu;
    }
    if (grid < 0) return;
    Params p{};
    for (int i = 0; i < 21; ++i) p.in[i] = (const float*)d_in[i];
    p.out = (float*)d_out; p.ws = (unsigned char*)d_ws;
    void* args[] = {&p};
    hipError_t e = hipLaunchCooperativeKernel((const void*)fwd_kernel, dim3(grid), dim3(512), args, LDS_BYTES, stream);
    if (e != hipSuccess) fprintf(stderr, "cooperative launch failed: %s (grid %d)\n", hipGetErrorString(e), grid);
}
```

```cpp
#include <hip/hip_runtime.h>
#include <hip/hip_cooperative_groups.h>
#include <cstdio>
#include <cstdint>
namespace cg = cooperative_groups;
namespace pg8 {
#define PG8_LAS __attribute__((address_space(3)))
typedef unsigned short bf16_t;
typedef short bf16x8 __attribute__((ext_vector_type(8)));
typedef float f32x4 __attribute__((ext_vector_type(4)));
typedef unsigned u32x4 __attribute__((ext_vector_type(4)));
constexpr int BM = 256, BK = 64, HALF = 128, HTB = HALF * BK * 2  , STAGE_BYTES = 8 * HTB, NXCD = 8, WGM = 8;

__host__ __device__ __forceinline__ int lds_byte(int r, int c) { const int st = (r >> 4) * 2 + (c >> 5), rr = r & 15, cc = c & 31, ob = rr * 64 + cc * 2; return st * 1024 + (ob ^ (((ob >> 9) & 1) << 5)); }
__host__ __device__ __forceinline__ void stage_rc(int b, int& R, int& C) { const int st = b / 1024, sb = b % 1024, swz = sb ^ (((sb >> 9) & 1) << 5); R = (st >> 1) * 16 + swz / 64; C = (st & 1) * 32 + (swz % 64) / 2; }
__host__ __device__ __forceinline__ int perm32(int rho) { const int n = rho >> 4, i = rho & 15; return 8 * (i >> 2) + 4 * n + (i & 3); }

struct Unit { int pm, pn; };
struct Gemm { const bf16_t* A; const bf16_t* Bt; int M, N, K; };

struct StaticOrder {
    int nM, nN, nwg, G, c, lo, hi;
    __host__ __device__ void init(int M, int N, int G_, int c_) { nM = M / BM; nN = N / BM; nwg = nM * nN; G = G_; c = c_; lo = 0; hi = nwg; }
    __host__ __device__ void range(int lo_, int hi_) { lo = lo_; hi = hi_ < nwg ? hi_ : nwg; }
    __host__ __device__ bool next(int i, Unit& u) const {
        const long L = (long)lo + (long)i * G + c; if (L >= hi) return false;
        int wgid = (int)L; { const int q = nwg / NXCD, r = nwg % NXCD, xcd = wgid % NXCD, off = wgid / NXCD; wgid = (xcd < r ? xcd * (q + 1) : r * (q + 1) + (xcd - r) * q) + off; }
        const int nig = WGM * nN, gid = wgid / nig, fm = gid * WGM, gsz = (nM - fm) < WGM ? (nM - fm) : WGM;
        u.pm = fm + ((wgid % nig) % gsz); u.pn = (wgid % nig) / gsz; return true;
    }
    __device__ __forceinline__ void a_ready(const Unit&) const {}
    __device__ __forceinline__ void done(const Unit&) const {}
};
}
namespace pg8 {

template <class Epi, class Sched, bool ALIGN_EPI = false, bool SP2 = false>
__device__ __forceinline__ void gemm_phase(PG8_LAS unsigned char* lds, const Gemm g, const Sched& S, const Epi& E, const int tid_in) {
    int tid_ = tid_in; asm volatile("" : "+v"(tid_)); const int tid = tid_, wid = __builtin_amdgcn_readfirstlane(tid >> 6), lane = tid & 63, wr = wid >> 2, wc = wid & 3, fr = lane & 15, fq = lane >> 4;
    const int K = g.K, nt = K / BK;
    unsigned voffA[2], voffB[2];
#pragma unroll
    for (int i = 0; i < 2; ++i) { int R, C; stage_rc(tid * 16 + i * 8192, R, C); const int Rb = Epi::PERM ? ((R & ~31) + perm32(R & 31)) : R;
        voffA[i] = (unsigned)(R * K + C) * 2u; voffB[i] = (unsigned)(Rb * K + C) * 2u; }
    const size_t kstep = (size_t)(BK * 2);
    const size_t hstep = (size_t)HALF * K * 2;
    const size_t tstep = 2 * hstep;
    const unsigned ldsw = (unsigned)wid * 1024u;
    const int aoff = lds_byte(wr * 64 + fr, fq * 8), boff = lds_byte(wc * 32 + fr, fq * 8);
#define PG8_SA(b, h) (((b) * 2 + (h)) * HTB)
#define PG8_SB(b, h) ((4 + (b) * 2 + (h)) * HTB)
#define PG8_STAGE(bufoff, gbase, voff) do { _Pragma("unroll") for (int _i = 0; _i < 2; ++_i) \
        __builtin_amdgcn_global_load_lds((const unsigned*)((const char*)(gbase) + (voff)[_i]), (PG8_LAS unsigned*)(lds + (bufoff) + ldsw + _i * 8192), 16, 0, 0); } while (0)
#define PG8_LDA(dst, b, h) do { _Pragma("unroll") for (int m = 0; m < 4; ++m) _Pragma("unroll") for (int k = 0; k < 2; ++k) dst[m][k] = *(const PG8_LAS bf16x8*)(lds + PG8_SA(b, h) + aoff + m * 2048 + k * 1024); } while (0)
#define PG8_LDB(dst, b, h) do { _Pragma("unroll") for (int n = 0; n < 2; ++n) _Pragma("unroll") for (int k = 0; k < 2; ++k) dst[n][k] = *(const PG8_LAS bf16x8*)(lds + PG8_SB(b, h) + boff + n * 2048 + k * 1024); } while (0)
#define PG8_MMA(ai, bj, At, Bt) do { __builtin_amdgcn_s_setprio(1); _Pragma("unroll") for (int m = 0; m < 4; ++m) _Pragma("unroll") for (int n = 0; n < 2; ++n) _Pragma("unroll") for (int k = 0; k < 2; ++k) \
        acc[ai][bj][m][n] = __builtin_amdgcn_mfma_f32_16x16x32_bf16(Bt[n][k], At[m][k], acc[ai][bj][m][n], 0, 0, 0); __builtin_amdgcn_s_setprio(0); } while (0)
#define PG8_WAIT_V(n) asm volatile("s_waitcnt vmcnt(" #n ")" ::: "memory")
#define PG8_WAIT_L(n) asm volatile("s_waitcnt lgkmcnt(" #n ")" ::: "memory")
#define PG8_BAR __builtin_amdgcn_s_barrier()
#define PG8_SCHED __builtin_amdgcn_sched_barrier(0)
    Unit cur, nxt; int ui = 0;
    if (!S.next(0, cur)) return;
    f32x4 acc[2][2][4][2];
#pragma unroll
    for (int a = 0; a < 2; ++a)
#pragma unroll
        for (int b = 0; b < 2; ++b)
#pragma unroll
            for (int m = 0; m < 4; ++m)
#pragma unroll
                for (int n = 0; n < 2; ++n) acc[a][b][m][n] = (f32x4){0.f, 0.f, 0.f, 0.f};
    bf16x8 At[4][2], B0[2][2], B1[2][2];
    const char* cA = (const char*)g.A + (size_t)cur.pm * tstep; const char* cB = (const char*)g.Bt + (size_t)cur.pn * tstep;
    S.a_ready(cur);
    if constexpr (SP2) {
        PG8_STAGE(PG8_SB(0, 0), cB, voffB); PG8_STAGE(PG8_SB(0, 1), cB + hstep, voffB); PG8_STAGE(PG8_SA(0, 0), cA, voffA); PG8_STAGE(PG8_SA(0, 1), cA + hstep, voffA);
        if (wr == 1) PG8_BAR;
        PG8_WAIT_V(2); PG8_BAR;
        PG8_STAGE(PG8_SB(1, 0), cB + kstep, voffB); PG8_STAGE(PG8_SA(1, 0), cA + kstep, voffA); PG8_STAGE(PG8_SB(1, 1), cB + hstep + kstep, voffB);
        PG8_WAIT_V(6); PG8_BAR;
    } else {
        PG8_STAGE(PG8_SB(0, 0), cB, voffB); PG8_STAGE(PG8_SA(0, 0), cA, voffA); PG8_STAGE(PG8_SB(0, 1), cB + hstep, voffB); PG8_STAGE(PG8_SA(0, 1), cA + hstep, voffA);
        if (wr == 1) PG8_BAR;
        PG8_WAIT_V(4); PG8_BAR;
        PG8_STAGE(PG8_SB(1, 0), cB + kstep, voffB); PG8_STAGE(PG8_SA(1, 0), cA + kstep, voffA); PG8_STAGE(PG8_SB(1, 1), cB + hstep + kstep, voffB);
        PG8_WAIT_V(6); PG8_BAR;
    }
    for (;;) {
        const bool has_next = S.next(ui + 1, nxt);
        const char* nA = has_next ? (const char*)g.A + (size_t)nxt.pm * tstep : cA; const char* nB = has_next ? (const char*)g.Bt + (size_t)nxt.pn * tstep : cB;
        for (int t = 0; t < nt; t += 2) {
            const bool last = (t == nt - 2);
            const char* a1 = cA + (size_t)(t + 1) * kstep;
            const char* a2 = last ? nA : cA + (size_t)(t + 2) * kstep; const char* b2 = last ? nB : cB + (size_t)(t + 2) * kstep;
            const char* a3 = a2 + kstep; const char* b3 = b2 + kstep;
            if (last && has_next) S.a_ready(nxt);
            if constexpr (SP2) {
            PG8_LDB(B0, 0, 0); PG8_LDB(B1, 0, 1); PG8_SCHED; PG8_LDA(At, 0, 0); PG8_STAGE(PG8_SA(1, 1), a1 + hstep, voffA);
            PG8_WAIT_V(8); PG8_WAIT_L(0); PG8_BAR; PG8_MMA(0, 0, At, B0); PG8_MMA(0, 1, At, B1); PG8_BAR; PG8_SCHED;
            PG8_LDA(At, 0, 1); PG8_STAGE(PG8_SB(0, 0), b2, voffB); PG8_STAGE(PG8_SB(0, 1), b2 + hstep, voffB); PG8_STAGE(PG8_SA(0, 0), a2, voffA);
            PG8_WAIT_V(8); PG8_WAIT_L(0); PG8_BAR; PG8_MMA(1, 0, At, B0); PG8_MMA(1, 1, At, B1); PG8_BAR; PG8_SCHED;
            PG8_LDB(B0, 1, 0); PG8_LDB(B1, 1, 1); PG8_SCHED; PG8_LDA(At, 1, 0); PG8_STAGE(PG8_SA(0, 1), a2 + hstep, voffA);
            PG8_WAIT_V(8); PG8_WAIT_L(0); PG8_BAR; PG8_MMA(0, 0, At, B0); PG8_MMA(0, 1, At, B1); PG8_BAR; PG8_SCHED;
            PG8_LDA(At, 1, 1); PG8_STAGE(PG8_SB(1, 0), b3, voffB); PG8_STAGE(PG8_SB(1, 1), b3 + hstep, voffB); PG8_STAGE(PG8_SA(1, 0), a3, voffA);
            PG8_WAIT_V(8); PG8_WAIT_L(0); PG8_BAR; PG8_MMA(1, 0, At, B0); PG8_MMA(1, 1, At, B1); PG8_BAR; PG8_SCHED;
            } else {
            PG8_LDB(B0, 0, 0); PG8_SCHED; PG8_LDA(At, 0, 0); PG8_STAGE(PG8_SA(1, 1), a1 + hstep, voffA);
            PG8_WAIT_L(8); PG8_BAR; PG8_WAIT_L(0); PG8_MMA(0, 0, At, B0); PG8_BAR; PG8_SCHED;
            PG8_LDB(B1, 0, 1); PG8_STAGE(PG8_SB(0, 0), b2, voffB);
            PG8_BAR; PG8_WAIT_L(0); PG8_MMA(0, 1, At, B1); PG8_BAR;
            PG8_LDA(At, 0, 1); PG8_STAGE(PG8_SA(0, 0), a2, voffA);
            PG8_BAR; PG8_WAIT_L(0); PG8_MMA(1, 0, At, B0); PG8_BAR; PG8_SCHED;
            PG8_STAGE(PG8_SB(0, 1), b2 + hstep, voffB);
            PG8_WAIT_V(6); PG8_BAR; PG8_MMA(1, 1, At, B1); PG8_BAR;
            PG8_LDB(B0, 1, 0); PG8_SCHED; PG8_LDA(At, 1, 0); PG8_STAGE(PG8_SA(0, 1), a2 + hstep, voffA);
            PG8_WAIT_L(8); PG8_BAR; PG8_WAIT_L(0); PG8_MMA(0, 0, At, B0); PG8_BAR; PG8_SCHED;
            PG8_LDB(B1, 1, 1); PG8_STAGE(PG8_SB(1, 0), b3, voffB);
            PG8_BAR; PG8_WAIT_L(0); PG8_MMA(0, 1, At, B1); PG8_BAR;
            PG8_LDA(At, 1, 1); PG8_STAGE(PG8_SA(1, 0), a3, voffA);
            PG8_BAR; PG8_WAIT_L(0); PG8_MMA(1, 0, At, B0); PG8_BAR; PG8_SCHED;
            PG8_STAGE(PG8_SB(1, 1), b3 + hstep, voffB);
            PG8_WAIT_V(6); PG8_BAR; PG8_MMA(1, 1, At, B1); PG8_BAR;
            }
        }
        if constexpr (ALIGN_EPI) { if (wr == 0) PG8_BAR; }
        if constexpr (!Epi::AFTER_DRAIN) { E(acc, cur, wr, wc, fr, fq); S.done(cur); }
        if (!has_next) break;
#pragma unroll
        for (int a = 0; a < 2; ++a)
#pragma unroll
            for (int b = 0; b < 2; ++b)
#pragma unroll
                for (int m = 0; m < 4; ++m)
#pragma unroll
                    for (int n = 0; n < 2; ++n) acc[a][b][m][n] = (f32x4){0.f, 0.f, 0.f, 0.f};
        cur = nxt; cA = nA; cB = nB; ++ui;
        if constexpr (ALIGN_EPI) { if (wr == 1) PG8_BAR; }
    }
    PG8_WAIT_V(0);
    if constexpr (!ALIGN_EPI) { if (wr == 0) PG8_BAR; }
    PG8_BAR;
    if constexpr (Epi::AFTER_DRAIN) { E.fused(acc, cur, wr, wc, fr, fq, lds, wid, lane); S.done(cur); }
#undef PG8_SA
#undef PG8_SB
#undef PG8_STAGE
#undef PG8_LDA
#undef PG8_LDB
#undef PG8_MMA
#undef PG8_WAIT_V
#undef PG8_WAIT_L
#undef PG8_BAR
#undef PG8_SCHED
}
}

#define DI __device__ __forceinline__
#define LAS __attribute__((address_space(3)))
typedef unsigned short bf16;
typedef short bf16x8 __attribute__((ext_vector_type(8)));
typedef short s16x4 __attribute__((ext_vector_type(4)));
typedef float f32x2 __attribute__((ext_vector_type(2)));
typedef float f32x4 __attribute__((ext_vector_type(4)));
typedef float f32x16 __attribute__((ext_vector_type(16)));
typedef unsigned u32x2 __attribute__((ext_vector_type(2)));
typedef unsigned u32x4 __attribute__((ext_vector_type(4)));
typedef __bf16 bf16x2_t __attribute__((ext_vector_type(2)));
#define LDS_WAIT() asm volatile("s_waitcnt lgkmcnt(0)" ::: "memory")
#define MFMA32(a, b, c) __builtin_amdgcn_mfma_f32_32x32x16_bf16((a), (b), (c), 0, 0, 0)

constexpr int DM = 1024, NBATCH = 8, SEQ = 4096, CTXL = 256, NCTX = NBATCH * CTXL, NLAT = NBATCH * SEQ, MTOT = NCTX + NLAT;
constexpr int NIN0 = 2816, NIN1 = 1536, DFF = 4096, KVLEN = CTXL + SEQ, AB_IN_W = 2832, NMODC = 6144;
constexpr float EPS = 1e-6f, LOG2E = 1.4426950408889634f;
constexpr size_t MiB = 1u << 20;
constexpr size_t WS_WIN0 = 0, WS_WOUT0 = 6 * MiB, WS_WIN1 = 8 * MiB, WS_WOUT1 = 11 * MiB, WS_W1 = 13 * MiB, WS_W2 = 29 * MiB, WS_MOD = 45 * MiB,
                 WS_GATES = 46 * MiB, WS_XC = 49 * MiB, WS_VT = 57 * MiB, WS_H = 74 * MiB, WS_OCAT = 142 * MiB, WS_BIG = 210 * MiB, WS_BAR = 482 * MiB, WS_RSS = 483 * MiB, WS_BIAS = 484 * MiB, WS_V1 = 485 * MiB, WS_END = 502 * MiB;
constexpr size_t WS_WG = 45 * MiB + 512 * 1024;
constexpr int LDS_BYTES = 147456;

struct Params { const float* in[21]; float* out; unsigned char* ws; };

DI unsigned cvtpk(float lo, float hi) { f32x2 v = {lo, hi}; bf16x2_t b = __builtin_convertvector(v, bf16x2_t); return __builtin_bit_cast(unsigned, b); }
DI bf16 f2bf(float x) { return (bf16)(cvtpk(x, 0.f) & 0xffffu); }
DI float bf2f(bf16 b) { return __uint_as_float(((unsigned)b) << 16); }
DI float wave_sum(float v) {
#pragma unroll
    for (int o = 1; o < 64; o <<= 1) v += __shfl_xor(v, o);
    return v;
}
DI int fresh_lane() { int l; asm volatile("v_mbcnt_lo_u32_b32 %0, -1, 0\n\tv_mbcnt_hi_u32_b32 %0, -1, %0" : "=v"(l)); return l; }
DI int crow(int i, int h) { return (i & 3) + 8 * (i >> 2) + 4 * h; }
DI f32x16 zero16() { f32x16 z; for (int i = 0; i < 16; ++i) z[i] = 0.f; return z; }

DI void mma32(f32x16& acc, const LAS bf16* A, int lda, const LAS bf16* B, int ldb, int K, int lane) {
    const int r = lane & 31, h = lane >> 5;
    const LAS bf16* ap = A + r * lda + 8 * h; const LAS bf16* bp = B + r * ldb + 8 * h;
#pragma unroll 1
    for (int k0 = 0; k0 < K; k0 += 16) {
        const bf16x8 a = *(const LAS bf16x8*)(ap + k0); const bf16x8 b = *(const LAS bf16x8*)(bp + k0);
        acc = MFMA32(a, b, acc);
    }
}

template <int ACT> struct EpiStore {
    static constexpr bool PERM = true, AFTER_DRAIN = false;
    bf16* O; int ldc;
    DI void operator()(const f32x4 (&acc)[2][2][4][2], const pg8::Unit& u, int wr, int wc, int fr, int fq) const {
        const int row0 = u.pm * 256 + wr * 64 + fr, col0 = u.pn * 256 + wc * 32 + 8 * fq;
#pragma unroll
        for (int ai = 0; ai < 2; ++ai)
#pragma unroll
            for (int m = 0; m < 4; ++m) { bf16* rowp = O + (size_t)(row0 + ai * 128 + m * 16) * ldc + col0;
#pragma unroll
                for (int bj = 0; bj < 2; ++bj) { f32x4 v0 = acc[ai][bj][m][0], v1 = acc[ai][bj][m][1];
                    if (ACT == 1) {
#pragma unroll
                        for (int e = 0; e < 4; ++e) { float a = fmaxf(v0[e], 0.f), b = fmaxf(v1[e], 0.f); v0[e] = a * a; v1[e] = b * b; } }
                    u32x4 w; w.x = cvtpk(v0[0], v0[1]); w.y = cvtpk(v0[2], v0[3]); w.z = cvtpk(v1[0], v1[1]); w.w = cvtpk(v1[2], v1[3]);
                    *(u32x4*)(rowp + bj * 128) = w; } }
    }
};
struct EpiResid {
    static constexpr bool PERM = true, AFTER_DRAIN = false;
    const float* srcC; const float* srcL; float* dstC; float* dstL; const float* mod; int gi; int row_base;
    DI void operator()(const f32x4 (&acc)[2][2][4][2], const pg8::Unit& u, int wr, int wc, int fr, int fq) const {
        const int grow0 = row_base + u.pm * 256;
        const float* s; float* d; int mrow;
        if (grow0 < NCTX) { s = srcC + (size_t)grow0 * DM; d = dstC + (size_t)grow0 * DM; mrow = 8; }
        else { const int lr = grow0 - NCTX; s = srcL + (size_t)lr * DM; d = dstL + (size_t)lr * DM; mrow = lr >> 12; }
        const float* gp = mod + mrow * NMODC + gi * DM;
#pragma unroll
        for (int bj = 0; bj < 2; ++bj) { const int col = u.pn * 256 + bj * 128 + wc * 32 + 8 * fq;
            const f32x4 g0 = *(const f32x4*)(gp + col), g1 = *(const f32x4*)(gp + col + 4);
#pragma unroll
            for (int ai = 0; ai < 2; ++ai) {
            f32x4 rr0[4], rr1[4];
#pragma unroll
                for (int m = 0; m < 4; ++m) { const int ro = (ai * 128 + wr * 64 + m * 16 + fr) * DM + col; rr0[m] = *(const f32x4*)(s + ro); rr1[m] = *(const f32x4*)(s + ro + 4); }
            asm volatile("" ::: "memory");
#pragma unroll
                for (int m = 0; m < 4; ++m) { const int ro = (ai * 128 + wr * 64 + m * 16 + fr) * DM + col;
                    *(f32x4*)(d + ro) = rr0[m] + g0 * acc[ai][bj][m][0]; *(f32x4*)(d + ro + 4) = rr1[m] + g1 * acc[ai][bj][m][1]; } } }
    }
};
struct EpiResidN {
    static constexpr bool PERM = true, AFTER_DRAIN = false;
    const float* srcC; const float* srcL; float* dstC; float* dstL; const float* mod; int gi; int row_base;
    const float* gnext; const float* modn; int sin; bf16* Hn; float* rss;
    DI void operator()(const f32x4 (&acc)[2][2][4][2], const pg8::Unit& u, int wr, int wc, int fr, int fq) const {
        const int grow0 = row_base + u.pm * 256;
        const float* s; float* d; int mrow;
        if (grow0 < NCTX) { s = srcC + (size_t)grow0 * DM; d = dstC + (size_t)grow0 * DM; mrow = 8; }
        else { const int lr = grow0 - NCTX; s = srcL + (size_t)lr * DM; d = dstL + (size_t)lr * DM; mrow = lr >> 12; }
        const float* gp = mod + mrow * NMODC + gi * DM; const float* scp = modn + mrow * NMODC + (sin + 1) * DM;
        bf16* hb = Hn + (size_t)grow0 * DM;
        float ssq[2][4];
#pragma unroll
        for (int ai = 0; ai < 2; ++ai)
#pragma unroll
            for (int m = 0; m < 4; ++m) ssq[ai][m] = 0.f;
#pragma unroll
        for (int bj = 0; bj < 2; ++bj) { const int col = u.pn * 256 + bj * 128 + wc * 32 + 8 * fq;
            const f32x4 g0 = *(const f32x4*)(gp + col), g1 = *(const f32x4*)(gp + col + 4);
            const f32x4 w0 = *(const f32x4*)(gnext + col) * (*(const f32x4*)(scp + col) + 1.f), w1 = *(const f32x4*)(gnext + col + 4) * (*(const f32x4*)(scp + col + 4) + 1.f);
#pragma unroll
            for (int ai = 0; ai < 2; ++ai) {
            f32x4 rr0[4], rr1[4];
#pragma unroll
                for (int m = 0; m < 4; ++m) { const int ro = (ai * 128 + wr * 64 + m * 16 + fr) * DM + col; rr0[m] = *(const f32x4*)(s + ro); rr1[m] = *(const f32x4*)(s + ro + 4); }
            asm volatile("" ::: "memory");
#pragma unroll
                for (int m = 0; m < 4; ++m) { const int ro = (ai * 128 + wr * 64 + m * 16 + fr) * DM + col;
                    const f32x4 r0 = rr0[m], r1 = rr1[m];
                    const f32x4 x0 = r0 + g0 * acc[ai][bj][m][0], x1 = r1 + g1 * acc[ai][bj][m][1];
                    *(f32x4*)(d + ro) = x0; *(f32x4*)(d + ro + 4) = x1;
                    ssq[ai][m] += (x0[0] * x0[0] + x0[1] * x0[1]) + (x0[2] * x0[2] + x0[3] * x0[3]) + (x1[0] * x1[0] + x1[1] * x1[1]) + (x1[2] * x1[2] + x1[3] * x1[3]);
                    const f32x4 h0 = x0 * w0, h1 = x1 * w1;
                    u32x4 w; w.x = cvtpk(h0[0], h0[1]); w.y = cvtpk(h0[2], h0[3]); w.z = cvtpk(h1[0], h1[1]); w.w = cvtpk(h1[2], h1[3]);
                    *(u32x4*)(hb + ro) = w; } } }
#pragma unroll
        for (int ai = 0; ai < 2; ++ai)
#pragma unroll
            for (int m = 0; m < 4; ++m) { float q = ssq[ai][m]; q += __shfl_xor(q, 16); q += __shfl_xor(q, 32);
                if (fq == 0) atomicAdd(rss + grow0 + ai * 128 + wr * 64 + m * 16 + fr, q); }
    }
};
template <int ACT> struct EpiStoreN {
    static constexpr bool PERM = true, AFTER_DRAIN = false;
    bf16* O; int ldc; const float* rss; const float* bias; int row_base;
    DI void operator()(const f32x4 (&acc)[2][2][4][2], const pg8::Unit& u, int wr, int wc, int fr, int fq) const {
        const int lrow0 = u.pm * 256 + wr * 64 + fr, grow0 = row_base + u.pm * 256, col0 = u.pn * 256 + wc * 32 + 8 * fq;
        bf16* Ou = O + (size_t)(u.pm * 256) * ldc + u.pn * 256;
        const int mrow = grow0 < NCTX ? 8 : (grow0 - NCTX) >> 12;
        float rstd[2][4];
#pragma unroll
        for (int ai = 0; ai < 2; ++ai)
#pragma unroll
            for (int m = 0; m < 4; ++m) rstd[ai][m] = rsqrtf(rss[row_base + lrow0 + ai * 128 + m * 16] * (1.f / DM) + EPS);
        const float* bp = bias + mrow * 4096 + col0;
        f32x4 bb[2][2];
#pragma unroll
        for (int bj = 0; bj < 2; ++bj) { bb[bj][0] = *(const f32x4*)(bp + bj * 128); bb[bj][1] = *(const f32x4*)(bp + bj * 128 + 4); }
        asm volatile("" ::: "memory");
#pragma unroll
        for (int bj = 0; bj < 2; ++bj) { const f32x4 b0 = bb[bj][0], b1 = bb[bj][1];
#pragma unroll
            for (int ai = 0; ai < 2; ++ai)
#pragma unroll
                for (int m = 0; m < 4; ++m) {
                    f32x4 v0 = acc[ai][bj][m][0] * rstd[ai][m] + b0, v1 = acc[ai][bj][m][1] * rstd[ai][m] + b1;
                    if (ACT == 1) {
#pragma unroll
                        for (int e = 0; e < 4; ++e) { float a = fmaxf(v0[e], 0.f), b = fmaxf(v1[e], 0.f); v0[e] = a * a; v1[e] = b * b; } }
                    u32x4 w; w.x = cvtpk(v0[0], v0[1]); w.y = cvtpk(v0[2], v0[3]); w.z = cvtpk(v1[0], v1[1]); w.w = cvtpk(v1[2], v1[3]);
                    *(u32x4*)(Ou + (wr * 64 + fr + ai * 128 + m * 16) * ldc + wc * 32 + 8 * fq + bj * 128) = w; } }
    }
};
template <class Epi> DI void run_gemm_rng_(LAS unsigned char* lds, const bf16* A, const bf16* Bt, int M, int N, int K, const Epi& E, int G, int c, int lo, int hi, int tid) {
    pg8::Gemm g{A, Bt, M, N, K}; pg8::StaticOrder S; S.init(M, N, G, c); S.range(lo, hi);
    pg8::gemm_phase<Epi, pg8::StaticOrder, true, true>(lds, g, S, E, tid);
}

DI void transpose_item(const float* __restrict__ W, int ldw, int K, bf16* WT, int nblk, LAS float* scr, int item, int lane) {
    const int kb = item / nblk, nb = item - kb * nblk, k0 = 64 * kb, n0 = 32 * nb;
    float wv[32];
#pragma unroll
    for (int i = 0; i < 32; ++i) wv[i] = W[(size_t)(k0 + 2 * i + (lane >> 5)) * ldw + n0 + (lane & 31)];
#pragma unroll
    for (int i = 0; i < 32; ++i) scr[(2 * i + (lane >> 5)) * 33 + (lane & 31)] = wv[i];
    LDS_WAIT();
    const int c = lane & 7;
#pragma unroll
    for (int j = 0; j < 4; ++j) { const int n = (lane >> 3) + 8 * j; const LAS float* s = scr + (8 * c) * 33 + n;
        u32x4 o; o.x = cvtpk(s[0], s[33]); o.y = cvtpk(s[66], s[99]); o.z = cvtpk(s[132], s[165]); o.w = cvtpk(s[198], s[231]);
        *(u32x4*)(WT + (size_t)(n0 + n) * K + k0 + 8 * c) = o; }
    LDS_WAIT();
}
constexpr int TR_I0 = 16 * 64, TR_I1 = 16 * 24, TR_I2 = 16 * 32, TR_I3 = 16 * 48, TR_I4 = 16 * 32, TR_I5 = 16 * 128, TR_I6 = 64 * 32;
constexpr int TR_EARLY = TR_I0 + TR_I1 + TR_I2 + TR_I3 + TR_I5 + TR_I6, TR_ALL = TR_EARLY + TR_I4 + TR_I5 + TR_I6;
DI void transpose_any(const Params& p, LAS float* scr, int it, int lane) {
    unsigned char* ws = p.ws; int r = it;
    if (r < TR_I0) { transpose_item(p.in[8], AB_IN_W, 1024, (bf16*)(ws + WS_WIN0), 64, scr, r, lane); return; } r -= TR_I0;
    if (r < TR_I1) { transpose_item(p.in[8] + 2064, AB_IN_W, 1024, (bf16*)(ws + WS_WIN0) + (size_t)2048 * 1024, 24, scr, r, lane); return; } r -= TR_I1;
    if (r < TR_I2) { transpose_item(p.in[14], 1024, 1024, (bf16*)(ws + WS_WOUT0), 32, scr, r, lane); return; } r -= TR_I2;
    if (r < TR_I3) { transpose_item(p.in[15], NIN1, 1024, (bf16*)(ws + WS_WIN1), 48, scr, r, lane); return; } r -= TR_I3;
    if (r < TR_I5) { transpose_item(p.in[19], DFF, 1024, (bf16*)(ws + WS_W1), 128, scr, r, lane); return; } r -= TR_I5;
    if (r < TR_I6) { transpose_item(p.in[20], 1024, DFF, (bf16*)(ws + WS_W2), 32, scr, r, lane); return; } r -= TR_I6;
    if (r < TR_I4) { transpose_item(p.in[18], 1024, 1024, (bf16*)(ws + WS_WOUT1), 32, scr, r, lane); return; } r -= TR_I4;
    if (r < TR_I5) { transpose_item(p.in[19] + (size_t)1024 * DFF, DFF, 1024, (bf16*)(ws + WS_W1) + (size_t)DFF * 1024, 128, scr, r, lane); return; } r -= TR_I5;
    transpose_item(p.in[20] + (size_t)DFF * 1024, 1024, DFF, (bf16*)(ws + WS_W2) + (size_t)DFF * 1024, 32, scr, r, lane);
}
DI void phase_prologue(const Params& p, LAS unsigned char* lds, int tid, int lane, int wave) {
    unsigned char* ws = p.ws;
    float* MOD = (float*)(ws + WS_MOD);
    for (int item = blockIdx.x; item < 192; item += gridDim.x) {
        const int l = item / 96, cgp = item - l * 96;
        LAS float* sl = (LAS float*)lds; LAS float* part = sl + 9 * 1024;
        for (int i = tid; i < 9 * 1024; i += 512) { const int r = i >> 10, k = i & 1023; const float cv = r < 8 ? p.in[1][r * 1024 + k] : p.in[3][k]; sl[i] = cv / (1.f + __expf(-cv)); }
        __syncthreads();
        const float* aw = p.in[4] + (size_t)l * 1024 * NMODC + cgp * 64 + lane;
        float acc[9];
#pragma unroll
        for (int r = 0; r < 9; ++r) acc[r] = 0.f;
        const int kbase = wave * 128;
#pragma unroll 32
        for (int k = 0; k < 128; ++k) { const float w = aw[(size_t)(kbase + k) * NMODC];
#pragma unroll
            for (int r = 0; r < 9; ++r) acc[r] += sl[r * 1024 + kbase + k] * w; }
#pragma unroll
        for (int r = 0; r < 9; ++r) part[(wave * 9 + r) * 64 + lane] = acc[r];
        __syncthreads();
        for (int i = tid; i < 576; i += 512) { const int r = i >> 6, cl = i & 63; float s = p.in[5][l * NMODC + cgp * 64 + cl];
#pragma unroll
            for (int kg = 0; kg < 8; ++kg) s += part[(kg * 9 + r) * 64 + cl];
            MOD[(l * 9 + r) * NMODC + cgp * 64 + cl] = s; }
        __syncthreads();
    }
    { float* rss = (float*)(ws + WS_RSS); for (int i = blockIdx.x * 512 + tid; i < 3 * MTOT; i += gridDim.x * 512) rss[i] = 0.f; }
    { bf16* WG = (bf16*)(ws + WS_WG);
      for (int idx = blockIdx.x * 512 + tid; idx < 16 * 1024; idx += gridDim.x * 512) { const int g = idx & 15, k = idx >> 4;
          const float w = p.in[8][(size_t)k * AB_IN_W + 2048 + g]; const bf16 hi = f2bf(w); const bf16 lo = f2bf(w - bf2f(hi));
          WG[g * 1024 + k] = hi; WG[16 * 1024 + g * 1024 + k] = lo; } }
    LAS float* scr = (LAS float*)(lds + wave * 16384);
    const int gw = blockIdx.x * 8 + wave, NGW = gridDim.x * 8;
    for (int it = gw; it < TR_EARLY - TR_I6; it += NGW) transpose_any(p, scr, it, lane);
}

DI float log_sigmoid(float x) { return -(fmaxf(-x, 0.f) + log1pf(__expf(-fabsf(x)))); }
template <bool GATES>
DI void phase_norm(const Params& p, LAS unsigned char* lds, const float* srcC, const float* srcL, const float* gn, const float* modL, int si, bf16* H,
                   int row_lo, int row_hi, int tid, int lane, int wave) {
    const int gw = blockIdx.x * 8 + wave, NGW = gridDim.x * 8;
    for (int row = row_lo + gw; row < row_hi; row += 2 * NGW) {
        const int rowB = row + NGW; const bool hasB = rowB < row_hi;
        const float* xa; const float* xb; int ma, mb;
        if (row < NCTX) { xa = srcC + (size_t)row * DM; ma = 8; } else { xa = srcL + (size_t)(row - NCTX) * DM; ma = (row - NCTX) >> 12; }
        const int rb = hasB ? rowB : row;
        if (rb < NCTX) { xb = srcC + (size_t)rb * DM; mb = 8; } else { xb = srcL + (size_t)(rb - NCTX) * DM; mb = (rb - NCTX) >> 12; }
        f32x4 va[4], vb[4]; float sa = 0.f, sb = 0.f;
#pragma unroll
        for (int j = 0; j < 4; ++j) { va[j] = ((const f32x4*)xa)[lane + 64 * j]; vb[j] = ((const f32x4*)xb)[lane + 64 * j]; }
        const float* sha = modL + ma * NMODC + si * DM; const float* shb = modL + mb * NMODC + si * DM;
        f32x4 gg[4], sca[4], tca[4], scb[4], tcb[4];
#pragma unroll
        for (int j = 0; j < 4; ++j) { gg[j] = ((const f32x4*)gn)[lane + 64 * j]; sca[j] = ((const f32x4*)(sha + DM))[lane + 64 * j]; tca[j] = ((const f32x4*)sha)[lane + 64 * j];
            scb[j] = ((const f32x4*)(shb + DM))[lane + 64 * j]; tcb[j] = ((const f32x4*)shb)[lane + 64 * j]; }
        asm volatile("" ::: "memory");
#pragma unroll
        for (int j = 0; j < 4; ++j) { sa += (va[j].x * va[j].x + va[j].y * va[j].y) + (va[j].z * va[j].z + va[j].w * va[j].w);
                                      sb += (vb[j].x * vb[j].x + vb[j].y * vb[j].y) + (vb[j].z * vb[j].z + vb[j].w * vb[j].w); }
#pragma unroll
        for (int o = 1; o < 64; o <<= 1) { sa += __shfl_xor(sa, o); sb += __shfl_xor(sb, o); }
        const float ra = rsqrtf(sa * (1.f / DM) + EPS), rbs = rsqrtf(sb * (1.f / DM) + EPS);
        bf16* ha = H + (size_t)row * DM; bf16* hb = H + (size_t)rb * DM;
#pragma unroll
        for (int j = 0; j < 4; ++j) {
            { const f32x4 v = va[j] * ra * gg[j] * (sca[j] + 1.f) + tca[j]; u32x2 o; o.x = cvtpk(v.x, v.y); o.y = cvtpk(v.z, v.w); ((u32x2*)ha)[lane + 64 * j] = o; }
            if (hasB) { const f32x4 v = vb[j] * rbs * gg[j] * (scb[j] + 1.f) + tcb[j]; u32x2 o; o.x = cvtpk(v.x, v.y); o.y = cvtpk(v.z, v.w); ((u32x2*)hb)[lane + 64 * j] = o; }
        }
    }
}

DI void phase_gates(const Params& p, LAS unsigned char* lds, const bf16* H, int tid, int lane, int wave, int bidx, int nblk) {
    constexpr int GP = 1032;
    LAS bf16* Ws = (LAS bf16*)lds;
    const bf16* WG = (const bf16*)(p.ws + WS_WG);
    __syncthreads();
    for (int i = tid; i < 32 * 128; i += 512) { const int rw = i >> 7, c = i & 127; *(LAS u32x4*)(Ws + rw * GP + c * 8) = *(const u32x4*)(WG + rw * 1024 + c * 8); }
    __syncthreads();
    float* GT = (float*)(p.ws + WS_GATES);
    const int r = lane & 31, hh = lane >> 5;
    const int gw = bidx * 8 + wave, NGW = nblk * 8;
    const float gb = p.in[9][r & 15];
    for (int tile = gw; tile < MTOT / 32; tile += NGW) {
        const int row0 = 32 * tile;
        const bf16* ap = H + (size_t)(row0 + r) * DM + 8 * hh;
        const LAS bf16* bh = Ws + (r & 15) * GP + 8 * hh; const LAS bf16* bl = bh + 16 * GP;
        f32x16 acc = zero16();
#pragma unroll 1
        for (int kg = 0; kg < 4; ++kg) { bf16x8 af[16];
#pragma unroll
            for (int q = 0; q < 16; ++q) af[q] = *(const bf16x8*)(ap + 16 * (16 * kg + q));
            asm volatile("" ::: "memory");
#pragma unroll
            for (int q = 0; q < 16; ++q) { const int ks = 16 * kg + q;
                acc = MFMA32(af[q], *(const LAS bf16x8*)(bh + 16 * ks), acc); acc = MFMA32(af[q], *(const LAS bf16x8*)(bl + 16 * ks), acc); } }
        if (r < 16) {
#pragma unroll
            for (int i = 0; i < 16; ++i) { float gv = acc[i] + gb; if ((r >> 2) & 1) gv = log_sigmoid(gv); GT[(size_t)(row0 + crow(i, hh)) * 16 + r] = gv; } }
    }
    __syncthreads();
}


DI void phase_bias(const Params& p, int lane, int wave, int it_lo, int it_hi, int bidx, int nblk) {
    const float* MOD = (const float*)(p.ws + WS_MOD); float* BIAS = (float*)(p.ws + WS_BIAS);
    const int gw = bidx * 8 + wave, NGW = nblk * 8;
    for (int it = it_lo + gw; it < it_hi; it += NGW) {
        int which, n; const bf16* WT; const float* sh;
        if (it < 4096) { which = 0; n = it; WT = (const bf16*)(p.ws + WS_W1); sh = MOD + 3 * DM; }
        else if (it < 4096 + 1536) { which = 1; n = it - 4096; WT = (const bf16*)(p.ws + WS_WIN1); sh = MOD + 9 * NMODC; }
        else { which = 2; n = it - 4096 - 1536; WT = (const bf16*)(p.ws + WS_W1) + (size_t)DFF * DM; sh = MOD + 9 * NMODC + 3 * DM; }
        const u32x4 w0 = *(const u32x4*)(WT + (size_t)n * DM + lane * 16), w1 = *(const u32x4*)(WT + (size_t)n * DM + lane * 16 + 8);
        float wf[16];
        wf[0] = __uint_as_float(w0.x << 16); wf[1] = __uint_as_float(w0.x & 0xffff0000u); wf[2] = __uint_as_float(w0.y << 16); wf[3] = __uint_as_float(w0.y & 0xffff0000u);
        wf[4] = __uint_as_float(w0.z << 16); wf[5] = __uint_as_float(w0.z & 0xffff0000u); wf[6] = __uint_as_float(w0.w << 16); wf[7] = __uint_as_float(w0.w & 0xffff0000u);
        wf[8] = __uint_as_float(w1.x << 16); wf[9] = __uint_as_float(w1.x & 0xffff0000u); wf[10] = __uint_as_float(w1.y << 16); wf[11] = __uint_as_float(w1.y & 0xffff0000u);
        wf[12] = __uint_as_float(w1.z << 16); wf[13] = __uint_as_float(w1.z & 0xffff0000u); wf[14] = __uint_as_float(w1.w << 16); wf[15] = __uint_as_float(w1.w & 0xffff0000u);
        float mine = 0.f;
        f32x4 s4[9][4];
#pragma unroll
        for (int r = 0; r < 9; ++r)
#pragma unroll
            for (int q = 0; q < 4; ++q) s4[r][q] = *(const f32x4*)(sh + r * NMODC + lane * 16 + 4 * q);
        float av[9];
#pragma unroll
        for (int r = 0; r < 9; ++r) { float a = 0.f;
#pragma unroll
            for (int q = 0; q < 4; ++q) a += s4[r][q][0] * wf[4 * q] + s4[r][q][1] * wf[4 * q + 1] + s4[r][q][2] * wf[4 * q + 2] + s4[r][q][3] * wf[4 * q + 3];
            av[r] = a; }
#pragma unroll
        for (int o = 1; o < 64; o <<= 1) {
#pragma unroll
            for (int r = 0; r < 9; ++r) av[r] += __shfl_xor(av[r], o); }
#pragma unroll
        for (int r = 0; r < 9; ++r) if (lane == r) mine = av[r];
        if (lane < 9) BIAS[(which * 9 + lane) * 4096 + n] = mine;
    }
}


DI void phase_post1(bf16* QKV, const float* qg, const float* kg, bf16* K1, bf16* V1, int lane, int wave, int row_lo, int row_hi, int bidx, int nblk) {
    constexpr int HD = 128, PPA = 32, NH = 10, pitch = NIN1, R = 2;
    const int gw = bidx * 8 + wave, NGW = nblk * 8;
    const float gq0 = qg[lane], gq1 = qg[lane + 64], gk0 = kg[lane], gk1 = kg[lane + 64];
    const int fi = lane & (PPA - 1); const float invf = exp2f(-(float)fi * (13.287712379549449f / (float)PPA));
    for (int row0 = row_lo + gw; row0 < row_hi; row0 += R * NGW) {
        int rows[R]; bool ok[R], lat[R]; int bb[R], key[R]; float cs[R], sn[R]; bf16* base[R];
        float x1[R][NH], x2[R][NH], ss[R][NH]; bf16 vv[R][4];
#pragma unroll
        for (int q = 0; q < R; ++q) { rows[q] = row0 + q * NGW; ok[q] = rows[q] < row_hi; if (!ok[q]) rows[q] = row0;
            lat[q] = rows[q] >= NCTX; const int tt = (rows[q] - NCTX) & (SEQ - 1);
            if (lat[q]) { bb[q] = (rows[q] - NCTX) >> 12; key[q] = CTXL + tt; } else { bb[q] = rows[q] >> 8; key[q] = rows[q] & 255; }
            cs[q] = 1.f; sn[q] = 0.f;
            if (lat[q]) { const float ang = (float)(lane < PPA ? (tt >> 6) : (tt & 63)) * invf; cs[q] = __cosf(ang); sn[q] = __sinf(ang); }
            base[q] = QKV + (size_t)rows[q] * pitch;
#pragma unroll
            for (int hq = 0; hq < NH; ++hq) { x1[q][hq] = bf2f(base[q][hq * HD + lane]); x2[q][hq] = bf2f(base[q][hq * HD + lane + 64]); }
#pragma unroll
            for (int j = 0; j < 4; ++j) vv[q][j] = base[q][1280 + 64 * j + lane]; }
        asm volatile("" ::: "memory");
#pragma unroll
        for (int q = 0; q < R; ++q)
#pragma unroll
            for (int hq = 0; hq < NH; ++hq) ss[q][hq] = x1[q][hq] * x1[q][hq] + x2[q][hq] * x2[q][hq];
#pragma unroll
        for (int o = 1; o < 64; o <<= 1) {
#pragma unroll
            for (int q = 0; q < R; ++q)
#pragma unroll
                for (int hq = 0; hq < NH; ++hq) ss[q][hq] += __shfl_xor(ss[q][hq], o); }
#pragma unroll
        for (int q = 0; q < R; ++q) if (ok[q]) {
#pragma unroll
            for (int hq = 0; hq < NH; ++hq) if (hq >= 8 || lat[q]) {
                const float rs = rsqrtf(ss[q][hq] * (1.f / (float)HD) + EPS);
                const float y1 = x1[q][hq] * rs * (hq < 8 ? gq0 : gk0), y2 = x2[q][hq] * rs * (hq < 8 ? gq1 : gk1);
                bf16* dst = hq < 8 ? base[q] + hq * HD : K1 + ((size_t)(bb[q] * 2 + (hq - 8)) * KVLEN + key[q]) * HD;
                dst[lane] = f2bf(y1 * cs[q] - y2 * sn[q]); dst[lane + 64] = f2bf(y2 * cs[q] + y1 * sn[q]); }
            bf16* vd0 = V1 + ((size_t)(bb[q] * 2) * KVLEN + key[q]) * HD; bf16* vd1 = V1 + ((size_t)(bb[q] * 2 + 1) * KVLEN + key[q]) * HD;
            vd0[lane] = vv[q][0]; vd0[lane + 64] = vv[q][1]; vd1[lane] = vv[q][2]; vd1[lane + 64] = vv[q][3]; }
    }
}

template <int HD>
DI void phase_post(bf16* QKV, int pitch, int qcol, int nq, int kcol, int nk, int vcol, const float* qg, const float* kg, bf16* VT, bool q_for_ctx,
                   LAS unsigned char* lds, int tid, int lane, int wave, int row_lo = 0, int row_hi = MTOT, int tile_lo = 0, int tile_hi = MTOT / 64) {
    constexpr int PPA = HD / 4, NH = 10, R = 2;
    const int gw = blockIdx.x * 8 + wave, NGW = gridDim.x * 8;
    float gq0, gq1 = 0.f, gk0, gk1 = 0.f;
    gq0 = qg[lane]; gk0 = kg[lane]; if (HD == 128) { gq1 = qg[lane + 64]; gk1 = kg[lane + 64]; }
    const int jj = (HD == 64) ? (lane & 31) : lane;
    const float invf = exp2f(-(float)(jj & (PPA - 1)) * (13.287712379549449f / (float)PPA));
    for (int row0 = row_lo + gw; row0 < row_hi; row0 += R * NGW) {
        int rows[R]; bool ok[R], lat[R]; int h0[R]; float cs[R], sn[R]; bf16* base[R];
        float x1[R][NH], x2[R][NH], ss[R][NH];
#pragma unroll
        for (int q = 0; q < R; ++q) { rows[q] = row0 + q * NGW; ok[q] = rows[q] < row_hi; if (!ok[q]) rows[q] = row0;
            lat[q] = rows[q] >= NCTX; const int tt = (rows[q] - NCTX) & (SEQ - 1);
            cs[q] = 1.f; sn[q] = 0.f;
            if (lat[q]) { const float ang = (float)(jj < PPA ? (tt >> 6) : (tt & 63)) * invf; cs[q] = __cosf(ang); sn[q] = __sinf(ang); }
            h0[q] = (lat[q] || q_for_ctx) ? 0 : nq;
            base[q] = QKV + (size_t)rows[q] * pitch + qcol;
#pragma unroll
            for (int hq = 0; hq < NH; ++hq) { x1[q][hq] = bf2f(base[q][hq * HD + lane]); x2[q][hq] = 0.f; if (HD == 128) x2[q][hq] = bf2f(base[q][hq * HD + lane + 64]); } }
        asm volatile("" ::: "memory");
#pragma unroll
        for (int q = 0; q < R; ++q)
#pragma unroll
            for (int hq = 0; hq < NH; ++hq) ss[q][hq] = x1[q][hq] * x1[q][hq] + x2[q][hq] * x2[q][hq];
#pragma unroll
        for (int o = 1; o < 64; o <<= 1) {
#pragma unroll
            for (int q = 0; q < R; ++q)
#pragma unroll
                for (int hq = 0; hq < NH; ++hq) ss[q][hq] += __shfl_xor(ss[q][hq], o); }
#pragma unroll
        for (int q = 0; q < R; ++q) {
#pragma unroll
            for (int hq = 0; hq < NH; ++hq) if (hq >= h0[q]) {
                const float rs = rsqrtf(ss[q][hq] * (1.f / (float)HD) + EPS);
                if (HD == 64) { const float y = x1[q][hq] * rs * (hq < 8 ? gq0 : gk0); const float pr = __shfl_xor(y, 32);
                    if (ok[q]) base[q][hq * HD + lane] = f2bf(lane < 32 ? y * cs[q] - pr * sn[q] : y * cs[q] + pr * sn[q]); }
                else { const float y1 = x1[q][hq] * rs * (hq < 8 ? gq0 : gk0), y2 = x2[q][hq] * rs * (hq < 8 ? gq1 : gk1);
                    if (ok[q]) { base[q][hq * HD + lane] = f2bf(y1 * cs[q] - y2 * sn[q]); base[q][hq * HD + lane + 64] = f2bf(y2 * cs[q] + y1 * sn[q]); } }
            } }
    }
    constexpr int NV = 2 * HD, TP = NV + 2;
    LAS bf16* tile = (LAS bf16*)lds;
    for (int tk = tile_lo + blockIdx.x; tk < tile_hi; tk += gridDim.x) {
        const int row0 = 64 * tk; int b, key0;
        if (row0 < NCTX) { b = row0 >> 8; key0 = row0 & 255; } else { const int lr = row0 - NCTX; b = lr >> 12; key0 = 256 + (lr & 4095); }
        { constexpr int NIT = 64 * NV / 512; bf16 tv[NIT];
#pragma unroll
          for (int i = 0; i < NIT; ++i) { const int idx = tid + 512 * i, tok = idx / NV, c = idx - tok * NV; tv[i] = QKV[(size_t)(row0 + tok) * pitch + vcol + c]; }
#pragma unroll
          for (int i = 0; i < NIT; ++i) { const int idx = tid + 512 * i, tok = idx / NV, c = idx - tok * NV; tile[tok * TP + c] = tv[i]; } }
        __syncthreads();
        for (int idx = tid; idx < 64 * NV; idx += 512) { const int rr = idx >> 6, key = idx & 63; VT[(size_t)(b * NV + rr) * KVLEN + key0 + key] = tile[key * TP + rr]; }
        __syncthreads();
    }
}

constexpr int MP = 136;
constexpr int ML_VT = 0, ML_VWT = 40 * MP * 2, ML_CT = 2 * 40 * MP * 2, ML_Q = 3 * 40 * MP * 2, ML_K = ML_Q + 128 * MP * 2, ML_KT = ML_K + 128 * MP * 2, ML_SC = ML_KT + 128 * MP * 2;
static_assert(ML_SC + 5120 <= LDS_BYTES, "mLSTM LDS map");
DI void mlstm_item(const Params& p, LAS unsigned char* lds, int item, int tid, int lane, int wave) {
    const int dvq = item & 3, dir = (item >> 2) & 1, head = (item >> 3) & 3, b = item >> 5;
    const bf16* QKV = (const bf16*)(p.ws + WS_BIG); const float* GT = (const float*)(p.ws + WS_GATES);
    float* XC = (float*)(p.ws + WS_XC);
    LAS bf16* VTs = (LAS bf16*)(lds + ML_VT); LAS bf16* VWTs = (LAS bf16*)(lds + ML_VWT); LAS bf16* CTs = (LAS bf16*)(lds + ML_CT);
    LAS bf16* Qs = (LAS bf16*)(lds + ML_Q); LAS bf16* Ks = (LAS bf16*)(lds + ML_K); LAS bf16* KTs = (LAS bf16*)(lds + ML_KT); LAS bf16* Ss = Ks;
    LAS float* sc = (LAS float*)(lds + ML_SC);
    LAS float* s_ic = sc; LAS float* s_fc = sc + 128; LAS float* s_a = sc + 256; LAS float* s_rt = sc + 384; LAS float* s_iw = sc + 512;
    LAS float* s_w = sc + 640; LAS float* s_emt = sc + 768; LAS float* s_den = sc + 896; LAS float* s_misc = sc + 1024;
    const int r = lane & 31, h = lane >> 5, ti = wave >> 1, tj = wave & 1;
    const float KSCALE = 0.08838834764831845f;
    for (int i = tid; i < 40 * MP; i += 512) CTs[i] = 0;
    if (tid < 128) VTs[32 * MP + tid] = 0x3F80;
    f32x16 accC = zero16(); float m = 0.f;
    __syncthreads();
    for (int ci = 0; ci < 34; ++ci) {
        int base;
        if (ci < 2) { const int cc = dir ? 1 - ci : ci; base = b * 256 + cc * 128; }
        else { const int cc = dir ? 31 - (ci - 2) : (ci - 2); base = NCTX + b * 4096 + cc * 128; }
#pragma unroll
        for (int i = 0; i < 4; ++i) { const int id = tid + 512 * i, rr = id >> 4, c = id & 15; const size_t grow = base + (dir ? 127 - rr : rr);
            const bf16* src = QKV + grow * NIN0 + head * 128 + c * 8;
            *(LAS u32x4*)(Qs + rr * MP + c * 8) = *(const u32x4*)src; *(LAS u32x4*)(Ks + rr * MP + c * 8) = *(const u32x4*)(src + 512); }
        { const int rr = tid >> 2, c = tid & 3; const size_t grow = base + (dir ? 127 - rr : rr);
            const u32x4 v = *(const u32x4*)(QKV + grow * NIN0 + 1024 + head * 128 + dvq * 32 + c * 8);
            LAS bf16* d = VTs + (c * 8) * MP + rr;
            d[0] = (bf16)(v.x & 0xffffu); d[MP] = (bf16)(v.x >> 16); d[2 * MP] = (bf16)(v.y & 0xffffu); d[3 * MP] = (bf16)(v.y >> 16);
            d[4 * MP] = (bf16)(v.z & 0xffffu); d[5 * MP] = (bf16)(v.z >> 16); d[6 * MP] = (bf16)(v.w & 0xffffu); d[7 * MP] = (bf16)(v.w >> 16); }
        if (tid < 256) { const int rr = tid & 127; const size_t grow = base + (dir ? 127 - rr : rr); const int gi = (dir ? 2 : 0) + (tid >> 7);
            const float gv = GT[grow * 16 + gi * 4 + head]; if (tid < 128) s_ic[rr] = gv; else s_fc[rr] = gv; }
        __syncthreads();
        { const int d = tid & 127, sg = tid >> 7;
#pragma unroll
            for (int s8 = 0; s8 < 4; ++s8) { const LAS bf16* kp = Ks + (32 * sg + 8 * s8) * MP + d;
                u32x4 o; o.x = (unsigned)kp[0] | ((unsigned)kp[MP] << 16); o.y = (unsigned)kp[2 * MP] | ((unsigned)kp[3 * MP] << 16);
                o.z = (unsigned)kp[4 * MP] | ((unsigned)kp[5 * MP] << 16); o.w = (unsigned)kp[6 * MP] | ((unsigned)kp[7 * MP] << 16);
                *(LAS u32x4*)(KTs + d * MP + 32 * sg + 8 * s8) = o; } }
        if (wave == 0) {
            const float f0 = s_fc[2 * lane], f1 = s_fc[2 * lane + 1], i0 = s_ic[2 * lane], i1 = s_ic[2 * lane + 1];
            float S = f0 + f1;
#pragma unroll
            for (int o = 1; o < 64; o <<= 1) { const float t = __shfl_up(S, o); if (lane >= o) S += t; }
            const float bc1 = S, bc0 = S - f1, a0 = i0 - bc0, a1 = i1 - bc1;
            float P = fmaxf(a0, a1);
#pragma unroll
            for (int o = 1; o < 64; o <<= 1) { const float t = __shfl_up(P, o); if (lane >= o) P = fmaxf(P, t); }
            float Pex = __shfl_up(P, 1); if (lane == 0) Pex = -INFINITY;
            const float pm0 = fmaxf(Pex, a0), pm1 = P;
            const float blast = __shfl(bc1, 63), Mall = __shfl(P, 63);
            const float mnew = blast + fmaxf(m, Mall);
            const float rt0 = -fmaxf(m, pm0), rt1 = -fmaxf(m, pm1);
            s_a[2 * lane] = a0; s_a[2 * lane + 1] = a1; s_rt[2 * lane] = rt0; s_rt[2 * lane + 1] = rt1;
            s_iw[2 * lane] = __expf(m + rt0); s_iw[2 * lane + 1] = __expf(m + rt1);
            s_w[2 * lane] = __expf(a0 + blast - mnew) * KSCALE; s_w[2 * lane + 1] = __expf(a1 + blast - mnew) * KSCALE;
            s_emt[2 * lane] = __expf(rt0 - bc0); s_emt[2 * lane + 1] = __expf(rt1 - bc1);
            if (lane == 0) { s_misc[0] = __expf(blast + m - mnew); s_misc[1] = mnew; }
        }
        __syncthreads();
        const float carry = s_misc[0], mnew = s_misc[1];
        for (int idx = tid; idx < 33 * 128; idx += 512) { const int e = idx >> 7, s = idx & 127; VWTs[e * MP + s] = f2bf(bf2f(VTs[e * MP + s]) * s_w[s]); }
        float sv[2][16];
#pragma unroll
        for (int tt = 0; tt < 2; ++tt) { const int tjs = (wave & 1) * 2 + tt;
            if (tjs <= ti) { f32x16 acc = zero16(); mma32(acc, Qs + 32 * ti * MP, MP, Ks + 32 * tjs * MP, MP, 128, lane);
                const int scol = 32 * tjs + r; const float as = s_a[scol];
#pragma unroll
                for (int i = 0; i < 16; ++i) { const int trow = 32 * ti + crow(i, h); const float e = (scol <= trow) ? __expf(as + s_rt[trow]) : 0.f; sv[tt][i] = acc[i] * KSCALE * e; } } }
        __syncthreads();
#pragma unroll
        for (int tt = 0; tt < 2; ++tt) { const int tjs = (wave & 1) * 2 + tt;
            if (tjs <= ti) { const int scol = 32 * tjs + r;
#pragma unroll
                for (int i = 0; i < 16; ++i) Ss[(32 * ti + crow(i, h)) * MP + scol] = f2bf(sv[tt][i]); } }
        __syncthreads();
        f32x16 a1 = zero16(), a2 = zero16(), up = zero16();
        mma32(a1, Qs + 32 * ti * MP, MP, CTs + 32 * tj * MP, MP, 128, lane);
        mma32(a2, Ss + 32 * ti * MP, MP, VTs + 32 * tj * MP, MP, 32 * (ti + 1), lane);
        float num[16];
#pragma unroll
        for (int i = 0; i < 16; ++i) num[i] = s_iw[32 * ti + crow(i, h)] * a1[i] + a2[i];
        if (tj == 1 && r == 0) {
#pragma unroll
            for (int i = 0; i < 16; ++i) s_den[32 * ti + crow(i, h)] = num[i]; }
        mma32(up, KTs + 32 * ti * MP, MP, VWTs + 32 * tj * MP, MP, 128, lane);
#pragma unroll
        for (int i = 0; i < 16; ++i) accC[i] = carry * accC[i] + up[i];
        __syncthreads();
        if (tj == 0) {
#pragma unroll
            for (int i = 0; i < 16; ++i) { const int trow = 32 * ti + crow(i, h); const float hv = num[i] / fmaxf(fabsf(s_den[trow]), s_emt[trow]);
                const int grow = base + (dir ? 127 - trow : trow);
                float* dst = grow < NCTX ? XC + (size_t)grow * DM : p.out + (size_t)(grow - NCTX) * DM;
                dst[dir * 512 + head * 128 + dvq * 32 + r] = hv; } }
        if (tj == 0 || r == 0) {
#pragma unroll
            for (int g = 0; g < 4; ++g) { u32x2 o; o.x = cvtpk(accC[4 * g], accC[4 * g + 1]); o.y = cvtpk(accC[4 * g + 2], accC[4 * g + 3]);
                *(LAS u32x2*)(CTs + (32 * tj + r) * MP + 32 * ti + 8 * g + 4 * h) = o; } }
        m = mnew;
    }
    __syncthreads();
}


constexpr int NCH = 34, UROWS = 129;
constexpr size_t WS_MSC = WS_GATES + 2560 * 1024;
DI int chunk_base(int b, int cp) { return cp < 2 ? b * CTXL + cp * 128 : NCTX + b * SEQ + (cp - 2) * 128; }
DI float shfl_up_l(float v, int o, int lane) { return __int_as_float(__builtin_amdgcn_ds_bpermute((lane >= o ? lane - o : lane) << 2, __float_as_int(v))); }
DI void chunk_scan(int dir, const LAS float* ic, const LAS float* fc, int lane, float& a0, float& a1, float& pm0, float& pm1, float& bc0, float& bc1, float& blast, float& Mall, int& u0, int& u1) {
    u0 = dir ? 127 - 2 * lane : 2 * lane; u1 = dir ? u0 - 1 : u0 + 1;
    const float f0 = fc[u0], f1 = fc[u1], i0 = ic[u0], i1 = ic[u1];
    float S = f0 + f1;
#pragma unroll
    for (int o = 1; o < 64; o <<= 1) { const float t = shfl_up_l(S, o, lane); if (lane >= o) S += t; }
    bc1 = S; bc0 = S - f1; a0 = i0 - bc0; a1 = i1 - bc1;
    float P = fmaxf(a0, a1);
#pragma unroll
    for (int o = 1; o < 64; o <<= 1) { const float t = shfl_up_l(P, o, lane); if (lane >= o) P = fmaxf(P, t); }
    float Pex = shfl_up_l(P, 1, lane); if (lane == 0) Pex = -INFINITY;
    pm0 = fmaxf(Pex, a0); pm1 = P;
    blast = __int_as_float(__builtin_amdgcn_readlane(__float_as_int(bc1), 63)); Mall = __int_as_float(__builtin_amdgcn_readlane(__float_as_int(P), 63));
}
constexpr int X_VT = 0, X_VWT = UROWS * MP * 2, X_KT = 2 * UROWS * MP * 2, X_SC = X_KT + 128 * MP * 2;
DI void mlstm_x1(const Params& p, LAS unsigned char* lds, int item, int tid_in, int lane_in, int wave) {
    int tid = tid_in; asm volatile("" : "+v"(tid)); const int lane = tid & 63; (void)lane_in;
    const int cp = item % NCH, head = (item / NCH) & 3, b = item / (NCH * 4);
    const bf16* QKV = (const bf16*)(p.ws + WS_BIG); const float* GT = (const float*)(p.ws + WS_GATES);
    bf16* UT = (bf16*)p.out; float* SC = (float*)(p.ws + WS_MSC);
    LAS bf16* VTs = (LAS bf16*)(lds + X_VT); LAS bf16* VWTs = (LAS bf16*)(lds + X_VWT); LAS bf16* KTs = (LAS bf16*)(lds + X_KT);
    LAS float* sc = (LAS float*)(lds + X_SC);
    LAS float* s_w = sc + 512;
    const int base = chunk_base(b, cp);
    const int r = lane & 31, h = lane >> 5;
    const float KSCALE = 0.08838834764831845f;
    __syncthreads();
#pragma unroll
    for (int i = 0; i < 4; ++i) { const int id = tid + 512 * i, rr = id & 127, c = id >> 7;
        const bf16* src = QKV + (size_t)(base + rr) * NIN0 + head * 128 + c * 8;
        const u32x4 k = *(const u32x4*)(src + 512), v = *(const u32x4*)(src + 1024);
        LAS bf16* dk = KTs + (c * 8) * MP + rr; LAS bf16* dv = VTs + (c * 8) * MP + rr;
        dk[0] = (bf16)(k.x & 0xffffu); dk[MP] = (bf16)(k.x >> 16); dk[2 * MP] = (bf16)(k.y & 0xffffu); dk[3 * MP] = (bf16)(k.y >> 16);
        dk[4 * MP] = (bf16)(k.z & 0xffffu); dk[5 * MP] = (bf16)(k.z >> 16); dk[6 * MP] = (bf16)(k.w & 0xffffu); dk[7 * MP] = (bf16)(k.w >> 16);
        dv[0] = (bf16)(v.x & 0xffffu); dv[MP] = (bf16)(v.x >> 16); dv[2 * MP] = (bf16)(v.y & 0xffffu); dv[3 * MP] = (bf16)(v.y >> 16);
        dv[4 * MP] = (bf16)(v.z & 0xffffu); dv[5 * MP] = (bf16)(v.z >> 16); dv[6 * MP] = (bf16)(v.w & 0xffffu); dv[7 * MP] = (bf16)(v.w >> 16); }
    { const int u = tid & 127, gi = tid >> 7; sc[gi * 128 + u] = GT[(size_t)(base + u) * 16 + gi * 4 + head]; }
    __syncthreads();
    if (wave < 2) { const int dir = wave; float a0, a1, pm0, pm1, bc0, bc1, blast, Mall; int u0, u1;
        chunk_scan(dir, sc + dir * 256, sc + dir * 256 + 128, lane, a0, a1, pm0, pm1, bc0, bc1, blast, Mall, u0, u1);
        s_w[dir * 128 + u0] = __expf(a0 - Mall) * KSCALE; s_w[dir * 128 + u1] = __expf(a1 - Mall) * KSCALE;
        if (lane == 0) { float* o = SC + ((size_t)((b * 4 + head) * 2 + dir) * NCH + cp) * 2; o[0] = blast; o[1] = Mall; } }
    __syncthreads();
    for (int dir = 0; dir < 2; ++dir) {
        for (int idx = tid; idx < UROWS * 16; idx += 512) { const int e = idx >> 4, c8 = (idx & 15) * 8;
            const u32x4 v = e < 128 ? *(const LAS u32x4*)(VTs + e * MP + c8) : (u32x4){0x3F803F80u, 0x3F803F80u, 0x3F803F80u, 0x3F803F80u};
            const f32x4 w0 = *(const LAS f32x4*)(s_w + dir * 128 + c8), w1 = *(const LAS f32x4*)(s_w + dir * 128 + c8 + 4);
            u32x4 o; o.x = cvtpk(__uint_as_float(v.x << 16) * w0[0], __uint_as_float(v.x & 0xffff0000u) * w0[1]); o.y = cvtpk(__uint_as_float(v.y << 16) * w0[2], __uint_as_float(v.y & 0xffff0000u) * w0[3]);
            o.z = cvtpk(__uint_as_float(v.z << 16) * w1[0], __uint_as_float(v.z & 0xffff0000u) * w1[1]); o.w = cvtpk(__uint_as_float(v.w << 16) * w1[2], __uint_as_float(v.w & 0xffff0000u) * w1[3]);
            *(LAS u32x4*)(VWTs + e * MP + c8) = o; }
        __syncthreads();
        bf16* Uo = UT + ((size_t)((b * 4 + head) * 2 + dir) * NCH + cp) * (UROWS * 128);
        for (int tile = wave; tile < 20; tile += 8) { const int td = tile & 3, te = tile >> 2;
            f32x16 acc = zero16();
            const LAS bf16* bp = VWTs + (te < 4 ? (32 * te + r) : 128) * MP + 8 * h; const LAS bf16* ap = KTs + (32 * td + r) * MP + 8 * h;
#pragma unroll
            for (int k0 = 0; k0 < 128; k0 += 16) acc = MFMA32(*(const LAS bf16x8*)(ap + k0), *(const LAS bf16x8*)(bp + k0), acc);
            if (te < 4 || r == 0) { bf16* dst = Uo + (size_t)(te < 4 ? 32 * te + r : 128) * 128 + 32 * td + 4 * h;
#pragma unroll
                for (int g = 0; g < 4; ++g) { u32x2 o; o.x = cvtpk(acc[4 * g], acc[4 * g + 1]); o.y = cvtpk(acc[4 * g + 2], acc[4 * g + 3]); *(u32x2*)(dst + 8 * g) = o; } } }
        __syncthreads();
    }
}
DI void mlstm_x2(const Params& p, int tid) {
    const bf16* __restrict__ UT = (const bf16*)p.out; const float* __restrict__ SC = (const float*)(p.ws + WS_MSC); float* __restrict__ MST = (float*)(p.ws + WS_MSC) + 64 * NCH * 2;
    bf16* __restrict__ CT = (bf16*)(p.ws + WS_BIG) + (size_t)MTOT * NIN0;
    constexpr int SZ = UROWS * 128;
    for (int item = blockIdx.x; item < 256; item += gridDim.x) {
        const int chain = item >> 2, part = item & 3, dir = chain & 1;
        const int g1 = part * 512 + tid; const bool has2 = (part == 0) && (tid < 16); const int g2 = 2048 + (tid & 15);
        float c[8], c2[8];
#pragma unroll
        for (int j = 0; j < 8; ++j) { c[j] = 0.f; c2[j] = 0.f; }
        float m = 0.f;
        const size_t cb = (size_t)chain * NCH;
#pragma unroll 1
        for (int half = 0; half < 2; ++half) {
            u32x4 uv[17], uw[17]; f32x2 scv[17];
#pragma unroll
            for (int j = 0; j < 17; ++j) { const int ci = half * 17 + j, cp = dir ? (ci < 2 ? 1 - ci : 35 - ci) : ci;
                uv[j] = *(const u32x4*)(UT + (cb + cp) * SZ + g1 * 8);
                uw[j] = has2 ? *(const u32x4*)(UT + (cb + cp) * SZ + g2 * 8) : (u32x4){0u, 0u, 0u, 0u};
                scv[j] = *(const f32x2*)(SC + (cb + cp) * 2); }
            asm volatile("" ::: "memory");
#pragma unroll
            for (int j = 0; j < 17; ++j) { const int ci = half * 17 + j, cp = dir ? (ci < 2 ? 1 - ci : 35 - ci) : ci;
                const float blast = scv[j].x, Mall = scv[j].y;
                u32x4 o; o.x = cvtpk(c[0], c[1]); o.y = cvtpk(c[2], c[3]); o.z = cvtpk(c[4], c[5]); o.w = cvtpk(c[6], c[7]);
                *(u32x4*)(CT + (cb + cp) * SZ + g1 * 8) = o;
                if (has2) { u32x4 o2; o2.x = cvtpk(c2[0], c2[1]); o2.y = cvtpk(c2[2], c2[3]); o2.z = cvtpk(c2[4], c2[5]); o2.w = cvtpk(c2[6], c2[7]); *(u32x4*)(CT + (cb + cp) * SZ + g2 * 8) = o2; }
                if (part == 0 && tid == 0) MST[cb + cp] = m;
                const float mnew = blast + fmaxf(m, Mall), cw = __expf(blast + m - mnew), uwt = __expf(blast + Mall - mnew);
                const u32x4 a = uv[j], b2 = uw[j];
                c[0] = cw * c[0] + uwt * __uint_as_float(a.x << 16); c[1] = cw * c[1] + uwt * __uint_as_float(a.x & 0xffff0000u);
                c[2] = cw * c[2] + uwt * __uint_as_float(a.y << 16); c[3] = cw * c[3] + uwt * __uint_as_float(a.y & 0xffff0000u);
                c[4] = cw * c[4] + uwt * __uint_as_float(a.z << 16); c[5] = cw * c[5] + uwt * __uint_as_float(a.z & 0xffff0000u);
                c[6] = cw * c[6] + uwt * __uint_as_float(a.w << 16); c[7] = cw * c[7] + uwt * __uint_as_float(a.w & 0xffff0000u);
                c2[0] = cw * c2[0] + uwt * __uint_as_float(b2.x << 16); c2[1] = cw * c2[1] + uwt * __uint_as_float(b2.x & 0xffff0000u);
                c2[2] = cw * c2[2] + uwt * __uint_as_float(b2.y << 16); c2[3] = cw * c2[3] + uwt * __uint_as_float(b2.y & 0xffff0000u);
                c2[4] = cw * c2[4] + uwt * __uint_as_float(b2.z << 16); c2[5] = cw * c2[5] + uwt * __uint_as_float(b2.z & 0xffff0000u);
                c2[6] = cw * c2[6] + uwt * __uint_as_float(b2.w << 16); c2[7] = cw * c2[7] + uwt * __uint_as_float(b2.w & 0xffff0000u);
                m = mnew; }
        }
    }
}
constexpr int Y_VT = 0, Y_S = UROWS * MP * 2, Y_C = Y_S + 128 * MP * 2, Y_SC = Y_C + 2 * UROWS * MP * 2;
static_assert(Y_SC + 7168 <= LDS_BYTES - 16, "X3 LDS map");
DI void mlstm_x3(const Params& p, LAS unsigned char* lds, int item, int tid_in, int lane_in, int wave) {
    (void)tid_in; (void)lane_in;
    int tid = wave * 64 + fresh_lane(); asm volatile("" : "+v"(tid)); const int lane = tid & 63;
    const int cp = item % NCH, head = (item / NCH) & 3, b = item / (NCH * 4);
    const bf16* QKV = (const bf16*)(p.ws + WS_BIG); const float* GT = (const float*)(p.ws + WS_GATES);
    const float* MST = (const float*)(p.ws + WS_MSC) + 64 * NCH * 2;
    const bf16* CT = (const bf16*)(p.ws + WS_BIG) + (size_t)MTOT * NIN0;
    bf16* OC = (bf16*)(p.ws + WS_OCAT);
    { size_t z0 = 0; asm volatile("" : "+s"(z0)); QKV += z0; CT += z0; OC += z0; GT += z0; }
    LAS bf16* VTs = (LAS bf16*)(lds + Y_VT); LAS bf16* Ss = (LAS bf16*)(lds + Y_S);
    LAS float* sc = (LAS float*)(lds + Y_SC);
    LAS float* s_dir = sc + 512; LAS float* s_ssq = sc + 512 + 1024;
    LAS bf16* Cs = (LAS bf16*)(lds + Y_C);
    const int base = chunk_base(b, cp);
    const int r_ = lane & 31, h = lane >> 5, ti = wave >> 1, eh = wave & 1;
    const float KSCALE = 0.08838834764831845f;
    __syncthreads();
    const float mst0 = MST[(size_t)((b * 4 + head) * 2) * NCH + cp], mst1 = MST[(size_t)((b * 4 + head) * 2 + 1) * NCH + cp];
    u32x4 vr[4];
#pragma unroll
    for (int i = 0; i < 4; ++i) { const int id = tid + 512 * i, rr = id & 127, c = id >> 7; vr[i] = *(const u32x4*)(QKV + (size_t)(base + rr) * NIN0 + 1024 + head * 128 + c * 8); }
    const float gval = GT[(size_t)(base + (tid & 127)) * 16 + (tid >> 7) * 4 + head];
    u32x4 cb[9];
    { const bf16* C0 = CT + ((size_t)((b * 4 + head) * 2) * NCH + cp) * (UROWS * 128);
#pragma unroll
      for (int i = 0; i < 9; ++i) { const int id = tid + 512 * i; const int idc = id < 2 * UROWS * 16 ? id : 0; const int dd = idc >= UROWS * 16, q = idc - dd * UROWS * 16;
          cb[i] = *(const u32x4*)(C0 + (size_t)dd * NCH * (UROWS * 128) + q * 8); } }
    bf16x8 qf[8], kf[2][8];
    { const bf16* qp = QKV + (size_t)(base + 32 * ti + r_) * NIN0 + head * 128 + 8 * h;
#pragma unroll
        for (int ks = 0; ks < 8; ++ks) qf[ks] = *(const bf16x8*)(qp + 16 * ks); }
#pragma unroll
    for (int tt = 0; tt < 2; ++tt) { const bf16* kp = QKV + (size_t)(base + 32 * (2 * eh + tt) + r_) * NIN0 + 512 + head * 128 + 8 * h;
#pragma unroll
        for (int ks = 0; ks < 8; ++ks) kf[tt][ks] = *(const bf16x8*)(kp + 16 * ks); }
    asm volatile("" ::: "memory");
#pragma unroll
    for (int i = 0; i < 4; ++i) { const int id = tid + 512 * i, rr = id & 127, c = id >> 7; const u32x4 v = vr[i];
        LAS bf16* dv = VTs + (c * 8) * MP + rr;
        dv[0] = (bf16)(v.x & 0xffffu); dv[MP] = (bf16)(v.x >> 16); dv[2 * MP] = (bf16)(v.y & 0xffffu); dv[3 * MP] = (bf16)(v.y >> 16);
        dv[4 * MP] = (bf16)(v.z & 0xffffu); dv[5 * MP] = (bf16)(v.z >> 16); dv[6 * MP] = (bf16)(v.w & 0xffffu); dv[7 * MP] = (bf16)(v.w >> 16); }
    if (tid < 128) VTs[128 * MP + tid] = 0x3F80;
    sc[(tid >> 7) * 128 + (tid & 127)] = gval;
#pragma unroll
    for (int i = 0; i < 9; ++i) { const int id = tid + 512 * i; if (id < 2 * UROWS * 16) { const int dd = id >= UROWS * 16, q = id - dd * UROWS * 16, e = q >> 4, c8 = (q & 15) * 8;
        *(LAS u32x4*)(Cs + (dd * UROWS + e) * MP + c8) = cb[i]; } }
    unsigned spk[2][8];
#pragma unroll
    for (int tt = 0; tt < 2; ++tt) { f32x16 sraw = zero16();
#pragma unroll
        for (int ks = 0; ks < 8; ++ks) sraw = MFMA32(qf[ks], kf[tt][ks], sraw);
#pragma unroll
        for (int i = 0; i < 8; ++i) spk[tt][i] = cvtpk(sraw[2 * i], sraw[2 * i + 1]); }
    __syncthreads();
    if (wave < 2) { const int dir = wave; float a0, a1, pm0, pm1, bc0, bc1, blast, Mall; int u0, u1;
        chunk_scan(dir, sc + dir * 256, sc + dir * 256 + 128, lane, a0, a1, pm0, pm1, bc0, bc1, blast, Mall, u0, u1);
        const float m = dir ? mst1 : mst0;
        const float rt0 = -fmaxf(m, pm0), rt1 = -fmaxf(m, pm1);
        LAS float* d = s_dir + dir * 512;
        d[u0] = a0; d[u1] = a1; d[128 + u0] = rt0; d[128 + u1] = rt1; d[256 + u0] = __expf(m + rt0); d[256 + u1] = __expf(m + rt1);
        d[384 + u0] = __expf(rt0 - bc0); d[384 + u1] = __expf(rt1 - bc1); }
    f32x16 hs[2]; hs[0] = zero16(); hs[1] = zero16();
#pragma unroll 1
    for (int dir = 0; dir < 2; ++dir) {
        __syncthreads();
        const LAS float* d = s_dir + dir * 512;
        int r = r_; asm volatile("" : "+v"(r));
#pragma unroll
        for (int tt = 0; tt < 2; ++tt) { const int tj = 2 * eh + tt; const bool need = dir ? (tj >= ti) : (tj <= ti);
            if (need) {
                const int scol = 32 * tj + r; const float as = d[scol];
#pragma unroll
                for (int i = 0; i < 16; ++i) { const int trow = 32 * ti + crow(i, h); const bool ok = dir ? (scol >= trow) : (scol <= trow);
                    const float e = ok ? __expf(as + d[128 + trow]) * KSCALE : 0.f;
                    const float sv = (i & 1) ? __uint_as_float(spk[tt][i >> 1] & 0xffff0000u) : __uint_as_float(spk[tt][i >> 1] << 16); Ss[trow * MP + scol] = f2bf(sv * e); } } }
        __syncthreads();
        asm volatile("" ::: "memory");
        const LAS bf16* Cb = Cs + dir * UROWS * MP;
        const int klo = dir ? 32 * ti : 0, khi = dir ? 128 : 32 * (ti + 1);
        const LAS bf16* sp = Ss + (32 * ti + r) * MP + 8 * h;
        {
            f32x16 a1 = zero16(), a2 = zero16();
            const LAS bf16* cpp = Cb + 128 * MP + 8 * h;
#pragma unroll
            for (int ks = 0; ks < 8; ++ks) a1 = MFMA32(qf[ks], *(const LAS bf16x8*)(cpp + 16 * ks), a1);
            const LAS bf16* vp = VTs + 128 * MP + 8 * h;
#pragma unroll 1
            for (int k0 = klo; k0 < khi; k0 += 16) a2 = MFMA32(*(const LAS bf16x8*)(sp + k0), *(const LAS bf16x8*)(vp + k0), a2);
            if (r == 0) {
#pragma unroll
            for (int i = 0; i < 16; ++i) { const int trow = 32 * ti + crow(i, h); sc[trow] = 1.f / fmaxf(fabsf(d[256 + trow] * a1[i] + a2[i]), d[384 + trow]); } }
        }
        asm volatile("" ::: "memory");
#pragma unroll
        for (int tt = 0; tt < 2; ++tt) { const int te = 2 * eh + tt;
            f32x16 a1 = zero16(), a2 = zero16();
            const LAS bf16* cpp = Cb + (32 * te + r) * MP + 8 * h;
#pragma unroll
            for (int ks = 0; ks < 8; ++ks) a1 = MFMA32(qf[ks], *(const LAS bf16x8*)(cpp + 16 * ks), a1);
            const LAS bf16* vp = VTs + (32 * te + r) * MP + 8 * h;
#pragma unroll 1
            for (int k0 = klo; k0 < khi; k0 += 16) a2 = MFMA32(*(const LAS bf16x8*)(sp + k0), *(const LAS bf16x8*)(vp + k0), a2);
#pragma unroll
            for (int i = 0; i < 16; ++i) { const int trow = 32 * ti + crow(i, h); hs[tt][i] += (d[256 + trow] * a1[i] + a2[i]) * sc[trow]; }
            asm volatile("" ::: "memory"); }
    }
#pragma unroll
    for (int i = 0; i < 16; ++i) { float q = hs[0][i] * hs[0][i] + hs[1][i] * hs[1][i];
#pragma unroll
        for (int o = 1; o < 32; o <<= 1) q += __int_as_float(__builtin_amdgcn_ds_bpermute((lane ^ o) << 2, __float_as_int(q)));
        if (r_ == 0) s_ssq[(32 * ti + crow(i, h)) * 2 + eh] = q; }
    __syncthreads();
    LAS float* Hs = (LAS float*)(lds + Y_C);
#pragma unroll
    for (int i = 0; i < 16; ++i) { const int trow = 32 * ti + crow(i, h);
        const float rs = rsqrtf((s_ssq[trow * 2] + s_ssq[trow * 2 + 1]) * (1.f / 128.f) + EPS);
        Hs[trow * 132 + 32 * (2 * eh) + r_] = hs[0][i] * rs; Hs[trow * 132 + 32 * (2 * eh + 1) + r_] = hs[1][i] * rs; }
    __syncthreads();
    const float* gn = p.in[10] + head * 128;
    const int c8o = (tid & 15) * 8;
    const f32x4 g0 = *(const f32x4*)(gn + c8o), g1 = *(const f32x4*)(gn + c8o + 4);
    u32x4 oav[4];
#pragma unroll
    for (int it = 0; it < 4; ++it) { const int row = (tid + 512 * it) >> 4; oav[it] = *(const u32x4*)(QKV + (size_t)(base + row) * NIN0 + 1536 + head * 128 + c8o); }
    asm volatile("" ::: "memory");
#pragma unroll
    for (int it = 0; it < 4; ++it) { const int row = (tid + 512 * it) >> 4; const size_t grow = base + row; const u32x4 oa = oav[it];
        const f32x4 v0 = *(const LAS f32x4*)(Hs + row * 132 + c8o), v1 = *(const LAS f32x4*)(Hs + row * 132 + c8o + 4);
        float o[8]; o[0] = __uint_as_float(oa.x << 16); o[1] = __uint_as_float(oa.x & 0xffff0000u); o[2] = __uint_as_float(oa.y << 16); o[3] = __uint_as_float(oa.y & 0xffff0000u);
        o[4] = __uint_as_float(oa.z << 16); o[5] = __uint_as_float(oa.z & 0xffff0000u); o[6] = __uint_as_float(oa.w << 16); o[7] = __uint_as_float(oa.w & 0xffff0000u);
        u32x4 w;
        w.x = cvtpk(v0[0] * g0[0] / (1.f + __expf(-o[0])), v0[1] * g0[1] / (1.f + __expf(-o[1]))); w.y = cvtpk(v0[2] * g0[2] / (1.f + __expf(-o[2])), v0[3] * g0[3] / (1.f + __expf(-o[3])));
        w.z = cvtpk(v1[0] * g1[0] / (1.f + __expf(-o[4])), v1[1] * g1[1] / (1.f + __expf(-o[5]))); w.w = cvtpk(v1[2] * g1[2] / (1.f + __expf(-o[6])), v1[3] * g1[3] / (1.f + __expf(-o[7])));
        *(u32x4*)(OC + grow * DM + head * 128 + c8o) = w; }
}

template <int D, int MODE, int NSUB>
DI void attn_item(const bf16* QKV, int pitch, int qcol0, int kcol0, const bf16* VT, bf16* O, int ocol0, const float* sink,
                  LAS unsigned char* lds, int item, int tid_in, int lane_in, int wave) {
    (void)tid_in; (void)lane_in;
    int tid = wave * 64 + fresh_lane(); asm volatile("" : "+v"(tid)); const int lane = tid & 63;
    constexpr int KT = 64 * NSUB, KP = D + 8, VP = KT + 4, KBYTES = KT * KP * 2, VBYTES = D * VP * 2, BUF = KBYTES + VBYTES, NPT = NSUB * D / 64, NKS = D / 16, NDT = D / 32, CPR = D / 8, VCR = 8 * NSUB;
    static_assert(2 * BUF <= LDS_BYTES - 16, "attention LDS");
    const int r = lane & 31, h = lane >> 5;
    int b, kvh, head, qrow, qpos = 0, nt, wstart = 0;
    if (MODE == 0) { const int qb = item & 15; head = (item >> 4) & 7; b = item >> 7; kvh = head >> 2; qrow = NCTX + b * SEQ + qb * 256 + 32 * wave; nt = KVLEN / KT; }
    else if (MODE == 1) { const int nb = item & 31, hp = (item >> 5) & 1; kvh = (item >> 6) & 1; b = item >> 7; head = kvh * 4 + hp * 2 + (wave >> 2);
        qpos = nb * 128 + (wave & 3) * 32 + r; qrow = NCTX + b * SEQ + nb * 128 + (wave & 3) * 32;
        wstart = nb > 0 ? (nb - 1) * 128 : 0; const int wend = nb < 31 ? (nb + 2) * 128 : SEQ; nt = (CTXL + wend - wstart) / KT; }
    else { const int qh = item & 1, hp = (item >> 1) & 1; kvh = (item >> 2) & 1; b = item >> 3; head = kvh * 4 + hp * 2 + (wave >> 2); qrow = b * 256 + qh * 128 + (wave & 3) * 32; nt = CTXL / KT; }
    const bf16* VTb = VT + (size_t)(b * 2 + kvh) * D * KVLEN;
    const int kcol = kcol0 + kvh * D;
    bf16x8 qf[NKS];
    { const bf16* qp = QKV + (size_t)(qrow + r) * pitch + qcol0 + head * D + 8 * h;
#pragma unroll
        for (int ks = 0; ks < NKS; ++ks) qf[ks] = *(const bf16x8*)(qp + 16 * ks); }
    const float scl = (D == 64 ? 0.125f : 0.08838834764831845f) * LOG2E;
    constexpr float THR2 = 11.0f;
    float mrun, lrun;
    if (MODE == 0) { mrun = -INFINITY; lrun = 0.f; } else { mrun = sink[head] * LOG2E; lrun = h == 0 ? 1.f : 0.f; }
    f32x16 o[NDT];
#pragma unroll
    for (int dt = 0; dt < NDT; ++dt) o[dt] = zero16();
    u32x4 kr[NPT], vr[NPT];
#define ATT_TILE(t, krow0, vkey0) do { const int key0 = KT * (t); if (MODE == 0) { krow0 = key0 < CTXL ? b * CTXL + key0 : NCTX + b * SEQ + key0 - CTXL; vkey0 = key0; } \
        else if (key0 < CTXL) { krow0 = b * CTXL + key0; vkey0 = key0; } else { const int kp_ = wstart + key0 - CTXL; krow0 = NCTX + b * SEQ + kp_; vkey0 = CTXL + kp_; } } while (0)
#define ATT_LOAD(t) do { int krow0, vkey0; ATT_TILE(t, krow0, vkey0); _Pragma("unroll") for (int i = 0; i < NPT; ++i) { const int id = tid + 512 * i; \
        kr[i] = *(const u32x4*)(QKV + (size_t)(krow0 + id / CPR) * pitch + kcol + (id % CPR) * 8); \
        vr[i] = *(const u32x4*)(VTb + (size_t)(id / VCR) * KVLEN + vkey0 + (id % VCR) * 8); } } while (0)
#define ATT_STORE(bi) do { LAS bf16* Kd = (LAS bf16*)(lds + (bi) * BUF); LAS bf16* Vd = (LAS bf16*)(lds + (bi) * BUF + KBYTES); _Pragma("unroll") for (int i = 0; i < NPT; ++i) { const int id = tid + 512 * i; \
        *(LAS u32x4*)(Kd + (id / CPR) * KP + (id % CPR) * 8) = kr[i]; { LAS u32x2* vd_ = (LAS u32x2*)(Vd + (id / VCR) * VP + (id % VCR) * 8); vd_[0] = (u32x2){vr[i].x, vr[i].y}; vd_[1] = (u32x2){vr[i].z, vr[i].w}; } } } while (0)
    ATT_LOAD(0); ATT_STORE(0);
    __syncthreads();
    for (int t = 0; t < nt; ++t) {
        if (t + 1 < nt) ATT_LOAD(t + 1);
        const LAS bf16* Kt = (const LAS bf16*)(lds + (t & 1) * BUF); const LAS bf16* Vt = (const LAS bf16*)(lds + (t & 1) * BUF + KBYTES);
#pragma unroll
        for (int sub = 0; sub < NSUB; ++sub) {
        f32x16 s[2];
#pragma unroll
        for (int q = 0; q < 2; ++q) { s[q] = zero16(); const LAS bf16* kp = Kt + (64 * sub + 32 * q + r) * KP + 8 * h;
#pragma unroll
            for (int ks = 0; ks < NKS; ++ks) s[q] = MFMA32(*(const LAS bf16x8*)(kp + 16 * ks), qf[ks], s[q]); }
        if (MODE == 1 && KT * t >= CTXL) { const int kp0 = wstart + KT * t + 64 * sub - CTXL - qpos;
#pragma unroll
            for (int q = 0; q < 2; ++q)
#pragma unroll
                for (int i = 0; i < 16; ++i) { const int d0 = kp0 + 32 * q + crow(i, h); if (d0 > 128 || d0 < -128) s[q][i] = -INFINITY; } }
        float mx = s[0][0];
#pragma unroll
        for (int q = 0; q < 2; ++q)
#pragma unroll
            for (int i = 0; i < 16; ++i) mx = fmaxf(mx, s[q][i]);
        mx = fmaxf(mx, __shfl_xor(mx, 32)) * scl;
        if (!__all(mx - mrun <= THR2)) {
            const float mnew = fmaxf(mrun, mx), alpha = __builtin_amdgcn_exp2f(mrun - mnew);
            lrun *= alpha; mrun = mnew;
#pragma unroll
            for (int dt = 0; dt < NDT; ++dt)
#pragma unroll
                for (int i = 0; i < 16; ++i) o[dt][i] *= alpha;
        }
        float ls = 0.f; const float nm = -mrun;
#pragma unroll
        for (int q = 0; q < 2; ++q)
#pragma unroll
            for (int i = 0; i < 16; ++i) { s[q][i] = __builtin_amdgcn_exp2f(fmaf(s[q][i], scl, nm)); ls += s[q][i]; }
        lrun += ls;
#pragma unroll
        for (int q = 0; q < 2; ++q)
#pragma unroll
            for (int s2 = 0; s2 < 2; ++s2) {
                u32x4 pw; pw.x = cvtpk(s[q][8 * s2], s[q][8 * s2 + 1]); pw.y = cvtpk(s[q][8 * s2 + 2], s[q][8 * s2 + 3]); pw.z = cvtpk(s[q][8 * s2 + 4], s[q][8 * s2 + 5]); pw.w = cvtpk(s[q][8 * s2 + 6], s[q][8 * s2 + 7]);
                const bf16x8 pb = __builtin_bit_cast(bf16x8, pw);
#pragma unroll
                for (int dt = 0; dt < NDT; ++dt) { const LAS bf16* vp = Vt + (32 * dt + r) * VP + 64 * sub + 32 * q + 16 * s2 + 4 * h;
                    const s16x4 lo = *(const LAS s16x4*)vp, hi = *(const LAS s16x4*)(vp + 8);
                    const bf16x8 a = __builtin_shufflevector(lo, hi, 0, 1, 2, 3, 4, 5, 6, 7);
                    o[dt] = MFMA32(a, pb, o[dt]); }
            }
        }
        if (t + 1 < nt) ATT_STORE((t + 1) & 1);
        __syncthreads();
    }
#undef ATT_TILE
#undef ATT_LOAD
#undef ATT_STORE
    const float inv = 1.f / (lrun + __shfl_xor(lrun, 32));
    bf16* op = O + (size_t)(qrow + r) * DM + ocol0 + head * D + 4 * h;
#pragma unroll
    for (int dt = 0; dt < NDT; ++dt)
#pragma unroll
        for (int g = 0; g < 4; ++g) { u32x2 w; w.x = cvtpk(o[dt][4 * g] * inv, o[dt][4 * g + 1] * inv); w.y = cvtpk(o[dt][4 * g + 2] * inv, o[dt][4 * g + 3] * inv);
            *(u32x2*)(op + 32 * dt + 8 * g) = w; }
}


namespace adb {
using bf16 = unsigned short;
using bf16x8 = __attribute__((ext_vector_type(8))) short;
using s16x4  = __attribute__((ext_vector_type(4))) short;
using f32x16 = __attribute__((ext_vector_type(16))) float;
using u32x4  = __attribute__((ext_vector_type(4))) unsigned;
using ::crow; using ::cvtpk;
constexpr int   D = 128, NW = 8, QBLK = 32, KVBLK = 64;
constexpr float SCALE = 0.088388347648318440f;
constexpr float THR = 8.f;
constexpr int SDEPTH = 2;
constexpr int LDQ = 1536, LDK = 128, LDO = 1024;
constexpr size_t SHM_V = KVBLK * D * 2, SHM_K = KVBLK * D * 2, SHM_ATTN = 2 * SHM_V + 2 * SHM_K + NW * 64 * 4;
#define KSWZ(row, colB) ((row) * 256 + ((colB) ^ (((row) & 7) << 4)))
#define SBAR() __builtin_amdgcn_sched_barrier(0)
template <typename TIn> struct Stage;
template <> struct Stage<bf16>  { using T = bf16x8;
  __device__ static __forceinline__ T ld8(const bf16* p) { return *reinterpret_cast<const bf16x8*>(p); }
  __device__ static __forceinline__ bf16x8 tobf(T x) { return x; } };

__device__ __forceinline__ void partialSM(f32x16& p0, f32x16& p1, float& m_reg, float& mn, float& alpha) {
  constexpr float C = SCALE * 1.4426950408889634f;
  float pmax = p0[0]; for (int r = 1; r < 16; ++r) pmax = fmaxf(pmax, p0[r]); for (int r = 0; r < 16; ++r) pmax = fmaxf(pmax, p1[r]);
  { auto rr = __builtin_amdgcn_permlane32_swap(__float_as_uint(pmax), __float_as_uint(pmax), false, false);
    pmax = fmaxf(__uint_as_float(rr[0]), __uint_as_float(rr[1])); }
  if (__builtin_expect(__all(pmax - m_reg <= THR / SCALE), 1)) { mn = m_reg; alpha = 1.f; }
  else { mn = fmaxf(m_reg, pmax); alpha = __builtin_amdgcn_exp2f((m_reg - mn) * C); m_reg = mn; }
  float mnC = -mn * C;
  for (int r = 0; r < 16; ++r) p0[r] = fmaf(p0[r], C, mnC); for (int r = 0; r < 16; ++r) p1[r] = fmaf(p1[r], C, mnC);
  for (int r = 0; r < 16; ++r) p0[r] = __builtin_amdgcn_exp2f(p0[r]);
}
__device__ __forceinline__ void finishSM(f32x16& p0, f32x16& p1, float alpha, float& l_reg, bf16x8& pa0, bf16x8& pa1, bf16x8& pa2, bf16x8& pa3) {
  for (int r = 0; r < 16; ++r) p1[r] = __builtin_amdgcn_exp2f(p1[r]);
  float ps = 0; for (int r = 0; r < 16; ++r) ps += p0[r]; for (int r = 0; r < 16; ++r) ps += p1[r];
  { auto rr = __builtin_amdgcn_permlane32_swap(__float_as_uint(ps), __float_as_uint(ps), false, false);
    ps = __uint_as_float(rr[0]) + __uint_as_float(rr[1]); }
  l_reg = l_reg * alpha + ps;
#define PK4(P, BASE, OUT) do { unsigned a0 = cvtpk(P[BASE + 0], P[BASE + 1]), a1 = cvtpk(P[BASE + 2], P[BASE + 3]);   \
    unsigned b0 = cvtpk(P[BASE + 4], P[BASE + 5]), b1 = cvtpk(P[BASE + 6], P[BASE + 7]);                              \
    auto r0 = __builtin_amdgcn_permlane32_swap(a0, b0, false, false); auto r1 = __builtin_amdgcn_permlane32_swap(a1, b1, false, false); \
    u32x4 w = {r0[0], r1[0], r0[1], r1[1]}; OUT = *reinterpret_cast<bf16x8*>(&w); } while (0)
  PK4(p0, 0, pa0); PK4(p0, 8, pa1); PK4(p1, 0, pa2); PK4(p1, 8, pa3);
#undef PK4
}
__device__ __forceinline__ void qkt(f32x16& p0, f32x16& p1, const bf16* Ks, const bf16x8* qr, int r32, int hi) {
  p0 = f32x16{}; p1 = f32x16{};
  for (int d0 = 0; d0 < 8; ++d0) { int cb = (d0 * 16 + hi * 8) * 2;
    bf16x8 b0 = *reinterpret_cast<const bf16x8*>((const char*)Ks + KSWZ(r32, cb));
    bf16x8 b1 = *reinterpret_cast<const bf16x8*>((const char*)Ks + KSWZ(32 + r32, cb));
    p0 = __builtin_amdgcn_mfma_f32_32x32x16_bf16(b0, qr[d0], p0, 0, 0, 0);
    p1 = __builtin_amdgcn_mfma_f32_32x32x16_bf16(b1, qr[d0], p1, 0, 0, 0); }
}
__device__ __forceinline__ int v_st(int k, int c) { const int kk = (k & ~0xC) | ((k & 4) << 1) | ((k & 8) >> 1); return ((kk >> 3) * 4 + (c >> 5)) * 512 + ((kk & 7) * 32 + (c & 31)) * 2; }
__device__ __forceinline__ int v_rd_base(int lane) { return ((lane & 3) << 3) | (((lane >> 2) & 3) << 6) | (((lane >> 4) & 1) << 5) | (((lane >> 5) & 1) << 8); }
constexpr int v_rd_off(int d0, int ks, int half) { return d0 * 512 + ks * 4096 + half * 2048; }
template <int OFF> __device__ __forceinline__ s16x4 tr_read(int vb) {
  s16x4 r; asm volatile("ds_read_b64_tr_b16 %0, %1 offset:%2" : "=&v"(r) : "v"(vb), "i"(OFF) : "memory"); return r;
}
template <int D0> __device__ __forceinline__ void pv_one(f32x16& od, int vb, bf16x8 pa0, bf16x8 pa1, bf16x8 pa2, bf16x8 pa3) {
  const s16x4 l0 = tr_read<v_rd_off(D0, 0, 0)>(vb), h0 = tr_read<v_rd_off(D0, 0, 1)>(vb), l1 = tr_read<v_rd_off(D0, 1, 0)>(vb), h1 = tr_read<v_rd_off(D0, 1, 1)>(vb);
  const s16x4 l2 = tr_read<v_rd_off(D0, 2, 0)>(vb), h2 = tr_read<v_rd_off(D0, 2, 1)>(vb), l3 = tr_read<v_rd_off(D0, 3, 0)>(vb), h3 = tr_read<v_rd_off(D0, 3, 1)>(vb);
  asm volatile("s_waitcnt lgkmcnt(0)" ::: "memory"); SBAR();
#define PK(L, H) (bf16x8){L[0], L[1], L[2], L[3], H[0], H[1], H[2], H[3]}
  od = __builtin_amdgcn_mfma_f32_32x32x16_bf16(pa0, PK(l0, h0), od, 0, 0, 0);
  od = __builtin_amdgcn_mfma_f32_32x32x16_bf16(pa1, PK(l1, h1), od, 0, 0, 0);
  od = __builtin_amdgcn_mfma_f32_32x32x16_bf16(pa2, PK(l2, h2), od, 0, 0, 0);
  od = __builtin_amdgcn_mfma_f32_32x32x16_bf16(pa3, PK(l3, h3), od, 0, 0, 0);
#undef PK
}
__device__ __forceinline__ void pv_d0(f32x16* o, int vb, bf16x8 pa0, bf16x8 pa1, bf16x8 pa2, bf16x8 pa3) {
  pv_one<0>(o[0], vb, pa0, pa1, pa2, pa3); pv_one<1>(o[1], vb, pa0, pa1, pa2, pa3); pv_one<2>(o[2], vb, pa0, pa1, pa2, pa3); pv_one<3>(o[3], vb, pa0, pa1, pa2, pa3);
}

template <typename TQ>
__device__ __forceinline__ void attn_dense_body(const TQ* __restrict__ Qb, const bf16* __restrict__ Kh, const bf16* __restrict__ Vh,
                                                bf16* __restrict__ Ob, int seq, char* lds, const int tid) {
  using St = Stage<bf16>; using SQ = Stage<TQ>;
  const int wid = __builtin_amdgcn_readfirstlane(tid >> 6), lane = tid & 63, r32 = lane & 31, hi = lane >> 5;
  bf16* V_lds = (bf16*)lds; bf16* K_lds = (bf16*)(lds + 2 * SHM_V);
  float* ws = (float*)(lds + 2 * SHM_V + 2 * SHM_K) + wid * 64; float* li_l = ws; float* al_l = ws + 32;
  float m_reg = -1e30f, l_reg = 0; f32x16 o[4] = {}; bf16x8 qr[8];
  const TQ* Qw = Qb + (long)(wid * QBLK + r32) * LDQ + hi * 8;
#pragma unroll
  for (int d0 = 0; d0 < 8; ++d0) qr[d0] = SQ::tobf(SQ::ld8(Qw + d0 * 16));
  const int sr = tid >> 4, sc = (tid & 15) * 8, vst0 = v_st(sr, sc), vst1 = v_st(32 + sr, sc);
  const int vb0 = (int)(uintptr_t)V_lds + v_rd_base(lane);
  struct { typename St::T vs0, vs1, ks0, ks1; } sr_[SDEPTH];
#define SLOAD(i, k0) do { sr_[i].vs0 = St::ld8(&Vh[(long)((k0) + sr) * LDK + sc]); sr_[i].vs1 = St::ld8(&Vh[(long)((k0) + 32 + sr) * LDK + sc]); \
    sr_[i].ks0 = St::ld8(&Kh[(long)((k0) + sr) * LDK + sc]); sr_[i].ks1 = St::ld8(&Kh[(long)((k0) + 32 + sr) * LDK + sc]); } while (0)
#define SWRITE(b, i) do { *(bf16x8*)((char*)V_lds + (b) * SHM_V + vst0) = St::tobf(sr_[i].vs0);          \
    *(bf16x8*)((char*)V_lds + (b) * SHM_V + vst1) = St::tobf(sr_[i].vs1); int kc = sc * 2;               \
    *(bf16x8*)((char*)K_lds + (b) * SHM_K + KSWZ(sr, kc)) = St::tobf(sr_[i].ks0);                       \
    *(bf16x8*)((char*)K_lds + (b) * SHM_K + KSWZ(32 + sr, kc)) = St::tobf(sr_[i].ks1); } while (0)
#define SWAIT() do { if constexpr (SDEPTH == 2) asm volatile("s_waitcnt vmcnt(4)" ::: "memory"); else asm volatile("s_waitcnt vmcnt(0)" ::: "memory"); } while (0)
#define RESC(a) do { if (__any((a) < 1.f)) { if (hi == 0) al_l[r32] = (a); asm volatile("s_waitcnt lgkmcnt(0)" ::: "memory"); \
    for (int d = 0; d < 4; ++d) for (int r = 0; r < 16; ++r) o[d][r] *= al_l[crow(r, hi)]; } } while (0)
  f32x16 pA0, pA1, pB0, pB1; float mnA, mnB, alA, alB; bf16x8 pa0, pa1, pa2, pa3; const int NT = seq / KVBLK;
  constexpr int SE = 0, SO = SDEPTH - 1;
  SLOAD(SE, 0); asm volatile("s_waitcnt vmcnt(0)" ::: "memory"); SWRITE(0, SE); __syncthreads();
  qkt(pA0, pA1, K_lds, qr, r32, hi); partialSM(pA0, pA1, m_reg, mnA, alA);
  SLOAD(SO, KVBLK); if constexpr (SDEPTH == 2) { if (2 < NT) SLOAD(SE, 2 * KVBLK); }
  SWAIT(); SWRITE(1, SO); __syncthreads();
  for (int j = 1; j + 1 < NT; j += 2) {
    SBAR(); qkt(pB0, pB1, (bf16*)((char*)K_lds + SHM_K), qr, r32, hi);
    finishSM(pA0, pA1, alA, l_reg, pa0, pa1, pa2, pa3); SBAR();
    SLOAD(SO, (j + SDEPTH) * KVBLK); SBAR();
    pv_d0(o, vb0, pa0, pa1, pa2, pa3); partialSM(pB0, pB1, m_reg, mnB, alB);
    __syncthreads(); SWAIT(); SWRITE(0, SE);
    RESC(alB); __syncthreads();
    SBAR(); qkt(pA0, pA1, K_lds, qr, r32, hi);
    finishSM(pB0, pB1, alB, l_reg, pa0, pa1, pa2, pa3); SBAR();
    if (SDEPTH == 1 || j + 3 < NT) SLOAD(SE, (j + 1 + SDEPTH) * KVBLK); SBAR();
    pv_d0(o, vb0 + (int)SHM_V, pa0, pa1, pa2, pa3); partialSM(pA0, pA1, m_reg, mnA, alA);
    __syncthreads(); SWAIT(); SWRITE(1, SO);
    RESC(alA); __syncthreads();
  }
  SBAR(); qkt(pB0, pB1, (bf16*)((char*)K_lds + SHM_K), qr, r32, hi);
  finishSM(pA0, pA1, alA, l_reg, pa0, pa1, pa2, pa3); SBAR();
  pv_d0(o, vb0, pa0, pa1, pa2, pa3); partialSM(pB0, pB1, m_reg, mnB, alB);
  __syncthreads(); RESC(alB);
  finishSM(pB0, pB1, alB, l_reg, pa0, pa1, pa2, pa3); SBAR();
  pv_d0(o, vb0 + (int)SHM_V, pa0, pa1, pa2, pa3);
  if (hi == 0) li_l[r32] = l_reg; asm volatile("s_waitcnt lgkmcnt(0)" ::: "memory");
  float rli[16];
#pragma unroll
  for (int r = 0; r < 16; ++r) rli[r] = __builtin_amdgcn_rcpf(li_l[crow(r, hi)]);
  bf16* Ow = Ob + (long)(wid * QBLK) * LDO;
#pragma unroll
  for (int r = 0; r < 16; ++r) { int orow = crow(r, hi);
    for (int d0 = 0; d0 < 4; ++d0) Ow[(long)orow * LDO + d0 * 32 + r32] = (bf16)(::cvtpk(o[d0][r] * rli[r], 0.f) & 0xffffu); }
#undef SLOAD
#undef SWRITE
#undef SWAIT
#undef RESC
}
#undef SBAR
#undef KSWZ
}

DI void phase_mlstm_out(const Params& p, int lane, int wave) {
    const bf16* QKV = (const bf16*)(p.ws + WS_BIG); bf16* OC = (bf16*)(p.ws + WS_OCAT); const float* XC = (const float*)(p.ws + WS_XC);
    const float* gn = p.in[10];
    const int gw = blockIdx.x * 8 + wave, NGW = gridDim.x * 8;
    for (int row = gw; row < MTOT; row += NGW) {
        const float* hp = row < NCTX ? XC + (size_t)row * DM : p.out + (size_t)(row - NCTX) * DM;
        const bf16* oa = QKV + (size_t)row * NIN0 + 1536;
        bf16* dst = OC + (size_t)row * DM;
#pragma unroll
        for (int hd = 0; hd < 4; ++hd) { const int c0 = hd * 128 + lane, c1 = c0 + 64;
            const float v0 = hp[c0] + hp[512 + c0], v1 = hp[c1] + hp[512 + c1];
            const float rs = rsqrtf(wave_sum(v0 * v0 + v1 * v1) * (1.f / 128.f) + EPS);
            const float o0 = bf2f(oa[c0]), o1 = bf2f(oa[c1]);
            dst[c0] = f2bf(v0 * rs * gn[c0] / (1.f + __expf(-o0))); dst[c1] = f2bf(v1 * rs * gn[c1] / (1.f + __expf(-o1))); }
    }
}


#define XB_TMO      128
#define XB_XCNT(j)  (256  + 64 * (j))
#define XB_XSUB(j)  (1280 + 64 * (j))
#define XB_XGEN(j)  (2304 + 64 * (j))
#define XB_TOP      3328
#define XB_TOPGEN   3392
#define XCD_BAR_WORDS 3456
#define XB_SPIN_CAP (1u << 18)
DI unsigned xb_ld(unsigned* p)              { return __hip_atomic_load(p, __ATOMIC_RELAXED, __HIP_MEMORY_SCOPE_AGENT); }
DI unsigned xb_add(unsigned* p, unsigned v) { return __hip_atomic_fetch_add(p, v, __ATOMIC_RELAXED, __HIP_MEMORY_SCOPE_AGENT); }
DI unsigned xb_xcc_id() { return (unsigned)__builtin_amdgcn_s_getreg((3 << 11) | 20) & 0xFu; }
#define XB_SPIN(cond, bar) do { unsigned _sp = 0; while (cond) { __builtin_amdgcn_s_sleep(1); \
    if ((++_sp & 255u) == 0u) { if (xb_ld(&(bar)[XB_TMO])) break; if (_sp > XB_SPIN_CAP) { atomicAdd(&(bar)[XB_TMO], 1u); break; } } } } while (0)
struct XcdBarrier { unsigned* bar; unsigned x; volatile LAS unsigned* st; };
DI XcdBarrier xcd_barrier_post(unsigned* bar, volatile LAS unsigned* st, int tid) {
    XcdBarrier b; b.bar = bar; b.x = xb_xcc_id(); b.st = st;
    if (tid == 0) (void)xb_add(&bar[XB_XCNT(b.x)], 1u);
    return b;
}
DI void xcd_barrier_complete(unsigned* bar, unsigned x, unsigned& nloc, unsigned& nx) {
    const unsigned G = gridDim.x * gridDim.y * gridDim.z;
    unsigned sum, cnt, mine, sp = 0u;
    for (;;) {
        sum = 0u; cnt = 0u; mine = 0u;
#pragma unroll
        for (unsigned j = 0; j < 16; ++j) { const unsigned c = xb_ld(&bar[XB_XCNT(j)]); sum += c; cnt += (c > 0u) ? 1u : 0u; mine = (j == x) ? c : mine; }
        if (sum == G) break;
        __builtin_amdgcn_s_sleep(1);
        if ((++sp & 255u) == 0u) { if (xb_ld(&bar[XB_TMO])) break; if (sp > XB_SPIN_CAP) { atomicAdd(&bar[XB_TMO], 1u); break; } }
    }
    nloc = mine > 0u ? mine : 1u; nx = cnt > 0u ? cnt : 1u;
}
DI void xcd_barrier(const XcdBarrier& b, int tid) {
    asm volatile("s_waitcnt vmcnt(0)" ::: "memory");
    __syncthreads();
    if (tid == 0) {
        unsigned* bar = b.bar;
        __builtin_amdgcn_s_waitcnt(0);
        unsigned nloc = b.st[0], nx = b.st[1];
        if (nloc == 0u) { xcd_barrier_complete(bar, b.x, nloc, nx); b.st[0] = nloc; b.st[1] = nx; }
        const unsigned old = xb_add(&bar[XB_XSUB(b.x)], 1u);
        const unsigned gen = old / nloc;
        if (old + 1u == (gen + 1u) * nloc) {
            __builtin_amdgcn_fence(__ATOMIC_RELEASE, "agent");
            asm volatile("s_waitcnt vmcnt(0)" ::: "memory");
            const unsigned og = xb_add(&bar[XB_TOP], 1u);
            const unsigned tg = og / nx;
            if (og + 1u == (tg + 1u) * nx) xb_add(&bar[XB_TOPGEN], 1u);
            else XB_SPIN(xb_ld(&bar[XB_TOPGEN]) == tg, bar);
            __builtin_amdgcn_fence(__ATOMIC_ACQUIRE, "agent");
            xb_add(&bar[XB_XGEN(b.x)], 1u);
            asm volatile("s_waitcnt vmcnt(0)" ::: "memory");
        } else {
            XB_SPIN(xb_ld(&bar[XB_XGEN(b.x)]) == gen, bar);
            __builtin_amdgcn_fence(__ATOMIC_ACQUIRE, "agent");
            asm volatile("s_waitcnt vmcnt(0)" ::: "memory");
        }
    }
    __syncthreads();
}
DI void sub_barrier(unsigned* cnt, unsigned n, int tid) {
    asm volatile("s_waitcnt vmcnt(0)" ::: "memory");
    __syncthreads();
    if (tid == 0) {
        __builtin_amdgcn_fence(__ATOMIC_RELEASE, "agent");
        asm volatile("s_waitcnt vmcnt(0)" ::: "memory");
        (void)xb_add(cnt, 1u);
        unsigned sp = 0u; while (xb_ld(cnt) < n) { __builtin_amdgcn_s_sleep(1); if (++sp > (1u << 22)) break; }
        __builtin_amdgcn_fence(__ATOMIC_ACQUIRE, "agent");
        asm volatile("s_waitcnt vmcnt(0)" ::: "memory");
    }
    __syncthreads();
}
#ifndef REP_X1
#define REP_X1 1
#endif
#ifndef REP_X2
#define REP_X2 1
#endif
#ifndef REP_X3
#define REP_X3 1
#endif
#ifndef REP_SYNC
#define REP_SYNC 1
#endif
#ifndef REP_ATTNC
#define REP_ATTNC 1
#endif
#ifndef REP_MLSTM
#define REP_MLSTM 1
#endif
#ifndef REP_SWA
#define REP_SWA 1
#endif
#ifndef REP_UP1
#define REP_UP1 1
#endif
#ifndef REP_NORM
#define REP_NORM 1
#endif
#ifndef REP_PROL
#define REP_PROL 1
#endif
#define GSYNC() do { FRESH_IDS(); for (int s_ = 0; s_ < REP_SYNC; ++s_) xcd_barrier(xbar, tid); } while (0)
__global__ void __launch_bounds__(512, 2) fwd_kernel(Params p) {
    extern __shared__ __attribute__((aligned(16))) unsigned char lds_raw[];
    LAS unsigned char* lds = (LAS unsigned char*)lds_raw;
    cg::grid_group grid = cg::this_grid();
#define FRESH_IDS() int tid_ = wave_s * 64 + fresh_lane(); asm volatile("" : "+v"(tid_)); const int tid = tid_, lane = tid & 63, wave = wave_s; (void)tid; (void)lane; (void)wave
#define run_gemm(...) run_gemm_rng_(__VA_ARGS__, (int)gridDim.x, (int)blockIdx.x, 0, 0x7fffffff, tid)
#define run_gemm_gc(...) run_gemm_rng_(__VA_ARGS__, 0, 0x7fffffff, tid)
#define run_gemm_rng(...) run_gemm_rng_(__VA_ARGS__, tid)
    const int wave_s = __builtin_amdgcn_readfirstlane((int)threadIdx.x >> 6);
    unsigned char* ws = p.ws;
    bf16* WIN0 = (bf16*)(ws + WS_WIN0); bf16* WOUT0 = (bf16*)(ws + WS_WOUT0); bf16* WIN1 = (bf16*)(ws + WS_WIN1); bf16* WOUT1 = (bf16*)(ws + WS_WOUT1);
    bf16* W1 = (bf16*)(ws + WS_W1); bf16* W2 = (bf16*)(ws + WS_W2);
    const float* MOD0 = (const float*)(ws + WS_MOD); const float* MOD1 = MOD0 + 9 * NMODC;
    float* XC = (float*)(ws + WS_XC); bf16* VT = (bf16*)(ws + WS_VT); bf16* H = (bf16*)(ws + WS_H); bf16* OC = (bf16*)(ws + WS_OCAT); bf16* BIG = (bf16*)(ws + WS_BIG);
    const float* x = p.in[0]; const float* ctx = p.in[2];

    unsigned* barw = (unsigned*)(ws + WS_BAR);
    volatile LAS unsigned* bst = (volatile LAS unsigned*)(lds + LDS_BYTES - 16);
    { FRESH_IDS();
      if (tid < 2) bst[tid] = 0u;
      if (blockIdx.x == 0) for (int i = tid; i < 4096; i += 512) barw[i] = 0u; }
    for (int rep_ = 0; rep_ < REP_PROL; ++rep_) { FRESH_IDS();
        phase_prologue(p, lds, tid, lane, wave);
    }
    grid.sync();
    XcdBarrier xbar; { FRESH_IDS(); xbar = xcd_barrier_post(barw, bst, tid); }
    float* RSS = (float*)(ws + WS_RSS); const float* BIAS = (const float*)(ws + WS_BIAS);
    for (int rep_ = 0; rep_ < REP_NORM; ++rep_) { FRESH_IDS(); __syncthreads();
        phase_norm<false>(p, lds, ctx, x, p.in[6], MOD0, 0, H, 0, MTOT, tid, lane, wave);
        phase_bias(p, lane, wave, 0, 4096 + 1536, (int)blockIdx.x, (int)gridDim.x);
    }
    GSYNC();
    { FRESH_IDS();
        run_gemm(lds, H, WIN0, MTOT, NIN0, DM, EpiStore<0>{BIG, NIN0});
        { const int G = (int)gridDim.x, rem = ((MTOT / 256) * (NIN0 / 256)) % G, b0 = rem ? rem : 0, nb = G - b0;
          if ((int)blockIdx.x >= b0) { LAS float* scr = (LAS float*)(lds + wave * 16384);
              for (int it = TR_EARLY - TR_I6 + ((int)blockIdx.x - b0) * 8 + wave; it < TR_EARLY; it += nb * 8) transpose_any(p, scr, it, lane); } }
        phase_gates(p, lds, H, tid, lane, wave, (int)blockIdx.x, (int)gridDim.x);
    }
    GSYNC();
    for (int rep_ = 0; rep_ < REP_MLSTM; ++rep_) {
    { FRESH_IDS();
        if (rep_ == 0) phase_post<64>(BIG, NIN0, 2048, 8, 2560, 2, 2688, p.in[11], p.in[12], VT, true, lds, tid, lane, wave);
        for (int rx_ = 0; rx_ < REP_X1; ++rx_) for (int item = blockIdx.x; item < 32 * NCH; item += gridDim.x) mlstm_x1(p, lds, item, tid, lane, wave);
    }
    GSYNC();
    { FRESH_IDS();
        const int G_ = (int)gridDim.x, nx3 = 32 * NCH, heavy = nx3 % G_, SWA_N = 1024 + 64;
        const int SWA_B = (heavy > 0 && G_ > heavy) ? 2 * (G_ - heavy) : 0, SWA_A = SWA_B < SWA_N ? SWA_N - SWA_B : SWA_N;
        if (((int)blockIdx.x & 1) == 0) for (int rx_ = 0; rx_ < REP_X2; ++rx_) mlstm_x2(p, tid);
        for (int rep_s = 0; rep_s < REP_SWA; ++rep_s)
        for (int item = (int)blockIdx.x; item < SWA_A; item += G_) {
            if (item < 1024) attn_item<64, 1, 2>(BIG, NIN0, 2048, 2560, VT, OC, 512, p.in[13], lds, item, tid, lane, wave);
            else attn_item<64, 2, 2>(BIG, NIN0, 2048, 2560, VT, OC, 512, p.in[13], lds, item - 1024, tid, lane, wave);
        }
        if (((int)blockIdx.x & 1) == 1) for (int rx_ = 0; rx_ < REP_X2; ++rx_) mlstm_x2(p, tid);
    }
    GSYNC();
    { FRESH_IDS();
        for (int rx_ = 0; rx_ < REP_X3; ++rx_) for (int item = blockIdx.x; item < 32 * NCH; item += gridDim.x) mlstm_x3(p, lds, item, tid, lane, wave);
        const int G_ = (int)gridDim.x, nx3 = 32 * NCH, heavy = nx3 % G_, SWA_N = 1024 + 64;
        const int SWA_B = (heavy > 0 && G_ > heavy) ? 2 * (G_ - heavy) : 0, SWA_A = SWA_B < SWA_N ? SWA_N - SWA_B : SWA_N;
        if (SWA_A < SWA_N && (int)blockIdx.x >= heavy)
            for (int item = SWA_A + (int)blockIdx.x - heavy; item < SWA_N; item += G_ - heavy) {
                if (item < 1024) attn_item<64, 1, 2>(BIG, NIN0, 2048, 2560, VT, OC, 512, p.in[13], lds, item, tid, lane, wave);
                else attn_item<64, 2, 2>(BIG, NIN0, 2048, 2560, VT, OC, 512, p.in[13], lds, item - 1024, tid, lane, wave);
            }
    }
    }
    GSYNC();
    { FRESH_IDS();
        run_gemm(lds, OC + (size_t)NCTX * DM, WOUT0, NLAT, DM, DM, EpiResidN{ctx, x, XC, p.out, MOD0, 2, NCTX, p.in[7], MOD0, 3, H, RSS});
    }
    GSYNC();
    { FRESH_IDS();
        const int NG1 = 32, bid = (int)blockIdx.x, G = (int)gridDim.x;
        const EpiStoreN<1> eup{BIG + (size_t)NCTX * DFF, DFF, RSS, BIAS, NCTX};
        if (bid < NG1) {
            run_gemm_gc(lds, OC, WOUT0, NCTX, DM, DM, EpiResidN{ctx, x, XC, p.out, MOD0, 2, 0, p.in[7], MOD0, 3, H, RSS}, NG1, bid);
            sub_barrier(barw + 3584, NG1, tid);
            run_gemm_gc(lds, H, W1, NCTX, DFF, DM, EpiStoreN<1>{BIG, DFF, RSS, BIAS, 0}, NG1, bid);
            run_gemm_rng(lds, H + (size_t)NCTX * DM, W1, NLAT, DFF, DM, eup, NG1, bid, 0, 96);
        } else {
            run_gemm_rng(lds, H + (size_t)NCTX * DM, W1, NLAT, DFF, DM, eup, G - NG1, bid - NG1, 96, 0x7fffffff);
        }
    }
    GSYNC();
    bf16* BIG1 = BIG + (size_t)16 * 1024 * 1024;
    const int GC = 32;
    { FRESH_IDS();
        run_gemm(lds, BIG + (size_t)NCTX * DFF, W2, NLAT, DM, DFF, EpiResidN{XC, p.out, XC, p.out, MOD0, 5, NCTX, p.in[6] + DM, MOD1, 0, H, RSS + MTOT});
    }
    GSYNC();
    { FRESH_IDS();
        if ((int)blockIdx.x < GC) run_gemm_gc(lds, BIG, W2, NCTX, DM, DFF, EpiResidN{XC, p.out, XC, p.out, MOD0, 5, 0, p.in[6] + DM, MOD1, 0, H, RSS + MTOT}, GC, (int)blockIdx.x);
        else { run_gemm_gc(lds, H + (size_t)NCTX * DM, WIN1, NLAT, NIN1, DM, EpiStoreN<0>{BIG1 + (size_t)NCTX * NIN1, NIN1, RSS + MTOT, BIAS + 9 * 4096, NCTX}, (int)gridDim.x - GC, (int)blockIdx.x - GC);
            LAS float* scr = (LAS float*)(lds + wave * 16384);
            for (int it = TR_EARLY + ((int)blockIdx.x - GC) * 8 + wave; it < TR_ALL; it += ((int)gridDim.x - GC) * 8) transpose_any(p, scr, it, lane); }
    }
    GSYNC();
    { FRESH_IDS();
        if ((int)blockIdx.x < 48) { run_gemm_gc(lds, H, WIN1, NCTX, NIN1, DM, EpiStoreN<0>{BIG1, NIN1, RSS + MTOT, BIAS + 9 * 4096, 0}, 48, (int)blockIdx.x);
            sub_barrier(barw + 3600, 48, tid);
            phase_post1(BIG1, p.in[16], p.in[17], VT, (bf16*)(ws + WS_V1), lane, wave, 0, NCTX, (int)blockIdx.x, 48); }
        else { phase_post1(BIG1, p.in[16], p.in[17], VT, (bf16*)(ws + WS_V1), lane, wave, NCTX, MTOT, (int)blockIdx.x - 48, (int)gridDim.x - 48);
            phase_bias(p, lane, wave, 4096 + 1536, 4096 + 1536 + 4096, (int)blockIdx.x - 48, (int)gridDim.x - 48); }
    }
    GSYNC();
    for (int rep_ = 0; rep_ < REP_ATTNC; ++rep_) { FRESH_IDS();
        const int G_ = (int)gridDim.x, vcu = (G_ % 8 == 0) ? ((int)blockIdx.x & 7) * (G_ >> 3) + ((int)blockIdx.x >> 3) : (int)blockIdx.x;
        for (int item = vcu; item < 1024; item += G_) {
            const int qb = item & 15, head = (item >> 4) & 7, b = item >> 7, kvh = head >> 2;
            int tl = wave * 64 + fresh_lane(); asm volatile("" : "+v"(tl));
            const size_t qrow = (size_t)NCTX + (size_t)b * SEQ + qb * 256;
            __syncthreads();
            adb::attn_dense_body<adb::bf16>(BIG1 + qrow * NIN1 + head * 128, VT + (size_t)(b * 2 + kvh) * KVLEN * 128, (const bf16*)(ws + WS_V1) + (size_t)(b * 2 + kvh) * KVLEN * 128,
                                            OC + qrow * DM + head * 128, KVLEN, (char*)lds, tl);
        }
    }
    GSYNC();
    { FRESH_IDS();
        run_gemm(lds, OC + (size_t)NCTX * DM, WOUT1, NLAT, DM, DM, EpiResidN{XC, p.out, XC, p.out, MOD1, 2, NCTX, p.in[7] + DM, MOD1, 3, H, RSS + 2 * MTOT});
    }
    GSYNC();
    for (int rep_ = 0; rep_ < REP_UP1; ++rep_) { FRESH_IDS();
        run_gemm(lds, H + (size_t)NCTX * DM, W1 + (size_t)DFF * DM, NLAT, DFF, DM, EpiStoreN<1>{BIG, DFF, RSS + 2 * MTOT, BIAS + 2 * 9 * 4096, NCTX});
    }
    GSYNC();
    { FRESH_IDS();
        run_gemm(lds, BIG, W2 + (size_t)DFF * DM, NLAT, DM, DFF, EpiResid{XC, p.out, XC, p.out, MOD1, 5, NCTX});
    }
}

extern "C" void kernel_launch(void* const* d_in, const int* in_sizes, int n_in, void* d_out, int out_size, void* d_ws, size_t ws_size, hipStream_t stream) {
    static int grid = 0;
    if (grid == 0) {
        if (n_in != 21 || out_size != NLAT * DM || ws_size < WS_END) { fprintf(stderr, "kernel_launch: unexpected shapes (n_in %d out %d ws %zu)\n", n_in, out_size, ws_size); grid = -1; return; }
        int dev = 0, cus = 0, per_cu = 0;
        hipGetDevice(&dev); hipDeviceGetAttribute(&cus, hipDeviceAttributeMultiprocessorCount, dev);
        hipFuncSetAttribute((const void*)fwd_kernel, hipFuncAttributeMaxDynamicSharedMemorySize, LDS_BYTES);
        hipOccupancyMaxActiveBlocksPerMultiprocessor(&per_cu, (const void*)fwd_kernel, 512, LDS_BYTES);
        if (per_cu < 1) { fprintf(stderr, "kernel_launch: occupancy query says %d blocks per CU\n", per_cu); per_cu = 1; }
        grid = cus * per_cu;
    }
    if (grid < 0) return;
    Params p{};
    for (int i = 0; i < 21; ++i) p.in[i] = (const float*)d_in[i];
    p.out = (float*)d_out; p.ws = (unsigned char*)d_ws;
    void* args[] = {&p};
    hipError_t e = hipLaunchCooperativeKernel((const void*)fwd_kernel, dim3(grid), dim3(512), args, LDS_BYTES, stream);
    if (e != hipSuccess) fprintf(stderr, "cooperative launch failed: %s (grid %d)\n", hipGetErrorString(e), grid);
}
```
